# Optimizing an MI355X kernel written in HIP

```python
import math
import jax, jax.numpy as jnp
from jax import lax
import numpy as np

D_MODEL = 2048
BATCH = 32
SEQ = 256
DEPTH = 4
DEC_BATCH = 8
DEC_SEQ = 2048
PAST_LEN = 512

GRID_W = 64
WIN_R = 8
WIN_C = 16
Q_BLOCK = 128
EPS = 1e-6
ROPE_BASE = 10000.0
N_EVEN = (DEPTH + 1) // 2
N_ODD = DEPTH // 2
NA_DIM = 128
NA_WIDTH = D_MODEL // 2
NA_HEADS = NA_WIDTH // NA_DIM
MLA_NOPE = 128
MLA_ROPE = 64
MLA_V = 128
MLA_WIDTH = D_MODEL // 2
MLA_HEADS = MLA_WIDTH // MLA_V
MLA_Q_LORA = D_MODEL // 4
MLA_KV_LORA = D_MODEL // 8
EVEN_SPLITS = (NA_WIDTH, NA_WIDTH, NA_WIDTH, NA_WIDTH, MLA_Q_LORA, MLA_KV_LORA, MLA_ROPE, MLA_WIDTH)
EVEN_IN = 4 * NA_WIDTH + MLA_Q_LORA + MLA_KV_LORA + MLA_ROPE + MLA_WIDTH
DIFF_HEADS = 8
DIFF_D = D_MODEL // (2 * DIFF_HEADS)
DIFF_WIDTH = 2 * DIFF_HEADS * DIFF_D
ODD_IN = 4 * DIFF_WIDTH
NA_SCALE = NA_DIM ** -0.5
MLA_SCALE = (MLA_NOPE + MLA_ROPE) ** -0.5
DIFF_SCALE = DIFF_D ** -0.5

kernel_name = 'hybrid_diffusion_na_mla_diffattn_step'


def _split(x, sizes):
    out, start = [], 0
    for s in sizes:
        out.append(x[..., start:start + s])
        start += s
    return out


def rmsnorm(x, g):
    x32 = x.astype(jnp.float32)
    y = x32 * lax.rsqrt(jnp.mean(x32 * x32, axis=-1, keepdims=True) + EPS)
    return (y * g.astype(jnp.float32)).astype(x.dtype)


def modulation(cond, w_ada, b_ada):
    ada = (jax.nn.silu(cond) @ w_ada + b_ada)[:, None, :]
    return jnp.split(ada, 3, axis=-1)


def rope_1d(x, pos):
    half = x.shape[-1] // 2
    inv = ROPE_BASE ** (-jnp.arange(half, dtype=jnp.float32) / half)
    ang = pos.astype(jnp.float32)[:, None] * inv[None, :]
    cos = jnp.cos(ang)[:, None, :]
    sin = jnp.sin(ang)[:, None, :]
    x1 = x[..., :half].astype(jnp.float32)
    x2 = x[..., half:].astype(jnp.float32)
    return jnp.concatenate([x1 * cos - x2 * sin, x2 * cos + x1 * sin], axis=-1).astype(x.dtype)


def axial_rope(x, rows, cols):
    a = x.shape[-1] // 2
    return jnp.concatenate([rope_1d(x[..., :a], rows), rope_1d(x[..., a:], cols)], axis=-1)


def dense_attention(q, k, v, scale):
    B, Sq, H, d = q.shape
    nb = Sq // Q_BLOCK
    qb = q.reshape(B, nb, Q_BLOCK, H, d).transpose(1, 0, 2, 3, 4)

    def block(q_blk):
        s = jnp.einsum('bqhd,bkhd->bhqk', q_blk, k).astype(jnp.float32) * scale
        p = jax.nn.softmax(s, axis=-1).astype(v.dtype)
        return jnp.einsum('bhqk,bkhd->bqhd', p, v)

    o = lax.map(block, qb)
    return o.transpose(1, 0, 2, 3, 4).reshape(B, Sq, H, v.shape[-1])


def na_tables(rows):
    wr = min(WIN_R, rows)
    r = np.arange(rows)
    c = np.arange(GRID_W)
    rs = np.clip(r - wr // 2, 0, rows - wr)
    cs = np.clip(c - WIN_C // 2, 0, GRID_W - WIN_C)
    kr = rs[:, None] + np.arange(wr)[None, :]
    kc = cs[:, None] + np.arange(WIN_C)[None, :]
    key_idx = kr[:, None, :, None] * GRID_W + kc[None, :, None, :]
    dr = kr - r[:, None]
    dc = kc - c[:, None]
    bias_idx = (dr[:, None, :, None] + WIN_R - 1) * (2 * WIN_C - 1) + (dc[None, :, None, :] + WIN_C - 1)
    K = wr * WIN_C
    return (jnp.asarray(key_idx.reshape(rows, GRID_W, K), dtype=jnp.int32),
            jnp.asarray(bias_idx.reshape(rows, GRID_W, K), dtype=jnp.int32))


def na_latent(q, k, v, k_ctx, v_ctx, rpb):
    B, S, H, d = q.shape
    rows = S // GRID_W
    key_idx, bias_idx = na_tables(rows)
    rpb_flat = rpb.reshape(H, -1)
    qr = q.reshape(B, rows, GRID_W, H, d).transpose(1, 0, 2, 3, 4)

    def row_block(args):
        q_blk, kidx, bidx = args
        k_win = k[:, kidx]
        v_win = v[:, kidx]
        bias = rpb_flat[:, bidx].astype(jnp.float32)
        s_win = jnp.einsum('bqhd,bqkhd->bhqk', q_blk, k_win).astype(jnp.float32) * NA_SCALE + bias[None]
        s_ctx = jnp.einsum('bqhd,bkhd->bhqk', q_blk, k_ctx).astype(jnp.float32) * NA_SCALE
        p = jax.nn.softmax(jnp.concatenate([s_win, s_ctx], axis=-1), axis=-1).astype(v.dtype)
        K = kidx.shape[-1]
        return (jnp.einsum('bhqk,bqkhd->bqhd', p[..., :K], v_win)
                + jnp.einsum('bhqk,bkhd->bqhd', p[..., K:], v_ctx))

    o = lax.map(row_block, (qr, key_idx, bias_idx))
    return o.transpose(1, 0, 2, 3, 4).reshape(B, S, H, d)


def even_project(h, w_in, g_q, w_uq, g_kv):
    B, S, _ = h.shape
    qa, ka, va, ga, cq, ckv_raw, kpe, gb = _split(h @ w_in, EVEN_SPLITS)
    heads = lambda t: t.reshape(B, S, NA_HEADS, NA_DIM)
    q_mla = (rmsnorm(cq, g_q) @ w_uq).reshape(B, S, MLA_HEADS, MLA_NOPE + MLA_ROPE)
    ckv = rmsnorm(ckv_raw, g_kv)
    return heads(qa), heads(ka), heads(va), ga, q_mla, ckv, kpe, gb


def mla_kv(ckv, kpe, w_ukv):
    B, S, _ = ckv.shape
    kv = (ckv @ w_ukv).reshape(B, S, MLA_HEADS, MLA_NOPE + MLA_V)
    k = jnp.concatenate([kv[..., :MLA_NOPE],
                         jnp.broadcast_to(kpe[:, :, None, :], (B, S, MLA_HEADS, MLA_ROPE))], axis=-1)
    return k, kv[..., MLA_NOPE:]


def even_merge(oa, ga, ob, gb, w_out):
    B, S = ga.shape[:2]
    y = jnp.concatenate([oa.reshape(B, S, -1) * jax.nn.silu(ga),
                         ob.reshape(B, S, -1) * jax.nn.silu(gb)], axis=-1)
    return y @ w_out


def even_context(h, w_in, w_out, g_q, w_uq, g_kv, w_ukv):
    qa, ka, va, ga, q_mla, ckv, kpe, gb = even_project(h, w_in, g_q, w_uq, g_kv)
    oa = dense_attention(qa, ka, va, NA_SCALE)
    kb, vb = mla_kv(ckv, kpe, w_ukv)
    ob = dense_attention(q_mla, kb, vb, MLA_SCALE)
    return even_merge(oa, ga, ob, gb, w_out), (ka, va, ckv, kpe)


def even_latent(h, ctx_k, ctx_v, ctx_ckv, ctx_kpe, rows, cols, w_in, w_out, rpb, g_q, w_uq, g_kv, w_ukv):
    qa, ka, va, ga, q_mla, ckv, kpe, gb = even_project(h, w_in, g_q, w_uq, g_kv)
    oa = na_latent(qa, ka, va, ctx_k, ctx_v, rpb)
    q_mla = jnp.concatenate([q_mla[..., :MLA_NOPE], axial_rope(q_mla[..., MLA_NOPE:], rows, cols)], axis=-1)
    kpe = axial_rope(kpe[:, :, None, :], rows, cols)[:, :, 0, :]
    kb_lat, vb_lat = mla_kv(ckv, kpe, w_ukv)
    kb_ctx, vb_ctx = mla_kv(ctx_ckv, ctx_kpe, w_ukv)
    ob = dense_attention(q_mla, jnp.concatenate([kb_ctx, kb_lat], axis=1),
                         jnp.concatenate([vb_ctx, vb_lat], axis=1), MLA_SCALE)
    return even_merge(oa, ga, ob, gb, w_out)


def odd_project(h, w_in):
    B, S, _ = h.shape
    q, k, v, g = jnp.split(h @ w_in, 4, axis=-1)
    q = q.reshape(B, S, DIFF_HEADS, 2, DIFF_D)
    k = k.reshape(B, S, DIFF_HEADS, 2, DIFF_D)
    v = v.reshape(B, S, DIFF_HEADS, 2 * DIFF_D)
    return q, k, v, g


def diff_rope(t, rows, cols):
    B, S = t.shape[:2]
    return axial_rope(t.reshape(B, S, 2 * DIFF_HEADS, DIFF_D), rows, cols).reshape(B, S, DIFF_HEADS, 2, DIFF_D)


def diff_attend(q, k, v, g, lam_params, g_sub, lam_init, w_out):
    B, S = q.shape[:2]
    o1 = dense_attention(q[..., 0, :], k[..., 0, :], v, DIFF_SCALE)
    o2 = dense_attention(q[..., 1, :], k[..., 1, :], v, DIFF_SCALE)
    lp = lam_params.astype(jnp.float32)
    lam = jnp.exp(jnp.sum(lp[0] * lp[1])) - jnp.exp(jnp.sum(lp[2] * lp[3])) + lam_init
    o = rmsnorm(o1 - lam.astype(o1.dtype) * o2, g_sub) * (1.0 - lam_init)
    return (o.reshape(B, S, -1) * jax.nn.silu(g)) @ w_out


def odd_context(h, w_in, w_out, lam_params, g_sub, lam_init):
    B, S, _ = h.shape
    q, k, v, g = odd_project(h, w_in)
    y = diff_attend(q, k, v, g, lam_params, g_sub, lam_init, w_out)
    return y, (k.reshape(B, S, DIFF_HEADS, 2 * DIFF_D), v)


def odd_latent(h, ctx_k, ctx_v, rows, cols, w_in, w_out, lam_params, g_sub, lam_init):
    B, L = ctx_k.shape[:2]
    q, k, v, g = odd_project(h, w_in)
    q = diff_rope(q, rows, cols)
    k = diff_rope(k, rows, cols)
    k_all = jnp.concatenate([ctx_k.reshape(B, L, DIFF_HEADS, 2, DIFF_D), k], axis=1)
    v_all = jnp.concatenate([ctx_v, v], axis=1)
    return diff_attend(q, k_all, v_all, g, lam_params, g_sub, lam_init, w_out)


def setup_inputs(seed: int = 0) -> dict:
    key = jax.random.key(seed)
    ks = jax.random.split(key, 32)
    nrm = lambda k, shape, s: jax.random.normal(k, shape, jnp.float32) * s
    D = D_MODEL
    return {
        'x_prompt': nrm(ks[0], (BATCH, SEQ, D), 1.0),
        'x_sample': nrm(ks[1], (DEC_BATCH, DEC_SEQ, D), 1.0),
        'cache_na_k': nrm(ks[2], (DEC_BATCH, N_EVEN, PAST_LEN, NA_HEADS, NA_DIM), 1.0),
        'cache_na_v': nrm(ks[3], (DEC_BATCH, N_EVEN, PAST_LEN, NA_HEADS, NA_DIM), 1.0),
        'cache_mla_ckv': nrm(ks[4], (DEC_BATCH, N_EVEN, PAST_LEN, MLA_KV_LORA), 1.0),
        'cache_mla_kpe': nrm(ks[5], (DEC_BATCH, N_EVEN, PAST_LEN, MLA_ROPE), 1.0),
        'cache_diff_k': nrm(ks[6], (DEC_BATCH, N_ODD, PAST_LEN, DIFF_HEADS, 2 * DIFF_D), 1.0),
        'cache_diff_v': nrm(ks[7], (DEC_BATCH, N_ODD, PAST_LEN, DIFF_HEADS, 2 * DIFF_D), 1.0),
        'c': nrm(ks[8], (DEC_BATCH, D), 1.0),
        'c_ctx': nrm(ks[9], (D,), 1.0),
        'w_ada': nrm(ks[10], (DEPTH, D, 3 * D), 0.5 * D ** -0.5),
        'b_ada': nrm(ks[11], (DEPTH, 3 * D), 0.01),
        'g_pre': 1.0 + nrm(ks[12], (DEPTH, D), 0.01),
        'g_post': 1.0 + nrm(ks[13], (DEPTH, D), 0.01),
        'w_in_even': nrm(ks[14], (N_EVEN, D, EVEN_IN), D ** -0.5),
        'w_out_even': nrm(ks[15], (N_EVEN, NA_WIDTH + MLA_WIDTH, D), (NA_WIDTH + MLA_WIDTH) ** -0.5),
        'na_rpb': nrm(ks[16], (N_EVEN, NA_HEADS, 2 * WIN_R - 1, 2 * WIN_C - 1), 0.1),
        'mla_g_q': 1.0 + nrm(ks[17], (N_EVEN, MLA_Q_LORA), 0.01),
        'mla_w_uq': nrm(ks[18], (N_EVEN, MLA_Q_LORA, MLA_HEADS * (MLA_NOPE + MLA_ROPE)), MLA_Q_LORA ** -0.5),
        'mla_g_kv': 1.0 + nrm(ks[19], (N_EVEN, MLA_KV_LORA), 0.01),
        'mla_w_ukv': nrm(ks[20], (N_EVEN, MLA_KV_LORA, MLA_HEADS * (MLA_NOPE + MLA_V)), MLA_KV_LORA ** -0.5),
        'w_in_odd': nrm(ks[21], (N_ODD, D, ODD_IN), D ** -0.5),
        'w_out_odd': nrm(ks[22], (N_ODD, DIFF_WIDTH, D), DIFF_WIDTH ** -0.5),
        'diff_lambda': nrm(ks[23], (N_ODD, 4, DIFF_D), 0.1),
        'diff_g': 1.0 + nrm(ks[24], (N_ODD, 2 * DIFF_D), 0.01),
    }


def reference(x_prompt, x_sample, cache_na_k, cache_na_v, cache_mla_ckv, cache_mla_kpe, cache_diff_k,
              cache_diff_v, c, c_ctx, w_ada, b_ada, g_pre, g_post, w_in_even, w_out_even, na_rpb,
              mla_g_q, mla_w_uq, mla_g_kv, mla_w_ukv, w_in_odd, w_out_odd, diff_lambda, diff_g):
    S = x_sample.shape[1]
    t = jnp.arange(S)
    rows = t // GRID_W
    cols = t % GRID_W
    xp, xs = x_prompt, x_sample
    na_k, na_v, mla_ckv, mla_kpe, diff_k, diff_v = [], [], [], [], [], []
    for l in range(DEPTH):
        i = l // 2
        sh_p, sc_p, gt_p = modulation(c_ctx[None, :], w_ada[l], b_ada[l])
        sh_s, sc_s, gt_s = modulation(c, w_ada[l], b_ada[l])
        hp = rmsnorm(xp, g_pre[l]) * (1.0 + sc_p) + sh_p
        hs = rmsnorm(xs, g_pre[l]) * (1.0 + sc_s) + sh_s
        if l % 2 == 0:
            yp, (ka, va, ckv, kpe) = even_context(hp, w_in_even[i], w_out_even[i], mla_g_q[i], mla_w_uq[i],
                                                  mla_g_kv[i], mla_w_ukv[i])
            na_k.append(ka)
            na_v.append(va)
            mla_ckv.append(ckv)
            mla_kpe.append(kpe)
            ys = even_latent(hs, cache_na_k[:, i], cache_na_v[:, i], cache_mla_ckv[:, i], cache_mla_kpe[:, i],
                             rows, cols, w_in_even[i], w_out_even[i], na_rpb[i], mla_g_q[i], mla_w_uq[i],
                             mla_g_kv[i], mla_w_ukv[i])
        else:
            lam_init = 0.8 - 0.6 * math.exp(-0.3 * l)
            yp, (kd, vd) = odd_context(hp, w_in_odd[i], w_out_odd[i], diff_lambda[i], diff_g[i], lam_init)
            diff_k.append(kd)
            diff_v.append(vd)
            ys = odd_latent(hs, cache_diff_k[:, i], cache_diff_v[:, i], rows, cols, w_in_odd[i], w_out_odd[i],
                            diff_lambda[i], diff_g[i], lam_init)
        xp = xp + gt_p * rmsnorm(yp, g_post[l])
        xs = xs + gt_s * rmsnorm(ys, g_post[l])
    return (xp, xs, jnp.stack(na_k, axis=1), jnp.stack(na_v, axis=1), jnp.stack(mla_ckv, axis=1),
            jnp.stack(mla_kpe, axis=1), jnp.stack(diff_k, axis=1), jnp.stack(diff_v, axis=1))
```

```cpp
#include <hip/hip_runtime.h>
#include <hip/hip_cooperative_groups.h>
#include <cstdio>
#include <cstdint>
namespace cg = cooperative_groups;

#define DI __device__ __forceinline__
typedef unsigned short bfu;
using bf16x8 = __attribute__((ext_vector_type(8))) short;
using s16x4  = __attribute__((ext_vector_type(4))) short;
using f32x16 = __attribute__((ext_vector_type(16))) float;
using f32x4  = __attribute__((ext_vector_type(4))) float;
using u32x4  = __attribute__((ext_vector_type(4))) unsigned;
using u32x2  = __attribute__((ext_vector_type(2))) unsigned;
typedef __bf16 bf2_t __attribute__((ext_vector_type(2)));
typedef float f2_t __attribute__((ext_vector_type(2)));

constexpr int D = 2048, TP = 8192, TS = 16384, T = 24576, TALL = 28672;
constexpr int EVEN_IN = 5952, ODD_IN = 8192;
constexpr float EPS = 1e-6f;
constexpr float LOG2E = 1.4426950408889634f;
constexpr float LOG2_ROPE = 13.287712379549449f;

constexpr size_t OUT_YP = 0, OUT_YS = 16777216, OUT_NAK = 50331648, OUT_NAV = 67108864, OUT_CKV = 83886080,
                 OUT_KPE = 88080384, OUT_DK = 89128960, OUT_DV = 122683392;

constexpr size_t al256(size_t x) { return (x + 255) / 256 * 256; }
constexpr size_t WS_WT_IN_E = 0;
constexpr size_t WS_WT_IN_O = WS_WT_IN_E + al256((size_t)2 * EVEN_IN * D * 2);
constexpr size_t WS_WT_OUT_E = WS_WT_IN_O + al256((size_t)2 * ODD_IN * D * 2);
constexpr size_t WS_WT_OUT_O = WS_WT_OUT_E + al256((size_t)2 * D * D * 2);
constexpr size_t WS_WT_UQ = WS_WT_OUT_O + al256((size_t)2 * D * D * 2);
constexpr size_t WS_WT_UKV = WS_WT_UQ + al256((size_t)2 * 1536 * 512 * 2);
constexpr size_t WS_C_NAK = WS_WT_UKV + al256((size_t)2 * 2048 * 256 * 2);
constexpr size_t WS_C_NAV = WS_C_NAK + al256((size_t)8 * 2 * 512 * 1024 * 2);
constexpr size_t WS_C_DK = WS_C_NAV + al256((size_t)8 * 2 * 512 * 1024 * 2);
constexpr size_t WS_C_DV = WS_C_DK + al256((size_t)8 * 2 * 512 * 2048 * 2);
constexpr size_t WS_MODP = WS_C_DV + al256((size_t)8 * 2 * 512 * 2048 * 2);
constexpr size_t WS_HBUF = WS_MODP + al256((size_t)4 * 4 * 9 * 6144 * 4);
constexpr size_t WS_CQN = WS_HBUF;
constexpr size_t WS_CKVN = WS_HBUF + al256((size_t)T * 512 * 2);
constexpr size_t WS_PBUF = WS_HBUF + al256((size_t)T * D * 2);
constexpr size_t WS_YBUF = WS_PBUF;
constexpr size_t WS_QM = WS_PBUF + al256((size_t)T * EVEN_IN * 2);
constexpr size_t WS_KMLA = WS_QM + al256((size_t)T * 1536 * 2);
constexpr size_t WS_VMLA = WS_KMLA + al256((size_t)TALL * 1536 * 2);
constexpr size_t WS_END_EVEN = WS_VMLA + al256((size_t)TALL * 1024 * 2);
constexpr size_t WS_SCR = WS_PBUF + al256((size_t)T * ODD_IN * 2);
constexpr size_t WS_END_ODD = WS_SCR + (size_t)1024 * 131072;
constexpr size_t WS_NEED = WS_END_EVEN > WS_END_ODD ? WS_END_EVEN : WS_END_ODD;

struct Params {
  const float* in[25];
  float* out;
  char* ws;
  int lo, hi;
};

DI unsigned cvtpk(float lo, float hi) {
  f2_t v = {lo, hi};
  bf2_t b = __builtin_convertvector(v, bf2_t);
  return __builtin_bit_cast(unsigned, b);
}
DI bfu f2bf(float x) { return (bfu)(cvtpk(x, 0.f) & 0xffffu); }
DI float bf2f(bfu b) { return __uint_as_float(((unsigned)b) << 16); }
DI float bflo(unsigned u) { return __uint_as_float(u << 16); }
DI float bfhi(unsigned u) { return __uint_as_float(u & 0xffff0000u); }
DI int opaque(int x) { asm volatile("" : "+v"(x)); return x; }
DI int crow(int r, int hi) { return (r & 3) + 8 * (r >> 2) + 4 * hi; }
DI float silu(float x) { return x / (1.f + __expf(-x)); }
DI f32x16 mfma(bf16x8 a, bf16x8 b, f32x16 c) { return __builtin_amdgcn_mfma_f32_32x32x16_bf16(a, b, c, 0, 0, 0); }
DI float wave_sum(float v) {
#pragma unroll
  for (int o = 32; o >= 1; o >>= 1) v += __shfl_xor(v, o);
  return v;
}
DI float block_sum(float v, float* red) {
  v = wave_sum(v);
  __syncthreads();
  if ((threadIdx.x & 63) == 0) red[threadIdx.x >> 6] = v;
  __syncthreads();
  return red[0] + red[1] + red[2] + red[3];
}
DI float modval(const Params& p, int l, int r, int n) {
  const float* mp = (const float*)(p.ws + WS_MODP);
  float s = p.in[11][l * 6144 + n];
#pragma unroll
  for (int ks = 0; ks < 4; ++ks) s += mp[((size_t)(ks * 4 + l) * 9 + r) * 6144 + n];
  return s;
}

DI void prep_mod_item(const Params& p, int item, char* lds) {
  const int tid = opaque(threadIdx.x), lane = tid & 63, wid = tid >> 6;
  const int ks = item & 3, cgp = (item >> 2) % 24, l = item / 96;
  float* scond = (float*)lds;
  float* red = (float*)(lds + 18432);
  for (int idx = tid; idx < 9 * 512; idx += 256) {
    int r = idx >> 9, kk = idx & 511;
    float cv = r < 8 ? p.in[8][r * 2048 + ks * 512 + kk] : p.in[9][ks * 512 + kk];
    scond[idx] = silu(cv);
  }
  __syncthreads();
  const float* W = p.in[10] + ((size_t)l * 2048 + ks * 512 + wid * 128) * 6144 + cgp * 256 + lane * 4;
  float acc[9][4];
#pragma unroll
  for (int r = 0; r < 9; ++r) { acc[r][0] = 0; acc[r][1] = 0; acc[r][2] = 0; acc[r][3] = 0; }
  for (int kk = 0; kk < 128; kk += 4) {
    f32x4 w[4];
#pragma unroll
    for (int u = 0; u < 4; ++u) w[u] = *(const f32x4*)(W + (size_t)(kk + u) * 6144);
#pragma unroll
    for (int u = 0; u < 4; ++u) {
#pragma unroll
      for (int r = 0; r < 9; ++r) {
        float s = scond[r * 512 + wid * 128 + kk + u];
        acc[r][0] += s * w[u][0]; acc[r][1] += s * w[u][1]; acc[r][2] += s * w[u][2]; acc[r][3] += s * w[u][3];
      }
    }
  }
#pragma unroll
  for (int r = 0; r < 9; ++r) {
    f32x4 v = {acc[r][0], acc[r][1], acc[r][2], acc[r][3]};
    *(f32x4*)(red + (wid * 9 + r) * 256 + lane * 4) = v;
  }
  __syncthreads();
  float* mp = (float*)(p.ws + WS_MODP);
  for (int idx = tid; idx < 9 * 256; idx += 256) {
    int r = idx >> 8, cc = idx & 255;
    float s = red[(0 * 9 + r) * 256 + cc] + red[(1 * 9 + r) * 256 + cc] + red[(2 * 9 + r) * 256 + cc] + red[(3 * 9 + r) * 256 + cc];
    mp[((size_t)(ks * 4 + l) * 9 + r) * 6144 + cgp * 256 + cc] = s;
  }
  __syncthreads();
}

DI void prep_transpose_tile(const float* __restrict__ src, bfu* __restrict__ dst, int K, int N, int k0, int n0, char* lds) {
  float* tl = (float*)lds;
  const int tid = opaque(threadIdx.x);
#pragma unroll
  for (int i = 0; i < 4; ++i) {
    int kr = (tid >> 4) + 16 * i, nc = (tid & 15) * 4;
    f32x4 v = *(const f32x4*)(src + (size_t)(k0 + kr) * N + n0 + nc);
    tl[kr * 65 + nc + 0] = v[0]; tl[kr * 65 + nc + 1] = v[1]; tl[kr * 65 + nc + 2] = v[2]; tl[kr * 65 + nc + 3] = v[3];
  }
  __syncthreads();
  {
    int n = tid >> 2, kseg = (tid & 3) * 16;
    unsigned w[8];
#pragma unroll
    for (int e = 0; e < 8; ++e) w[e] = cvtpk(tl[(kseg + 2 * e) * 65 + n], tl[(kseg + 2 * e + 1) * 65 + n]);
    u32x4 a = {w[0], w[1], w[2], w[3]}, b = {w[4], w[5], w[6], w[7]};
    bfu* d = dst + (size_t)(n0 + n) * K + k0 + kseg;
    *(u32x4*)d = a; *(u32x4*)(d + 8) = b;
  }
  __syncthreads();
}

DI void phase_prep(const Params& p, char* lds) {
  constexpr int N_MOD = 384, N_TR_L = 9440, N_TR = 2 * N_TR_L, N_CV = 3072;
  for (int item = blockIdx.x; item < N_MOD + N_TR + N_CV; item += gridDim.x) {
    if (item < N_MOD) { prep_mod_item(p, item, lds); continue; }
    int it = item - N_MOD;
    if (it < N_TR) {
      int i = it / N_TR_L, r = it % N_TR_L;
      const float* src; bfu* dst; int K, N;
      if (r < 2976) { src = p.in[14] + (size_t)i * 2048 * EVEN_IN; dst = (bfu*)(p.ws + WS_WT_IN_E) + (size_t)i * EVEN_IN * 2048; K = 2048; N = EVEN_IN; }
      else if ((r -= 2976) < 1024) { src = p.in[15] + (size_t)i * 2048 * 2048; dst = (bfu*)(p.ws + WS_WT_OUT_E) + (size_t)i * 2048 * 2048; K = 2048; N = 2048; }
      else if ((r -= 1024) < 192) { src = p.in[18] + (size_t)i * 512 * 1536; dst = (bfu*)(p.ws + WS_WT_UQ) + (size_t)i * 1536 * 512; K = 512; N = 1536; }
      else if ((r -= 192) < 128) { src = p.in[20] + (size_t)i * 256 * 2048; dst = (bfu*)(p.ws + WS_WT_UKV) + (size_t)i * 2048 * 256; K = 256; N = 2048; }
      else if ((r -= 128) < 4096) { src = p.in[21] + (size_t)i * 2048 * ODD_IN; dst = (bfu*)(p.ws + WS_WT_IN_O) + (size_t)i * ODD_IN * 2048; K = 2048; N = ODD_IN; }
      else { r -= 4096; src = p.in[22] + (size_t)i * 2048 * 2048; dst = (bfu*)(p.ws + WS_WT_OUT_O) + (size_t)i * 2048 * 2048; K = 2048; N = 2048; }
      int nN = N / 64;
      int kt = r / nN, nt = r % nN;
      prep_transpose_tile(src, dst, K, N, kt * 64, nt * 64, lds);
      continue;
    }
    it -= N_TR;
    {
      const int tidc = opaque(threadIdx.x);
      size_t ch = (size_t)it * 2048;
      const float* src; bfu* dst;
      if (ch < 1048576) { src = p.in[2]; dst = (bfu*)(p.ws + WS_C_NAK); }
      else if ((ch -= 1048576) < 1048576) { src = p.in[3]; dst = (bfu*)(p.ws + WS_C_NAV); }
      else if ((ch -= 1048576) < 2097152) { src = p.in[6]; dst = (bfu*)(p.ws + WS_C_DK); }
      else { ch -= 2097152; src = p.in[7]; dst = (bfu*)(p.ws + WS_C_DV); }
#pragma unroll
      for (int u = 0; u < 8; ++u) {
        size_t c = ch + u * 256 + tidc;
        f32x4 a = *(const f32x4*)(src + c * 8), b = *(const f32x4*)(src + c * 8 + 4);
        u32x4 w = {cvtpk(a[0], a[1]), cvtpk(a[2], a[3]), cvtpk(b[0], b[1]), cvtpk(b[2], b[3])};
        *(u32x4*)(dst + c * 8) = w;
      }
    }
  }
}

DI void phase_rows(const Params& p, int kind, int l, char* lds) {
  float* red = (float*)lds;
  const int tid = opaque(threadIdx.x), col = tid * 8;
  const int rows_per = (T + gridDim.x - 1) / gridDim.x;
  const int t_begin = blockIdx.x * rows_per;
  const int t_end = min(T, t_begin + rows_per);
  const int ln = kind == 0 ? 0 : l + 1;
  const bool do_h = ln < 4;
  int cur_r = -1;
  float sc[8], sh[8], gp[8], gate[8], gpo[8];
  bfu* hbuf = (bfu*)(p.ws + WS_HBUF);
  const float* ybuf = (const float*)(p.ws + WS_YBUF);
  for (int t = t_begin; t < t_end; ++t) {
    const int r = t < TP ? 8 : (t - TP) >> 11;
    if (r != cur_r) {
      cur_r = r;
#pragma unroll
      for (int e = 0; e < 8; ++e) {
        if (do_h) {
          sh[e] = modval(p, ln, r, col + e);
          sc[e] = 1.f + modval(p, ln, r, 2048 + col + e);
          gp[e] = p.in[12][ln * 2048 + col + e];
        }
        if (kind == 1) {
          gate[e] = modval(p, l, r, 4096 + col + e);
          gpo[e] = p.in[13][l * 2048 + col + e];
        }
      }
    }
    const float* xin = (kind == 0 || l == 0) ? (t < TP ? p.in[0] + (size_t)t * D : p.in[1] + (size_t)(t - TP) * D) : p.out + (size_t)t * D;
    float x[8];
    { f32x4 a = *(const f32x4*)(xin + col), b = *(const f32x4*)(xin + col + 4);
      x[0] = a[0]; x[1] = a[1]; x[2] = a[2]; x[3] = a[3]; x[4] = b[0]; x[5] = b[1]; x[6] = b[2]; x[7] = b[3]; }
    if (kind == 1) {
      float y[8];
      { f32x4 a = *(const f32x4*)(ybuf + (size_t)t * D + col), b = *(const f32x4*)(ybuf + (size_t)t * D + col + 4);
        y[0] = a[0]; y[1] = a[1]; y[2] = a[2]; y[3] = a[3]; y[4] = b[0]; y[5] = b[1]; y[6] = b[2]; y[7] = b[3]; }
      float ss = 0;
#pragma unroll
      for (int e = 0; e < 8; ++e) ss += y[e] * y[e];
      ss = block_sum(ss, red);
      float rstd = rsqrtf(ss * (1.f / 2048.f) + EPS);
#pragma unroll
      for (int e = 0; e < 8; ++e) x[e] = x[e] + gate[e] * (y[e] * rstd * gpo[e]);
      f32x4 a = {x[0], x[1], x[2], x[3]}, b = {x[4], x[5], x[6], x[7]};
      *(f32x4*)(p.out + (size_t)t * D + col) = a; *(f32x4*)(p.out + (size_t)t * D + col + 4) = b;
    }
    if (do_h) {
      float ss = 0;
#pragma unroll
      for (int e = 0; e < 8; ++e) ss += x[e] * x[e];
      ss = block_sum(ss, red);
      float rstd = rsqrtf(ss * (1.f / 2048.f) + EPS);
      float h[8];
#pragma unroll
      for (int e = 0; e < 8; ++e) h[e] = x[e] * rstd * gp[e] * sc[e] + sh[e];
      u32x4 w = {cvtpk(h[0], h[1]), cvtpk(h[2], h[3]), cvtpk(h[4], h[5]), cvtpk(h[6], h[7])};
      *(u32x4*)(hbuf + (size_t)t * D + col) = w;
    }
  }
}

constexpr int G_ROW = 144;
constexpr int G_TILE = 128 * G_ROW;
enum { EPI_E1 = 0, EPI_O1 = 1, EPI_QM = 2, EPI_KV = 3, EPI_Y = 4 };

template <int EPI>
DI void gemm_tile(const Params& p, const bfu* __restrict__ A, int lda, const bfu* __restrict__ Bt, int ldb, int K,
                  int m0, int n0, int li, char* lds) {
  const int tid = opaque(threadIdx.x), lane = tid & 63, wid = tid >> 6, wm = wid >> 1, wn = wid & 1, r32 = lane & 31, hh = lane >> 5;
  f32x16 acc[2][2];
#pragma unroll
  for (int a = 0; a < 2; ++a)
#pragma unroll
    for (int b = 0; b < 2; ++b)
#pragma unroll
      for (int r = 0; r < 16; ++r) acc[a][b][r] = 0.f;
  const int lr = tid >> 3, lc = (tid & 7) * 8;
  const bfu* Ap = A + (size_t)(m0 + lr) * lda + lc;
  const bfu* Bp = Bt + (size_t)(n0 + lr) * ldb + lc;
  bf16x8 ra[4], rb[4];
#pragma unroll
  for (int i = 0; i < 4; ++i) { ra[i] = *(const bf16x8*)(Ap + (size_t)i * 32 * lda); rb[i] = *(const bf16x8*)(Bp + (size_t)i * 32 * ldb); }
  const int nk = K >> 6;
  const int wofs = lr * G_ROW + lc * 2;
  for (int kt = 0; kt < nk; ++kt) {
    char* bufA = lds + (kt & 1) * (2 * G_TILE);
    char* bufB = bufA + G_TILE;
#pragma unroll
    for (int i = 0; i < 4; ++i) { *(bf16x8*)(bufA + wofs + i * 32 * G_ROW) = ra[i]; *(bf16x8*)(bufB + wofs + i * 32 * G_ROW) = rb[i]; }
    __syncthreads();
    if (kt + 1 < nk) {
#pragma unroll
      for (int i = 0; i < 4; ++i) { ra[i] = *(const bf16x8*)(Ap + (size_t)i * 32 * lda + (kt + 1) * 64); rb[i] = *(const bf16x8*)(Bp + (size_t)i * 32 * ldb + (kt + 1) * 64); }
    }
    const char* pa = bufA + (wm * 64 + r32) * G_ROW + hh * 16;
    const char* pb = bufB + (wn * 64 + r32) * G_ROW + hh * 16;
#pragma unroll
    for (int ks = 0; ks < 4; ++ks) {
      bf16x8 a0 = *(const bf16x8*)(pa + ks * 32), a1 = *(const bf16x8*)(pa + 32 * G_ROW + ks * 32);
      bf16x8 b0 = *(const bf16x8*)(pb + ks * 32), b1 = *(const bf16x8*)(pb + 32 * G_ROW + ks * 32);
      acc[0][0] = mfma(a0, b0, acc[0][0]); acc[0][1] = mfma(a0, b1, acc[0][1]);
      acc[1][0] = mfma(a1, b0, acc[1][0]); acc[1][1] = mfma(a1, b1, acc[1][1]);
    }
  }
  __syncthreads();

  const int rowb = m0 + wm * 64, colb = n0 + wn * 64;
  if constexpr (EPI == EPI_O1) {
    if (m0 >= TP && n0 < 4096) {
      const float inv = exp2f(-(float)r32 * (LOG2_ROPE / 32.f));
#pragma unroll
      for (int mt = 0; mt < 2; ++mt)
#pragma unroll
        for (int r = 0; r < 16; ++r) {
          int row = rowb + mt * 32 + crow(r, hh);
          int s = (row - TP) & 2047;
          float pos = (float)(wn == 0 ? (s >> 6) : (s & 63));
          float ang = pos * inv;
          float cs = __cosf(ang), sn = __sinf(ang);
          float x1 = acc[mt][0][r], x2 = acc[mt][1][r];
          acc[mt][0][r] = x1 * cs - x2 * sn;
          acc[mt][1][r] = x2 * cs + x1 * sn;
        }
    }
  }
#pragma unroll
  for (int mt = 0; mt < 2; ++mt)
#pragma unroll
    for (int nt = 0; nt < 2; ++nt) {
      const int col = colb + nt * 32 + r32;
      const int colg = colb + nt * 32;
#pragma unroll
      for (int r = 0; r < 16; ++r) {
        const int row = rowb + mt * 32 + crow(r, hh);
        const float v = acc[mt][nt][r];
        if constexpr (EPI == EPI_E1) {
          if (colg < EVEN_IN) {
            ((bfu*)(p.ws + WS_PBUF))[(size_t)row * EVEN_IN + col] = f2bf(v);
            if (m0 < TP) {
              size_t orow = (size_t)((row >> 8) * 2 + li) * 256 + (row & 255);
              if (colg >= 1024 && colg < 2048) p.out[OUT_NAK + orow * 1024 + (col - 1024)] = v;
              else if (colg >= 2048 && colg < 3072) p.out[OUT_NAV + orow * 1024 + (col - 2048)] = v;
              else if (colg >= 4864 && colg < 4928) p.out[OUT_KPE + orow * 64 + (col - 4864)] = v;
            }
          }
        } else if constexpr (EPI == EPI_O1) {
          ((bfu*)(p.ws + WS_PBUF))[(size_t)row * ODD_IN + col] = f2bf(v);
          if (m0 < TP) {
            size_t orow = (size_t)((row >> 8) * 2 + li) * 256 + (row & 255);
            if (colg >= 2048 && colg < 4096) p.out[OUT_DK + orow * 2048 + (col - 2048)] = v;
            else if (colg >= 4096 && colg < 6144) p.out[OUT_DV + orow * 2048 + (col - 4096)] = v;
          }
        } else if constexpr (EPI == EPI_QM) {
          ((bfu*)(p.ws + WS_QM))[(size_t)row * 1536 + col] = f2bf(v);
        } else if constexpr (EPI == EPI_KV) {
          int hd = col >> 8, j = col & 255;
          if (j < 128) ((bfu*)(p.ws + WS_KMLA))[(size_t)row * 1536 + hd * 192 + j] = f2bf(v);
          else ((bfu*)(p.ws + WS_VMLA))[(size_t)row * 1024 + hd * 128 + (j - 128)] = f2bf(v);
        } else {
          ((float*)(p.ws + WS_YBUF))[(size_t)row * D + col] = v;
        }
      }
    }
}

DI void tile_mn(int id, int nN, int& m, int& n) {
  int grp = id / (8 * nN), rem = id % (8 * nN);
  m = grp * 8 + (rem & 7); n = rem >> 3;
}

DI void phase_mid(const Params& p, int li) {
  const int tid = opaque(threadIdx.x), lane = tid & 63, wid = tid >> 6;
  const bfu* P = (const bfu*)(p.ws + WS_PBUF);
  bfu* cqn = (bfu*)(p.ws + WS_CQN);
  bfu* ckvn = (bfu*)(p.ws + WS_CKVN);
  bfu* kmla = (bfu*)(p.ws + WS_KMLA);
  const float* gq = p.in[17] + li * 512;
  const float* gkv = p.in[19] + li * 256;
  for (int t = blockIdx.x * 4 + wid; t < TALL; t += gridDim.x * 4) {
    float kp;
    if (t < T) {
      const bfu* Pr = P + (size_t)t * EVEN_IN;
      {
        u32x4 w = *(const u32x4*)(Pr + 4096 + lane * 8);
        float v[8] = {bflo(w[0]), bfhi(w[0]), bflo(w[1]), bfhi(w[1]), bflo(w[2]), bfhi(w[2]), bflo(w[3]), bfhi(w[3])};
        float ss = 0;
#pragma unroll
        for (int e = 0; e < 8; ++e) ss += v[e] * v[e];
        ss = wave_sum(ss);
        float rstd = rsqrtf(ss * (1.f / 512.f) + EPS);
#pragma unroll
        for (int e = 0; e < 8; ++e) v[e] = v[e] * rstd * gq[lane * 8 + e];
        u32x4 o = {cvtpk(v[0], v[1]), cvtpk(v[2], v[3]), cvtpk(v[4], v[5]), cvtpk(v[6], v[7])};
        *(u32x4*)(cqn + (size_t)t * 512 + lane * 8) = o;
      }
      {
        u32x2 w = *(const u32x2*)(Pr + 4608 + lane * 4);
        float v[4] = {bflo(w[0]), bfhi(w[0]), bflo(w[1]), bfhi(w[1])};
        float ss = v[0] * v[0] + v[1] * v[1] + v[2] * v[2] + v[3] * v[3];
        ss = wave_sum(ss);
        float rstd = rsqrtf(ss * (1.f / 256.f) + EPS);
#pragma unroll
        for (int e = 0; e < 4; ++e) v[e] = v[e] * rstd * gkv[lane * 4 + e];
        u32x2 o = {cvtpk(v[0], v[1]), cvtpk(v[2], v[3])};
        *(u32x2*)(ckvn + (size_t)t * 256 + lane * 4) = o;
        if (t < TP) {
          size_t orow = (size_t)((t >> 8) * 2 + li) * 256 + (t & 255);
          f32x4 f = {v[0], v[1], v[2], v[3]};
          *(f32x4*)(p.out + OUT_CKV + orow * 256 + lane * 4) = f;
        }
      }
      kp = bf2f(Pr[4864 + lane]);
      if (t >= TP) {
        int s = (t - TP) & 2047;
        float pos = (float)(lane < 32 ? (s >> 6) : (s & 63));
        int jj = lane & 15;
        float inv = exp2f(-(float)jj * (LOG2_ROPE / 16.f));
        float ang = pos * inv;
        float cs = __cosf(ang), sn = __sinf(ang);
        float pv = __shfl_xor(kp, 16);
        kp = (lane & 16) ? (kp * cs + pv * sn) : (kp * cs - pv * sn);
      }
    } else {
      int ci = t - T;
      int b = ci >> 9, j = ci & 511;
      size_t crow_ = (size_t)(b * 2 + li) * 512 + j;
      f32x4 f = *(const f32x4*)(p.in[4] + crow_ * 256 + lane * 4);
      u32x2 o = {cvtpk(f[0], f[1]), cvtpk(f[2], f[3])};
      *(u32x2*)(ckvn + (size_t)t * 256 + lane * 4) = o;
      kp = p.in[5][crow_ * 64 + lane];
    }
    bfu kb = f2bf(kp);
#pragma unroll
    for (int hd = 0; hd < 8; ++hd) kmla[(size_t)t * 1536 + hd * 192 + 128 + lane] = kb;
  }
}

struct Seg { const bfu* K; const bfu* V; int ldk, ldv, n; };
constexpr int ATT_V_OFF = 25600, ATT_BIAS_OFF = 25600 + 20480;
constexpr int ATT_TR_ROW = 132;

template <int DQK, bool NA, bool ROPEQ>
DI void attn_core(const int tid, f32x16* o, const bfu* __restrict__ Qrow, const Seg& s0, const Seg& s1, float C, char* lds,
                  int gr, int gc, int kr0, float prow, float pcol) {
  constexpr int KROW = DQK * 2 + 16, VROW = 320;
  constexpr int ND = DQK / 16;
  const int lane = tid & 63, r32 = lane & 31, hh = lane >> 5;
  char* Ksm = lds; char* Vsm = lds + ATT_V_OFF;
  const float* sbias = (const float*)(lds + ATT_BIAS_OFF);
  bf16x8 qr[ND];
#pragma unroll
  for (int d0 = 0; d0 < ND; ++d0) qr[d0] = *(const bf16x8*)(Qrow + d0 * 16);
  if constexpr (ROPEQ) {
#pragma unroll
    for (int pr = 0; pr < 2; ++pr) {
      float pos = pr == 0 ? prow : pcol;
      bf16x8 a = qr[8 + 2 * pr], b = qr[9 + 2 * pr];
      float xa[8], xb[8];
#pragma unroll
      for (int e = 0; e < 8; ++e) {
        float inv = exp2f(-(float)(8 * hh + e) * (LOG2_ROPE / 16.f));
        float ang = pos * inv;
        float cs = __cosf(ang), sn = __sinf(ang);
        float x1 = bf2f((bfu)a[e]), x2 = bf2f((bfu)b[e]);
        xa[e] = x1 * cs - x2 * sn; xb[e] = x2 * cs + x1 * sn;
      }
      u32x4 wa = {cvtpk(xa[0], xa[1]), cvtpk(xa[2], xa[3]), cvtpk(xa[4], xa[5]), cvtpk(xa[6], xa[7])};
      u32x4 wb = {cvtpk(xb[0], xb[1]), cvtpk(xb[2], xb[3]), cvtpk(xb[4], xb[5]), cvtpk(xb[6], xb[7])};
      qr[8 + 2 * pr] = __builtin_bit_cast(bf16x8, wa); qr[9 + 2 * pr] = __builtin_bit_cast(bf16x8, wb);
    }
  }
#pragma unroll
  for (int d = 0; d < 4; ++d)
#pragma unroll
    for (int r = 0; r < 16; ++r) o[d][r] = 0.f;
  float m = -1e30f, l = 0.f;
  const int nt0 = s0.n >> 6, ntile = nt0 + (s1.n >> 6);
  const int rs = min(max(gr - 4, 0), 24), cs_ = min(max(gc - 8, 0), 48);
  const int vbase = ((hh * 4 + ((lane & 15) >> 2)) * VROW) + (16 * ((lane >> 4) & 1) + 4 * (lane & 3)) * 2;
  for (int j = 0; j < ntile; ++j) {
    const bool in0 = j < nt0;
    const bfu* Kp = in0 ? s0.K + (size_t)(j * 64) * s0.ldk : s1.K + (size_t)((j - nt0) * 64) * s1.ldk;
    const bfu* Vp = in0 ? s0.V + (size_t)(j * 64) * s0.ldv : s1.V + (size_t)((j - nt0) * 64) * s1.ldv;
    const int ldk = in0 ? s0.ldk : s1.ldk, ldv = in0 ? s0.ldv : s1.ldv;
    __syncthreads();
    __builtin_amdgcn_sched_barrier(0);
#pragma unroll
    for (int hb = 0; hb < DQK / 64; ++hb) {
      bf16x8 kv[2];
#pragma unroll
      for (int i = 0; i < 2; ++i) {
        int c = tid + 256 * (hb * 2 + i), key = c / (DQK / 8), cc = c % (DQK / 8);
        kv[i] = *(const bf16x8*)(Kp + (size_t)key * ldk + cc * 8);
      }
#pragma unroll
      for (int i = 0; i < 2; ++i) {
        int c = tid + 256 * (hb * 2 + i), key = c / (DQK / 8), cc = c % (DQK / 8);
        *(bf16x8*)(Ksm + key * KROW + cc * 16) = kv[i];
      }
      __builtin_amdgcn_sched_barrier(0);
    }
#pragma unroll
    for (int hb = 0; hb < 2; ++hb) {
      bf16x8 vv[2];
#pragma unroll
      for (int i = 0; i < 2; ++i) {
        int c = tid + 256 * (hb * 2 + i), key = c >> 4, cc = c & 15;
        vv[i] = *(const bf16x8*)(Vp + (size_t)key * ldv + cc * 8);
      }
#pragma unroll
      for (int i = 0; i < 2; ++i) {
        int c = tid + 256 * (hb * 2 + i), key = c >> 4, cc = c & 15;
        *(bf16x8*)(Vsm + key * VROW + cc * 16) = vv[i];
      }
      __builtin_amdgcn_sched_barrier(0);
    }
    __syncthreads();
    f32x16 p0, p1;
#pragma unroll
    for (int r = 0; r < 16; ++r) { p0[r] = 0.f; p1[r] = 0.f; }
#pragma unroll
    for (int d0 = 0; d0 < ND; ++d0) {
      bf16x8 k0 = *(const bf16x8*)(Ksm + r32 * KROW + d0 * 32 + hh * 16);
      bf16x8 k1 = *(const bf16x8*)(Ksm + (32 + r32) * KROW + d0 * 32 + hh * 16);
      p0 = mfma(k0, qr[d0], p0);
      p1 = mfma(k1, qr[d0], p1);
    }
    if (NA && !in0) {
      const int kr = kr0 + (j - nt0);
      const bool rowok = (kr >= rs) && (kr < rs + 8);
      const int brow = (kr - gr + 7) * 31 - gc + 15;
#pragma unroll
      for (int r = 0; r < 16; ++r) {
        int kc0 = crow(r, hh), kc1 = 32 + kc0;
        bool ok0 = rowok && (kc0 >= cs_) && (kc0 < cs_ + 16);
        bool ok1 = rowok && (kc1 >= cs_) && (kc1 < cs_ + 16);
        float b0 = sbias[ok0 ? brow + kc0 : 0], b1 = sbias[ok1 ? brow + kc1 : 0];
        p0[r] = ok0 ? p0[r] * C + b0 : -1e30f;
        p1[r] = ok1 ? p1[r] * C + b1 : -1e30f;
      }
    } else {
#pragma unroll
      for (int r = 0; r < 16; ++r) { p0[r] *= C; p1[r] *= C; }
    }
    float mx = p0[0];
#pragma unroll
    for (int r = 1; r < 16; ++r) mx = fmaxf(mx, p0[r]);
#pragma unroll
    for (int r = 0; r < 16; ++r) mx = fmaxf(mx, p1[r]);
    mx = fmaxf(mx, __shfl_xor(mx, 32));
    const float mn = fmaxf(m, mx);
    const float alpha = __builtin_amdgcn_exp2f(m - mn);
    m = mn;
    float ps = 0.f;
#pragma unroll
    for (int r = 0; r < 16; ++r) { p0[r] = __builtin_amdgcn_exp2f(p0[r] - mn); ps += p0[r]; }
#pragma unroll
    for (int r = 0; r < 16; ++r) { p1[r] = __builtin_amdgcn_exp2f(p1[r] - mn); ps += p1[r]; }
    ps += __shfl_xor(ps, 32);
    l = l * alpha + ps;
#pragma unroll
    for (int d = 0; d < 4; ++d)
#pragma unroll
      for (int r = 0; r < 16; ++r) o[d][r] *= alpha;
    bf16x8 pa[4];
    {
      u32x4 w0 = {cvtpk(p0[0], p0[1]), cvtpk(p0[2], p0[3]), cvtpk(p0[4], p0[5]), cvtpk(p0[6], p0[7])};
      u32x4 w1 = {cvtpk(p0[8], p0[9]), cvtpk(p0[10], p0[11]), cvtpk(p0[12], p0[13]), cvtpk(p0[14], p0[15])};
      u32x4 w2 = {cvtpk(p1[0], p1[1]), cvtpk(p1[2], p1[3]), cvtpk(p1[4], p1[5]), cvtpk(p1[6], p1[7])};
      u32x4 w3 = {cvtpk(p1[8], p1[9]), cvtpk(p1[10], p1[11]), cvtpk(p1[12], p1[13]), cvtpk(p1[14], p1[15])};
      pa[0] = __builtin_bit_cast(bf16x8, w0); pa[1] = __builtin_bit_cast(bf16x8, w1);
      pa[2] = __builtin_bit_cast(bf16x8, w2); pa[3] = __builtin_bit_cast(bf16x8, w3);
    }
#pragma unroll
    for (int d = 0; d < 4; ++d) {
#pragma unroll
      for (int s = 0; s < 4; ++s) {
        const int offlo = (16 * s) * VROW + d * 64, offhi = (16 * s + 8) * VROW + d * 64;
        s16x4 lo = __builtin_amdgcn_ds_read_tr16_b64_v4i16((s16x4 __attribute__((address_space(3)))*)(Vsm + vbase + offlo));
        s16x4 hi = __builtin_amdgcn_ds_read_tr16_b64_v4i16((s16x4 __attribute__((address_space(3)))*)(Vsm + vbase + offhi));
        bf16x8 vb = {lo[0], lo[1], lo[2], lo[3], hi[0], hi[1], hi[2], hi[3]};
        o[d] = mfma(vb, pa[s], o[d]);
      }
    }
  }
  const float linv = 1.f / l;
#pragma unroll
  for (int d = 0; d < 4; ++d)
#pragma unroll
    for (int r = 0; r < 16; ++r) o[d][r] *= linv;
}

DI float* tr_stage(const int tid, const f32x16* o, char* lds) {
  const int lane = tid & 63, wid = tid >> 6, r32 = lane & 31, hh = lane >> 5;
  float* tr = (float*)lds + wid * (32 * ATT_TR_ROW);
  __syncthreads();
#pragma unroll
  for (int d = 0; d < 4; ++d)
#pragma unroll
    for (int g = 0; g < 4; ++g) {
      f32x4 v = {o[d][4 * g], o[d][4 * g + 1], o[d][4 * g + 2], o[d][4 * g + 3]};
      *(f32x4*)(tr + r32 * ATT_TR_ROW + d * 32 + 8 * g + 4 * hh) = v;
    }
  return tr;
}

DI void store_gated(const int tid, const Params& p, const f32x16* o, int t0, int gcol, int ocol, char* lds) {
  const int lane = tid & 63, wid = tid >> 6;
  const bfu* P = (const bfu*)(p.ws + WS_PBUF);
  bfu* O = (bfu*)(p.ws + WS_HBUF);
  const float* tr = tr_stage(tid, o, lds);
  for (int rr = 0; rr < 32; ++rr) {
    size_t t = (size_t)(t0 + wid * 32 + rr);
    f2_t v = *(const f2_t*)(tr + rr * ATT_TR_ROW + lane * 2);
    unsigned g = *(const unsigned*)(P + t * EVEN_IN + gcol + lane * 2);
    *(unsigned*)(O + t * D + ocol + lane * 2) = cvtpk(v[0] * silu(bflo(g)), v[1] * silu(bfhi(g)));
  }
}


DI void phase_attn_even(const Params& p, int li, char* lds) {
  const bfu* P = (const bfu*)(p.ws + WS_PBUF);
  const bfu* Qm = (const bfu*)(p.ws + WS_QM);
  const bfu* Km = (const bfu*)(p.ws + WS_KMLA);
  const bfu* Vm = (const bfu*)(p.ws + WS_VMLA);
  const bfu* cnk = (const bfu*)(p.ws + WS_C_NAK);
  const bfu* cnv = (const bfu*)(p.ws + WS_C_NAV);
  const float CM = 0.07216878364870322f * LOG2E;
  const float CN = 0.08838834764831845f * LOG2E;
  int item = blockIdx.x;
  for (; item < 1024; item += gridDim.x) {
    const int tid = opaque(threadIdx.x), lane = tid & 63, wid = tid >> 6, r32 = lane & 31, hh = lane >> 5;
    f32x16 o[4];
    int b = item >> 7, hd = (item >> 4) & 7, qb = item & 15;
    int t0 = TP + b * 2048 + qb * 128;
    int trow = t0 + wid * 32 + r32;
    int s = qb * 128 + wid * 32 + r32;
    Seg s0 = {Km + (size_t)(T + b * 512) * 1536 + hd * 192, Vm + (size_t)(T + b * 512) * 1024 + hd * 128, 1536, 1024, 512};
    Seg s1 = {Km + (size_t)(TP + b * 2048) * 1536 + hd * 192, Vm + (size_t)(TP + b * 2048) * 1024 + hd * 128, 1536, 1024, 2048};
    attn_core<192, false, true>(tid, o, Qm + (size_t)trow * 1536 + hd * 192 + hh * 8, s0, s1, CM, lds, 0, 0, 0, (float)(s >> 6), (float)(s & 63));
    store_gated(tid, p, o, t0, 4928 + hd * 128, 1024 + hd * 128, lds);
  }
  for (; item < 2048; item += gridDim.x) {
    const int tid = opaque(threadIdx.x), lane = tid & 63, wid = tid >> 6, r32 = lane & 31, hh = lane >> 5;
    f32x16 o[4];
    int it = item - 1024;
    int b = it >> 7, hd = (it >> 4) & 7, qb = it & 15;
    int t0 = TP + b * 2048 + qb * 128;
    int trow = t0 + wid * 32 + r32;
    int qi = wid * 32 + r32;
    int gr = qb * 2 + (qi >> 6), gc = qi & 63;
    int kr0 = min(max(qb * 2 - 4, 0), 24);
    int kr1 = min(max(qb * 2 + 1 - 4, 0), 24) + 8;
    __syncthreads();
    float* sb = (float*)(lds + ATT_BIAS_OFF);
    for (int idx = tid; idx < 465; idx += 256) sb[idx] = p.in[16][(size_t)(li * 8 + hd) * 465 + idx] * LOG2E;
    Seg s0 = {cnk + (size_t)((b * 2 + li) * 512) * 1024 + hd * 128, cnv + (size_t)((b * 2 + li) * 512) * 1024 + hd * 128, 1024, 1024, 512};
    const bfu* Pl = P + (size_t)(TP + b * 2048 + kr0 * 64) * EVEN_IN;
    Seg s1 = {Pl + 1024 + hd * 128, Pl + 2048 + hd * 128, EVEN_IN, EVEN_IN, (kr1 - kr0) * 64};
    attn_core<128, true, false>(tid, o, P + (size_t)trow * EVEN_IN + hd * 128 + hh * 8, s0, s1, CN, lds, gr, gc, kr0, 0.f, 0.f);
    store_gated(tid, p, o, t0, 3072 + hd * 128, hd * 128, lds);
  }
  for (; item < 2560; item += gridDim.x) {
    const int tid = opaque(threadIdx.x), lane = tid & 63, wid = tid >> 6, r32 = lane & 31, hh = lane >> 5;
    f32x16 o[4];
    int it = item - 2048;
    int b = it >> 4, hd = (it >> 1) & 7, qb = it & 1;
    int t0 = b * 256 + qb * 128;
    int trow = t0 + wid * 32 + r32;
    Seg s0 = {Km + (size_t)(b * 256) * 1536 + hd * 192, Vm + (size_t)(b * 256) * 1024 + hd * 128, 1536, 1024, 256};
    Seg s1 = {s0.K, s0.V, 1536, 1024, 0};
    attn_core<192, false, false>(tid, o, Qm + (size_t)trow * 1536 + hd * 192 + hh * 8, s0, s1, CM, lds, 0, 0, 0, 0.f, 0.f);
    store_gated(tid, p, o, t0, 4928 + hd * 128, 1024 + hd * 128, lds);
  }
  for (; item < 3072; item += gridDim.x) {
    const int tid = opaque(threadIdx.x), lane = tid & 63, wid = tid >> 6, r32 = lane & 31, hh = lane >> 5;
    f32x16 o[4];
    int it = item - 2560;
    int b = it >> 4, hd = (it >> 1) & 7, qb = it & 1;
    int t0 = b * 256 + qb * 128;
    int trow = t0 + wid * 32 + r32;
    const bfu* Pb = P + (size_t)(b * 256) * EVEN_IN;
    Seg s0 = {Pb + 1024 + hd * 128, Pb + 2048 + hd * 128, EVEN_IN, EVEN_IN, 256};
    Seg s1 = {s0.K, s0.V, EVEN_IN, EVEN_IN, 0};
    attn_core<128, false, false>(tid, o, P + (size_t)trow * EVEN_IN + hd * 128 + hh * 8, s0, s1, CN, lds, 0, 0, 0, 0.f, 0.f);
    store_gated(tid, p, o, t0, 3072 + hd * 128, hd * 128, lds);
  }
}

DI void phase_attn_odd(const Params& p, int l, char* lds) {
  const int li = l >> 1;
  const bfu* P = (const bfu*)(p.ws + WS_PBUF);
  bfu* O = (bfu*)(p.ws + WS_HBUF);
  const bfu* cdk = (const bfu*)(p.ws + WS_C_DK);
  const bfu* cdv = (const bfu*)(p.ws + WS_C_DV);
  float* scr = (float*)(p.ws + WS_SCR) + (size_t)blockIdx.x * 32768;
  const float CD = 0.08838834764831845f * LOG2E;
  const float lam_init = 0.8f - 0.6f * expf(-0.3f * (float)l);
  float lam;
  {
    const float* lp = p.in[23] + li * 512;
    float s1 = 0.f, s2 = 0.f;
    for (int k = 0; k < 128; ++k) { s1 += lp[k] * lp[128 + k]; s2 += lp[256 + k] * lp[384 + k]; }
    lam = expf(s1) - expf(s2) + lam_init;
  }
  const float* gsub = p.in[24] + li * 256;
  for (int item = blockIdx.x; item < 1536; item += gridDim.x) {
    const int tid = opaque(threadIdx.x), lane = tid & 63, wid = tid >> 6, r32 = lane & 31, hh = lane >> 5;
    int b, hd, qb, t0; Seg s0, s1;
    if (item < 1024) {
      b = item >> 7; hd = (item >> 4) & 7; qb = item & 15;
      t0 = TP + b * 2048 + qb * 128;
      const bfu* Pl = P + (size_t)(TP + b * 2048) * ODD_IN;
      s0 = Seg{cdk + (size_t)((b * 2 + li) * 512) * 2048 + hd * 256, cdv + (size_t)((b * 2 + li) * 512) * 2048 + hd * 256, 2048, 2048, 512};
      s1 = Seg{Pl + 2048 + hd * 256, Pl + 4096 + hd * 256, ODD_IN, ODD_IN, 2048};
    } else {
      int it = item - 1024;
      b = it >> 4; hd = (it >> 1) & 7; qb = it & 1;
      t0 = b * 256 + qb * 128;
      const bfu* Pb = P + (size_t)(b * 256) * ODD_IN;
      s0 = Seg{Pb + 2048 + hd * 256, Pb + 4096 + hd * 256, ODD_IN, ODD_IN, 256};
      s1 = Seg{s0.K, s0.V, ODD_IN, ODD_IN, 0};
    }
    const int trow = t0 + wid * 32 + r32;
    float ssq = 0.f;
    for (int pass = 0; pass < 4; ++pass) {
      const int vh = pass >> 1, c = pass & 1;
      f32x16 o[4];
      Seg a0 = s0, a1 = s1;
      a0.K += c * 128; a1.K += c * 128; a0.V += vh * 128; a1.V += vh * 128;
      attn_core<128, false, false>(tid, o, P + (size_t)trow * ODD_IN + hd * 256 + c * 128 + hh * 8, a0, a1, CD, lds, 0, 0, 0, 0.f, 0.f);
      float* sc = scr + vh * 16384 + tid;
      if (c == 1) {
        float ss = 0.f;
#pragma unroll
        for (int d = 0; d < 4; ++d)
#pragma unroll
          for (int r = 0; r < 16; ++r) {
            float dd = sc[(d * 16 + r) * 256] - lam * o[d][r];
            o[d][r] = dd; ss += dd * dd;
          }
        ssq += ss;
      }
#pragma unroll
      for (int d = 0; d < 4; ++d)
#pragma unroll
        for (int r = 0; r < 16; ++r) sc[(d * 16 + r) * 256] = o[d][r];
    }
    ssq += __shfl_xor(ssq, 32);
    const float rstd = rsqrtf(ssq * (1.f / 256.f) + EPS) * (1.f - lam_init);
    for (int half = 0; half < 2; ++half) {
      f32x16 o[4];
      const float* sc = scr + half * 16384 + tid;
#pragma unroll
      for (int d = 0; d < 4; ++d)
#pragma unroll
        for (int r = 0; r < 16; ++r) o[d][r] = sc[(d * 16 + r) * 256] * rstd;
      const float* tr = tr_stage(tid, o, lds);
      const int colb = hd * 256 + half * 128 + lane * 2;
      const float g0 = gsub[half * 128 + lane * 2], g1 = gsub[half * 128 + lane * 2 + 1];
      for (int rr = 0; rr < 32; ++rr) {
        size_t t = (size_t)(t0 + wid * 32 + rr);
        f2_t v = *(const f2_t*)(tr + rr * ATT_TR_ROW + lane * 2);
        unsigned g = *(const unsigned*)(P + t * ODD_IN + 6144 + colb);
        *(unsigned*)(O + t * D + colb) = cvtpk(v[0] * g0 * silu(bflo(g)), v[1] * g1 * silu(bfhi(g)));
      }
    }
  }
}

#ifndef PM
#define PM 0xffff
#endif
DI void run_phase(const Params& p, int ph, char* lds) {
  if (ph == 0) { if (PM & 1) phase_prep(p, lds); return; }
  if (ph == 1) { if (PM & 2) phase_rows(p, 0, 0, lds); return; }
  const int q = ph - 2, pair = q / 10, r = q % 10;
  const bfu* hbuf = (const bfu*)(p.ws + WS_HBUF);
  if (r < 6) {
    const int l = 2 * pair, li = pair;
    if (r == 0 && (PM & 4)) {
      const bfu* W = (const bfu*)(p.ws + WS_WT_IN_E) + (size_t)li * EVEN_IN * D;
      for (int id = blockIdx.x; id < 192 * 47; id += gridDim.x) { int m, n; tile_mn(id, 47, m, n); gemm_tile<EPI_E1>(p, hbuf, D, W, D, D, m * 128, n * 128, li, lds); }
    } else if (r == 1 && (PM & 8)) {
      phase_mid(p, li);
    } else if (r == 2 && (PM & 16)) {
      const bfu* Wq = (const bfu*)(p.ws + WS_WT_UQ) + (size_t)li * 1536 * 512;
      const bfu* Wkv = (const bfu*)(p.ws + WS_WT_UKV) + (size_t)li * 2048 * 256;
      for (int id = blockIdx.x; id < 2304 + 3584; id += gridDim.x) {
        int m, n;
        if (id < 2304) { tile_mn(id, 12, m, n); gemm_tile<EPI_QM>(p, (const bfu*)(p.ws + WS_CQN), 512, Wq, 512, 512, m * 128, n * 128, li, lds); }
        else { tile_mn(id - 2304, 16, m, n); gemm_tile<EPI_KV>(p, (const bfu*)(p.ws + WS_CKVN), 256, Wkv, 256, 256, m * 128, n * 128, li, lds); }
      }
    } else if (r == 3 && (PM & 32)) {
      phase_attn_even(p, li, lds);
    } else if (r == 4 && (PM & 64)) {
      const bfu* W = (const bfu*)(p.ws + WS_WT_OUT_E) + (size_t)li * D * D;
      for (int id = blockIdx.x; id < 192 * 16; id += gridDim.x) { int m, n; tile_mn(id, 16, m, n); gemm_tile<EPI_Y>(p, hbuf, D, W, D, D, m * 128, n * 128, li, lds); }
    } else if (r == 5 && (PM & 128)) {
      phase_rows(p, 1, l, lds);
    }
  } else {
    const int l = 2 * pair + 1, li = pair, k = r - 6;
    if (k == 0 && (PM & 256)) {
      const bfu* W = (const bfu*)(p.ws + WS_WT_IN_O) + (size_t)li * ODD_IN * D;
      for (int id = blockIdx.x; id < 192 * 64; id += gridDim.x) { int m, n; tile_mn(id, 64, m, n); gemm_tile<EPI_O1>(p, hbuf, D, W, D, D, m * 128, n * 128, li, lds); }
    } else if (k == 1 && (PM & 512)) {
      phase_attn_odd(p, l, lds);
    } else if (k == 2 && (PM & 1024)) {
      const bfu* W = (const bfu*)(p.ws + WS_WT_OUT_O) + (size_t)li * D * D;
      for (int id = blockIdx.x; id < 192 * 16; id += gridDim.x) { int m, n; tile_mn(id, 16, m, n); gemm_tile<EPI_Y>(p, hbuf, D, W, D, D, m * 128, n * 128, li, lds); }
    } else if (k == 3 && (PM & 2048)) {
      phase_rows(p, 1, l, lds);
    }
  }
}

constexpr int N_PHASES = 22;
constexpr int LDS_BYTES = 4 * G_TILE;

__global__ void __launch_bounds__(256, 2) fwd_megakernel(Params p) {
  __shared__ __attribute__((aligned(16))) char lds[LDS_BYTES];
  cg::grid_group grid = cg::this_grid();
  for (int ph = p.lo; ph < p.hi; ++ph) {
    run_phase(p, ph, lds);
    if (ph + 1 < p.hi) grid.sync();
  }
}

extern "C" void kernel_launch(void* const* d_in, const int* in_sizes, int n_in, void* d_out, int out_size, void* d_ws, size_t ws_size,
                              hipStream_t stream) {
  static int grid_blocks = 0;
  if (!grid_blocks) {
    int dev = 0, cus = 0, per_cu = 0;
    hipGetDevice(&dev);
    hipDeviceGetAttribute(&cus, hipDeviceAttributeMultiprocessorCount, dev);
    hipOccupancyMaxActiveBlocksPerMultiprocessor(&per_cu, fwd_megakernel, 256, 0);
    if (per_cu > 2) per_cu = 2;
    if (per_cu < 1) per_cu = 1;
    grid_blocks = cus * per_cu;
    if (grid_blocks > 1024) grid_blocks = 1024;
  }
  if (n_in != 25 || ws_size < WS_NEED) {
    fprintf(stderr, "kernel_launch: bad n_in %d or ws_size %zu < %zu\n", n_in, ws_size, (size_t)WS_NEED);
    return;
  }
  Params p{};
  for (int i = 0; i < 25; ++i) p.in[i] = (const float*)d_in[i];
  p.out = (float*)d_out;
  p.ws = (char*)d_ws;
  p.lo = 0; p.hi = N_PHASES;
  void* args[] = {&p};
  hipError_t e = hipLaunchCooperativeKernel((void*)fwd_megakernel, dim3(grid_blocks), dim3(256), args, 0, stream);
  if (e != hipSuccess) fprintf(stderr, "cooperative launch failed: %s (grid %d)\n", hipGetErrorString(e), grid_blocks);
}
```

```cpp
#include <hip/hip_runtime.h>
#include <hip/hip_cooperative_groups.h>
#include <cstdio>
#include <cstdint>
namespace cg = cooperative_groups;

#define DI __device__ __forceinline__
typedef unsigned short bfu;
using bf16x8 = __attribute__((ext_vector_type(8))) short;
using s16x4  = __attribute__((ext_vector_type(4))) short;
using f32x16 = __attribute__((ext_vector_type(16))) float;
using f32x4  = __attribute__((ext_vector_type(4))) float;
using u32x4  = __attribute__((ext_vector_type(4))) unsigned;
using u32x2  = __attribute__((ext_vector_type(2))) unsigned;
typedef __bf16 bf2_t __attribute__((ext_vector_type(2)));
typedef float f2_t __attribute__((ext_vector_type(2)));

constexpr int D = 2048, TP = 8192, TS = 16384, T = 24576, TALL = 28672;
constexpr int EVEN_IN = 5952, ODD_IN = 8192;
constexpr float EPS = 1e-6f;
constexpr float LOG2E = 1.4426950408889634f;
constexpr float LOG2_ROPE = 13.287712379549449f;

constexpr size_t OUT_YP = 0, OUT_YS = 16777216, OUT_NAK = 50331648, OUT_NAV = 67108864, OUT_CKV = 83886080,
                 OUT_KPE = 88080384, OUT_DK = 89128960, OUT_DV = 122683392;

constexpr size_t al256(size_t x) { return (x + 255) / 256 * 256; }
constexpr size_t WS_WT_IN_E = 0;
constexpr int EVEN_PAD = 6144;
constexpr size_t WS_WT_IN_O = WS_WT_IN_E + al256((size_t)2 * EVEN_PAD * D * 2);
constexpr size_t WS_WT_OUT_E = WS_WT_IN_O + al256((size_t)2 * ODD_IN * D * 2);
constexpr size_t WS_WT_OUT_O = WS_WT_OUT_E + al256((size_t)2 * D * D * 2);
constexpr size_t WS_WT_UQ = WS_WT_OUT_O + al256((size_t)2 * D * D * 2);
constexpr size_t WS_WT_UKV = WS_WT_UQ + al256((size_t)2 * 1536 * 512 * 2);
constexpr size_t WS_C_NAK = WS_WT_UKV + al256((size_t)2 * 2048 * 256 * 2);
constexpr size_t WS_C_NAV = WS_C_NAK + al256((size_t)8 * 2 * 512 * 1024 * 2);
constexpr size_t WS_C_DK = WS_C_NAV + al256((size_t)8 * 2 * 512 * 1024 * 2);
constexpr size_t WS_C_DV = WS_C_DK + al256((size_t)8 * 2 * 512 * 2048 * 2);
constexpr size_t WS_MODP = WS_C_DV + al256((size_t)8 * 2 * 512 * 2048 * 2);
constexpr size_t WS_HBUF = WS_MODP + al256((size_t)4 * 4 * 9 * 6144 * 4);
constexpr size_t WS_CQN = WS_HBUF;
constexpr size_t WS_CKVN = WS_HBUF + al256((size_t)T * 512 * 2);
constexpr size_t WS_PBUF = WS_HBUF + al256((size_t)T * D * 2);
constexpr size_t WS_YBUF = WS_PBUF;
constexpr size_t WS_QM = WS_PBUF + al256((size_t)T * EVEN_IN * 2);
constexpr size_t WS_KMLA = WS_QM + al256((size_t)T * 1536 * 2);
constexpr size_t WS_VMLA = WS_KMLA + al256((size_t)TALL * 1536 * 2);
constexpr size_t WS_END_EVEN = WS_VMLA + al256((size_t)TALL * 1024 * 2);
constexpr size_t WS_SCR = WS_PBUF + al256((size_t)T * ODD_IN * 2);
constexpr size_t WS_END_ODD = WS_SCR + (size_t)1024 * 131072;
constexpr size_t WS_NEED = WS_END_EVEN > WS_END_ODD ? WS_END_EVEN : WS_END_ODD;

struct Params {
  const float* in[25];
  float* out;
  char* ws;
  int lo, hi;
};

DI unsigned cvtpk(float lo, float hi) {
  f2_t v = {lo, hi};
  bf2_t b = __builtin_convertvector(v, bf2_t);
  return __builtin_bit_cast(unsigned, b);
}
DI bfu f2bf(float x) { return (bfu)(cvtpk(x, 0.f) & 0xffffu); }
DI float bf2f(bfu b) { return __uint_as_float(((unsigned)b) << 16); }
DI float bflo(unsigned u) { return __uint_as_float(u << 16); }
DI float bfhi(unsigned u) { return __uint_as_float(u & 0xffff0000u); }
DI int opaque(int x) { asm volatile("" : "+v"(x)); return x; }
DI int crow(int r, int hi) { return (r & 3) + 8 * (r >> 2) + 4 * hi; }
DI float silu(float x) { return x / (1.f + __expf(-x)); }
DI f32x16 mfma(bf16x8 a, bf16x8 b, f32x16 c) { return __builtin_amdgcn_mfma_f32_32x32x16_bf16(a, b, c, 0, 0, 0); }
DI float wave_sum(float v) {
#pragma unroll
  for (int o = 32; o >= 1; o >>= 1) v += __shfl_xor(v, o);
  return v;
}
DI float block_sum(float v, float* red, int tid) {
  v = wave_sum(v);
  __syncthreads();
  if ((tid & 63) == 0) red[tid >> 6] = v;
  __syncthreads();
  const int hb = (tid >> 8) * 4;
  return red[hb] + red[hb + 1] + red[hb + 2] + red[hb + 3];
}
DI float modval(const Params& p, int l, int r, int n) {
  const float* mp = (const float*)(p.ws + WS_MODP);
  float s = p.in[11][l * 6144 + n];
#pragma unroll
  for (int ks = 0; ks < 4; ++ks) s += mp[((size_t)(ks * 4 + l) * 9 + r) * 6144 + n];
  return s;
}

DI void prep_mod_item(const Params& p, int item, char* lds) {
  const int tid = opaque(threadIdx.x), lane = tid & 63, wid = tid >> 6;
  const int ks = item & 3, cgp = (item >> 2) % 24, l = item / 96;
  float* scond = (float*)lds;
  float* red = (float*)(lds + 18432);
  for (int idx = tid; idx < 9 * 512; idx += 512) {
    int r = idx >> 9, kk = idx & 511;
    float cv = r < 8 ? p.in[8][r * 2048 + ks * 512 + kk] : p.in[9][ks * 512 + kk];
    scond[idx] = silu(cv);
  }
  __syncthreads();
  const float* W = p.in[10] + ((size_t)l * 2048 + ks * 512 + wid * 64) * 6144 + cgp * 256 + lane * 4;
  float acc[9][4];
#pragma unroll
  for (int r = 0; r < 9; ++r) { acc[r][0] = 0; acc[r][1] = 0; acc[r][2] = 0; acc[r][3] = 0; }
  for (int kk = 0; kk < 64; kk += 4) {
    f32x4 w[4];
#pragma unroll
    for (int u = 0; u < 4; ++u) w[u] = *(const f32x4*)(W + (size_t)(kk + u) * 6144);
#pragma unroll
    for (int u = 0; u < 4; ++u) {
#pragma unroll
      for (int r = 0; r < 9; ++r) {
        float s = scond[r * 512 + wid * 64 + kk + u];
        acc[r][0] += s * w[u][0]; acc[r][1] += s * w[u][1]; acc[r][2] += s * w[u][2]; acc[r][3] += s * w[u][3];
      }
    }
  }
#pragma unroll
  for (int r = 0; r < 9; ++r) {
    f32x4 v = {acc[r][0], acc[r][1], acc[r][2], acc[r][3]};
    *(f32x4*)(red + (wid * 9 + r) * 256 + lane * 4) = v;
  }
  __syncthreads();
  float* mp = (float*)(p.ws + WS_MODP);
  for (int idx = tid; idx < 9 * 256; idx += 512) {
    int r = idx >> 8, cc = idx & 255;
    float s = 0.f;
#pragma unroll
    for (int w = 0; w < 8; ++w) s += red[(w * 9 + r) * 256 + cc];
    mp[((size_t)(ks * 4 + l) * 9 + r) * 6144 + cgp * 256 + cc] = s;
  }
  __syncthreads();
}

DI int swap45(int n) { return (n & ~0x30) | ((n & 0x10) << 1) | ((n & 0x20) >> 1); }

DI void prep_transpose_tile(const float* __restrict__ src, bfu* __restrict__ dst, int K, int N, int k0, int n0, char* lds, int tid) {
  float* tl = (float*)lds + (tid >> 8) * (64 * 65);
  const int t4 = tid & 255;
#pragma unroll
  for (int i = 0; i < 4; ++i) {
    int kr = (t4 >> 4) + 16 * i, nc = (t4 & 15) * 4;
    f32x4 v = *(const f32x4*)(src + (size_t)(k0 + kr) * N + n0 + nc);
    tl[kr * 65 + nc + 0] = v[0]; tl[kr * 65 + nc + 1] = v[1]; tl[kr * 65 + nc + 2] = v[2]; tl[kr * 65 + nc + 3] = v[3];
  }
  __syncthreads();
  {
    int n = t4 >> 2, kseg = (t4 & 3) * 16;
    unsigned w[8];
#pragma unroll
    for (int e = 0; e < 8; ++e) w[e] = cvtpk(tl[(kseg + 2 * e) * 65 + n], tl[(kseg + 2 * e + 1) * 65 + n]);
    u32x4 a = {w[0], w[1], w[2], w[3]}, b = {w[4], w[5], w[6], w[7]};
    bfu* d = dst + (size_t)swap45(n0 + n) * K + k0 + kseg;
    *(u32x4*)d = a; *(u32x4*)(d + 8) = b;
  }
  __syncthreads();
}

DI void phase_prep(const Params& p, char* lds) {
  constexpr int N_MOD = 384, N_TR_L = 9440, N_TRP = N_TR_L, N_CV = 1536;
  for (int item = blockIdx.x; item < N_MOD + N_TRP + N_CV; item += gridDim.x) {
    if (item < N_MOD) { prep_mod_item(p, item, lds); continue; }
    const int tid = opaque(threadIdx.x);
    int it = item - N_MOD;
    if (it < N_TRP) {
      int tl = it * 2 + (tid >> 8);
      int i = tl / N_TR_L, r = tl % N_TR_L;
      const float* src; bfu* dst; int K, N;
      if (r < 2976) { src = p.in[14] + (size_t)i * 2048 * EVEN_IN; dst = (bfu*)(p.ws + WS_WT_IN_E) + (size_t)i * EVEN_PAD * 2048; K = 2048; N = EVEN_IN; }
      else if ((r -= 2976) < 1024) { src = p.in[15] + (size_t)i * 2048 * 2048; dst = (bfu*)(p.ws + WS_WT_OUT_E) + (size_t)i * 2048 * 2048; K = 2048; N = 2048; }
      else if ((r -= 1024) < 192) { src = p.in[18] + (size_t)i * 512 * 1536; dst = (bfu*)(p.ws + WS_WT_UQ) + (size_t)i * 1536 * 512; K = 512; N = 1536; }
      else if ((r -= 192) < 128) { src = p.in[20] + (size_t)i * 256 * 2048; dst = (bfu*)(p.ws + WS_WT_UKV) + (size_t)i * 2048 * 256; K = 256; N = 2048; }
      else if ((r -= 128) < 4096) { src = p.in[21] + (size_t)i * 2048 * ODD_IN; dst = (bfu*)(p.ws + WS_WT_IN_O) + (size_t)i * ODD_IN * 2048; K = 2048; N = ODD_IN; }
      else { r -= 4096; src = p.in[22] + (size_t)i * 2048 * 2048; dst = (bfu*)(p.ws + WS_WT_OUT_O) + (size_t)i * 2048 * 2048; K = 2048; N = 2048; }
      int nN = N / 64;
      int kt = r / nN, nt = r % nN;
      prep_transpose_tile(src, dst, K, N, kt * 64, nt * 64, lds, tid);
      continue;
    }
    it -= N_TRP;
    {
      size_t ch = (size_t)it * 4096;
      const float* src; bfu* dst;
      if (ch < 1048576) { src = p.in[2]; dst = (bfu*)(p.ws + WS_C_NAK); }
      else if ((ch -= 1048576) < 1048576) { src = p.in[3]; dst = (bfu*)(p.ws + WS_C_NAV); }
      else if ((ch -= 1048576) < 2097152) { src = p.in[6]; dst = (bfu*)(p.ws + WS_C_DK); }
      else { ch -= 2097152; src = p.in[7]; dst = (bfu*)(p.ws + WS_C_DV); }
#pragma unroll
      for (int u = 0; u < 8; ++u) {
        size_t c = ch + u * 512 + tid;
        f32x4 a = *(const f32x4*)(src + c * 8), b = *(const f32x4*)(src + c * 8 + 4);
        u32x4 w = {cvtpk(a[0], a[1]), cvtpk(a[2], a[3]), cvtpk(b[0], b[1]), cvtpk(b[2], b[3])};
        *(u32x4*)(dst + c * 8) = w;
      }
    }
  }
}

DI void phase_rows(const Params& p, int kind, int l, char* lds) {
  float* red = (float*)lds;
  const int tid = opaque(threadIdx.x), col = (tid & 255) * 8;
  const int rows_per = ((T / 2 + gridDim.x - 1) / gridDim.x) * 2;
  const int t_begin = blockIdx.x * rows_per;
  const int t_end = min(T, t_begin + rows_per);
  const int ln = kind == 0 ? 0 : l + 1;
  const bool do_h = ln < 4;
  int cur_r = -1;
  float sc[8], sh[8], gp[8], gate[8], gpo[8];
  bfu* hbuf = (bfu*)(p.ws + WS_HBUF);
  const float* ybuf = (const float*)(p.ws + WS_YBUF);
  for (int tt = t_begin; tt < t_end; tt += 2) {
    const int t = tt + (tid >> 8);
    const int r = t < TP ? 8 : (t - TP) >> 11;
    if (r != cur_r) {
      cur_r = r;
#pragma unroll
      for (int e = 0; e < 8; ++e) {
        if (do_h) {
          sh[e] = modval(p, ln, r, col + e);
          sc[e] = 1.f + modval(p, ln, r, 2048 + col + e);
          gp[e] = p.in[12][ln * 2048 + col + e];
        }
        if (kind == 1) {
          gate[e] = modval(p, l, r, 4096 + col + e);
          gpo[e] = p.in[13][l * 2048 + col + e];
        }
      }
    }
    const float* xin = (kind == 0 || l == 0) ? (t < TP ? p.in[0] + (size_t)t * D : p.in[1] + (size_t)(t - TP) * D) : p.out + (size_t)t * D;
    float x[8];
    { f32x4 a = *(const f32x4*)(xin + col), b = *(const f32x4*)(xin + col + 4);
      x[0] = a[0]; x[1] = a[1]; x[2] = a[2]; x[3] = a[3]; x[4] = b[0]; x[5] = b[1]; x[6] = b[2]; x[7] = b[3]; }
    if (kind == 1) {
      float y[8];
      { f32x4 a = *(const f32x4*)(ybuf + (size_t)t * D + col), b = *(const f32x4*)(ybuf + (size_t)t * D + col + 4);
        y[0] = a[0]; y[1] = a[1]; y[2] = a[2]; y[3] = a[3]; y[4] = b[0]; y[5] = b[1]; y[6] = b[2]; y[7] = b[3]; }
      float ss = 0;
#pragma unroll
      for (int e = 0; e < 8; ++e) ss += y[e] * y[e];
      ss = block_sum(ss, red, tid);
      float rstd = rsqrtf(ss * (1.f / 2048.f) + EPS);
#pragma unroll
      for (int e = 0; e < 8; ++e) x[e] = x[e] + gate[e] * (y[e] * rstd * gpo[e]);
      f32x4 a = {x[0], x[1], x[2], x[3]}, b = {x[4], x[5], x[6], x[7]};
      *(f32x4*)(p.out + (size_t)t * D + col) = a; *(f32x4*)(p.out + (size_t)t * D + col + 4) = b;
    }
    if (do_h) {
      float ss = 0;
#pragma unroll
      for (int e = 0; e < 8; ++e) ss += x[e] * x[e];
      ss = block_sum(ss, red, tid);
      float rstd = rsqrtf(ss * (1.f / 2048.f) + EPS);
      float h[8];
#pragma unroll
      for (int e = 0; e < 8; ++e) h[e] = x[e] * rstd * gp[e] * sc[e] + sh[e];
      u32x4 w = {cvtpk(h[0], h[1]), cvtpk(h[2], h[3]), cvtpk(h[4], h[5]), cvtpk(h[6], h[7])};
      *(u32x4*)(hbuf + (size_t)t * D + col) = w;
    }
  }
}

constexpr int GBM = 256, GBK = 64, GHALF = 128, GHT = GHALF * GBK;
enum { EPI_E1 = 0, EPI_O1 = 1, EPI_QM = 2, EPI_KV = 3, EPI_Y = 4 };

DI int lds_byte(int r, int c) {
  int st = (r >> 4) * 2 + (c >> 5), rr = r & 15, cc = c & 31, ob = rr * 64 + cc * 2;
  return st * 1024 + (ob ^ (((ob >> 9) & 1) << 5));
}
DI void stage_rc(int b, int& R, int& C) {
  int st = b / 1024, sb = b % 1024, swz = sb ^ (((sb >> 9) & 1) << 5);
  R = (st >> 1) * 16 + swz / 64; C = (st & 1) * 32 + (swz % 64) / 2;
}

template <int EPI>
DI void gemm256(const Params& p, const bfu* __restrict__ A, const bfu* __restrict__ Bt, const int K, const int brow, const int bcol,
                const int li, char* lds) {
  const int tid = opaque(threadIdx.x);
  bfu* shm = (bfu*)lds;
#define SA(b, h) (shm + ((b) * 2 + (h)) * GHT)
#define SB(b, h) (shm + (4 + (b) * 2 + (h)) * GHT)
#define STAGE(P_, BASE, br, kt) do { long _g = (long)(br) * K + (long)(kt) * GBK;                          \
    for (int _i = 0; _i < 2; ++_i) { int _b = tid * 16 + _i * 8192; int _r, _c; stage_rc(_b, _r, _c);      \
      __builtin_amdgcn_global_load_lds((const unsigned*)(BASE + _g + (long)_r * K + _c),                    \
        (__attribute__((address_space(3))) unsigned*)((char*)(P_) + _b), 16, 0, 0); } } while (0)
#define LDA(dst, b, h) for (int m = 0; m < 4; ++m) for (int k = 0; k < 2; ++k)                              \
    dst[m][k] = *reinterpret_cast<const bf16x8*>((char*)SA(b, h) + lds_byte(wr * 64 + m * 16 + fr, k * 32 + fq * 8))
#define LDB(dst, b, h) for (int n = 0; n < 2; ++n) for (int k = 0; k < 2; ++k)                              \
    dst[n][k] = *reinterpret_cast<const bf16x8*>((char*)SB(b, h) + lds_byte(wc * 32 + n * 16 + fr, k * 32 + fq * 8))
#define MMA(ai, bj, At_, Bt_) do { __builtin_amdgcn_s_setprio(1);                                            \
    for (int m = 0; m < 4; ++m) for (int n = 0; n < 2; ++n) for (int k = 0; k < 2; ++k)                      \
      acc[ai][bj][m][n] = __builtin_amdgcn_mfma_f32_16x16x32_bf16(At_[m][k], Bt_[n][k], acc[ai][bj][m][n], 0, 0, 0); \
    __builtin_amdgcn_s_setprio(0); } while (0)
#define WAIT_V(n) asm volatile("s_waitcnt vmcnt(" #n ")" ::: "memory")
#define WAIT_L(n) asm volatile("s_waitcnt lgkmcnt(" #n ")" ::: "memory")
#define BAR __builtin_amdgcn_s_barrier()
#define SCHED __builtin_amdgcn_sched_barrier(0)
  const int wid = tid >> 6, lane = tid & 63, wr = wid >> 2, wc = wid & 3, fr = lane & 15, fq = lane >> 4;
  f32x4 acc[2][2][4][2];
#pragma unroll
  for (int a_ = 0; a_ < 2; ++a_)
#pragma unroll
    for (int b_ = 0; b_ < 2; ++b_)
#pragma unroll
      for (int m = 0; m < 4; ++m)
#pragma unroll
        for (int n = 0; n < 2; ++n) { acc[a_][b_][m][n][0] = 0.f; acc[a_][b_][m][n][1] = 0.f; acc[a_][b_][m][n][2] = 0.f; acc[a_][b_][m][n][3] = 0.f; }
  bf16x8 At[4][2], B0[2][2], B1[2][2];
  const int nt = K / GBK;
  WAIT_V(0); BAR;
  STAGE(SB(0, 0), Bt, bcol, 0); STAGE(SA(0, 0), A, brow, 0);
  STAGE(SB(0, 1), Bt, bcol + GHALF, 0); STAGE(SA(0, 1), A, brow + GHALF, 0);
  if (wr == 1) BAR;
  WAIT_V(4); BAR;
  STAGE(SB(1, 0), Bt, bcol, 1); STAGE(SA(1, 0), A, brow, 1); STAGE(SB(1, 1), Bt, bcol + GHALF, 1);
  WAIT_V(6); BAR;
  for (int t = 0; t < nt - 2; t += 2) {
    LDB(B0, 0, 0); SCHED; LDA(At, 0, 0); STAGE(SA(1, 1), A, brow + GHALF, t + 1);
    WAIT_L(8); BAR; WAIT_L(0); MMA(0, 0, At, B0); BAR; SCHED;
    LDB(B1, 0, 1); STAGE(SB(0, 0), Bt, bcol, t + 2);
    BAR; WAIT_L(0); MMA(0, 1, At, B1); BAR;
    LDA(At, 0, 1); STAGE(SA(0, 0), A, brow, t + 2);
    BAR; WAIT_L(0); MMA(1, 0, At, B0); BAR; SCHED;
    STAGE(SB(0, 1), Bt, bcol + GHALF, t + 2);
    WAIT_V(6); BAR; MMA(1, 1, At, B1); BAR;
    LDB(B0, 1, 0); SCHED; LDA(At, 1, 0); STAGE(SA(0, 1), A, brow + GHALF, t + 2);
    WAIT_L(8); BAR; WAIT_L(0); MMA(0, 0, At, B0); BAR; SCHED;
    LDB(B1, 1, 1); STAGE(SB(1, 0), Bt, bcol, t + 3);
    BAR; WAIT_L(0); MMA(0, 1, At, B1); BAR;
    LDA(At, 1, 1); STAGE(SA(1, 0), A, brow, t + 3);
    BAR; WAIT_L(0); MMA(1, 0, At, B0); BAR; SCHED;
    STAGE(SB(1, 1), Bt, bcol + GHALF, t + 3);
    WAIT_V(6); BAR; MMA(1, 1, At, B1); BAR;
  }
  { LDB(B0, 0, 0); LDA(At, 0, 0); STAGE(SA(1, 1), A, brow + GHALF, nt - 1);
    BAR; WAIT_L(0); MMA(0, 0, At, B0); BAR;
    LDB(B1, 0, 1); BAR; WAIT_L(0); MMA(0, 1, At, B1); BAR;
    LDA(At, 0, 1); WAIT_V(4); BAR; WAIT_L(0); MMA(1, 0, At, B0); MMA(1, 1, At, B1); BAR; }
  { LDB(B0, 1, 0); LDA(At, 1, 0); WAIT_V(2); BAR; WAIT_L(0); MMA(0, 0, At, B0); BAR;
    LDB(B1, 1, 1); WAIT_V(0); BAR; WAIT_L(0); MMA(0, 1, At, B1); BAR;
    LDA(At, 1, 1); BAR; WAIT_L(0); MMA(1, 0, At, B0); MMA(1, 1, At, B1); BAR; }
  if (wr == 0) BAR;
#undef SA
#undef SB
#undef STAGE
#undef LDA
#undef LDB
#undef MMA
#undef WAIT_V
#undef WAIT_L
#undef BAR
#undef SCHED

  const int jr = (wc & 1) * 16 + fr;
  if constexpr (EPI == EPI_O1) {
    if (brow >= TP && bcol < 4096) {
      const float inv = exp2f(-(float)jr * (LOG2_ROPE / 32.f));
      const bool colrope = (wc >> 1) & 1;
#pragma unroll
      for (int ai = 0; ai < 2; ++ai)
#pragma unroll
        for (int m = 0; m < 4; ++m)
#pragma unroll
          for (int j = 0; j < 4; ++j) {
            int row = brow + ai * 128 + wr * 64 + m * 16 + fq * 4 + j;
            int s = (row - TP) & 2047;
            float ang = (float)(colrope ? (s & 63) : (s >> 6)) * inv;
            float cs = __cosf(ang), sn = __sinf(ang);
#pragma unroll
            for (int bj = 0; bj < 2; ++bj) {
              float x1 = acc[ai][bj][m][0][j], x2 = acc[ai][bj][m][1][j];
              acc[ai][bj][m][0][j] = x1 * cs - x2 * sn;
              acc[ai][bj][m][1][j] = x2 * cs + x1 * sn;
            }
          }
    }
  }
#pragma unroll
  for (int ai = 0; ai < 2; ++ai)
#pragma unroll
    for (int bj = 0; bj < 2; ++bj)
#pragma unroll
      for (int n = 0; n < 2; ++n) {
        const int colg = bcol + bj * 128 + (wc >> 1) * 64 + n * 32 + (wc & 1) * 16;
        const int col = colg + fr;
#pragma unroll
        for (int m = 0; m < 4; ++m)
#pragma unroll
          for (int j = 0; j < 4; ++j) {
            const int row = brow + ai * 128 + wr * 64 + m * 16 + fq * 4 + j;
            const float v = acc[ai][bj][m][n][j];
            if constexpr (EPI == EPI_E1) {
              if (colg < EVEN_IN) {
                ((bfu*)(p.ws + WS_PBUF))[(size_t)row * EVEN_IN + col] = f2bf(v);
                if (brow < TP) {
                  size_t orow = (size_t)((row >> 8) * 2 + li) * 256 + (row & 255);
                  if (colg >= 1024 && colg < 2048) p.out[OUT_NAK + orow * 1024 + (col - 1024)] = v;
                  else if (colg >= 2048 && colg < 3072) p.out[OUT_NAV + orow * 1024 + (col - 2048)] = v;
                  else if (colg >= 4864 && colg < 4928) p.out[OUT_KPE + orow * 64 + (col - 4864)] = v;
                }
              }
            } else if constexpr (EPI == EPI_O1) {
              ((bfu*)(p.ws + WS_PBUF))[(size_t)row * ODD_IN + col] = f2bf(v);
              if (brow < TP) {
                size_t orow = (size_t)((row >> 8) * 2 + li) * 256 + (row & 255);
                if (colg >= 2048 && colg < 4096) p.out[OUT_DK + orow * 2048 + (col - 2048)] = v;
                else if (colg >= 4096 && colg < 6144) p.out[OUT_DV + orow * 2048 + (col - 4096)] = v;
              }
            } else if constexpr (EPI == EPI_QM) {
              ((bfu*)(p.ws + WS_QM))[(size_t)row * 1536 + col] = f2bf(v);
            } else if constexpr (EPI == EPI_KV) {
              int hd = col >> 8, jj = col & 255;
              if (jj < 128) ((bfu*)(p.ws + WS_KMLA))[(size_t)row * 1536 + hd * 192 + jj] = f2bf(v);
              else ((bfu*)(p.ws + WS_VMLA))[(size_t)row * 1024 + hd * 128 + (jj - 128)] = f2bf(v);
            } else {
              ((float*)(p.ws + WS_YBUF))[(size_t)row * D + col] = v;
            }
          }
      }
}

DI int tile_id(int it) {
  const int G = gridDim.x;
  const int pb = (G & 7) == 0 ? (blockIdx.x & 7) * (G >> 3) + (blockIdx.x >> 3) : blockIdx.x;
  return it * G + pb;
}
DI void tile_mn(int id, int nN, int& m, int& n) {
  int grp = id / (8 * nN), rem = id % (8 * nN);
  m = grp * 8 + (rem & 7); n = rem >> 3;
}

DI void phase_mid(const Params& p, int li) {
  const int tid = opaque(threadIdx.x), lane = tid & 63, wid = tid >> 6;
  const bfu* P = (const bfu*)(p.ws + WS_PBUF);
  bfu* cqn = (bfu*)(p.ws + WS_CQN);
  bfu* ckvn = (bfu*)(p.ws + WS_CKVN);
  bfu* kmla = (bfu*)(p.ws + WS_KMLA);
  const float* gq = p.in[17] + li * 512;
  const float* gkv = p.in[19] + li * 256;
  for (int t = blockIdx.x * 8 + wid; t < TALL; t += gridDim.x * 8) {
    float kp;
    if (t < T) {
      const bfu* Pr = P + (size_t)t * EVEN_IN;
      {
        u32x4 w = *(const u32x4*)(Pr + 4096 + lane * 8);
        float v[8] = {bflo(w[0]), bfhi(w[0]), bflo(w[1]), bfhi(w[1]), bflo(w[2]), bfhi(w[2]), bflo(w[3]), bfhi(w[3])};
        float ss = 0;
#pragma unroll
        for (int e = 0; e < 8; ++e) ss += v[e] * v[e];
        ss = wave_sum(ss);
        float rstd = rsqrtf(ss * (1.f / 512.f) + EPS);
#pragma unroll
        for (int e = 0; e < 8; ++e) v[e] = v[e] * rstd * gq[lane * 8 + e];
        u32x4 o = {cvtpk(v[0], v[1]), cvtpk(v[2], v[3]), cvtpk(v[4], v[5]), cvtpk(v[6], v[7])};
        *(u32x4*)(cqn + (size_t)t * 512 + lane * 8) = o;
      }
      {
        u32x2 w = *(const u32x2*)(Pr + 4608 + lane * 4);
        float v[4] = {bflo(w[0]), bfhi(w[0]), bflo(w[1]), bfhi(w[1])};
        float ss = v[0] * v[0] + v[1] * v[1] + v[2] * v[2] + v[3] * v[3];
        ss = wave_sum(ss);
        float rstd = rsqrtf(ss * (1.f / 256.f) + EPS);
#pragma unroll
        for (int e = 0; e < 4; ++e) v[e] = v[e] * rstd * gkv[lane * 4 + e];
        u32x2 o = {cvtpk(v[0], v[1]), cvtpk(v[2], v[3])};
        *(u32x2*)(ckvn + (size_t)t * 256 + lane * 4) = o;
        if (t < TP) {
          size_t orow = (size_t)((t >> 8) * 2 + li) * 256 + (t & 255);
          f32x4 f = {v[0], v[1], v[2], v[3]};
          *(f32x4*)(p.out + OUT_CKV + orow * 256 + lane * 4) = f;
        }
      }
      kp = bf2f(Pr[4864 + lane]);
      if (t >= TP) {
        int s = (t - TP) & 2047;
        float pos = (float)(lane < 32 ? (s >> 6) : (s & 63));
        int jj = lane & 15;
        float inv = exp2f(-(float)jj * (LOG2_ROPE / 16.f));
        float ang = pos * inv;
        float cs = __cosf(ang), sn = __sinf(ang);
        float pv = __shfl_xor(kp, 16);
        kp = (lane & 16) ? (kp * cs + pv * sn) : (kp * cs - pv * sn);
      }
    } else {
      int ci = t - T;
      int b = ci >> 9, j = ci & 511;
      size_t crow_ = (size_t)(b * 2 + li) * 512 + j;
      f32x4 f = *(const f32x4*)(p.in[4] + crow_ * 256 + lane * 4);
      u32x2 o = {cvtpk(f[0], f[1]), cvtpk(f[2], f[3])};
      *(u32x2*)(ckvn + (size_t)t * 256 + lane * 4) = o;
      kp = p.in[5][crow_ * 64 + lane];
    }
    bfu kb = f2bf(kp);
#pragma unroll
    for (int hd = 0; hd < 8; ++hd) kmla[(size_t)t * 1536 + hd * 192 + 128 + lane] = kb;
  }
}

struct Seg { const bfu* K; const bfu* V; int ldk, ldv, n; };
constexpr int ATT_V_OFF = 25600, ATT_BIAS_OFF = 25600 + 20480;
constexpr int ATT_TR_ROW = 132;
constexpr int ATT_HALF_LDS = 4 * 32 * ATT_TR_ROW * 4;

template <int DQK, bool NA, bool ROPEQ>
DI void attn_core(const int tid, f32x16* o, const bfu* __restrict__ Qrow, const Seg& s0, const Seg& s1, float C, char* lds,
                  int gr, int gc, int kr0, float prow, float pcol) {
  constexpr int KROW = DQK * 2 + 16, VROW = 320;
  constexpr int ND = DQK / 16;
  const int lane = tid & 63, r32 = lane & 31, hh = lane >> 5;
  char* Ksm = lds; char* Vsm = lds + ATT_V_OFF;
  const float* sbias = (const float*)(lds + ATT_BIAS_OFF);
  bf16x8 qr[ND];
#pragma unroll
  for (int d0 = 0; d0 < ND; ++d0) qr[d0] = *(const bf16x8*)(Qrow + d0 * 16);
  if constexpr (ROPEQ) {
#pragma unroll
    for (int pr = 0; pr < 2; ++pr) {
      float pos = pr == 0 ? prow : pcol;
      bf16x8 a = qr[8 + 2 * pr], b = qr[9 + 2 * pr];
      float xa[8], xb[8];
#pragma unroll
      for (int e = 0; e < 8; ++e) {
        float inv = exp2f(-(float)(8 * hh + e) * (LOG2_ROPE / 16.f));
        float ang = pos * inv;
        float cs = __cosf(ang), sn = __sinf(ang);
        float x1 = bf2f((bfu)a[e]), x2 = bf2f((bfu)b[e]);
        xa[e] = x1 * cs - x2 * sn; xb[e] = x2 * cs + x1 * sn;
      }
      u32x4 wa = {cvtpk(xa[0], xa[1]), cvtpk(xa[2], xa[3]), cvtpk(xa[4], xa[5]), cvtpk(xa[6], xa[7])};
      u32x4 wb = {cvtpk(xb[0], xb[1]), cvtpk(xb[2], xb[3]), cvtpk(xb[4], xb[5]), cvtpk(xb[6], xb[7])};
      qr[8 + 2 * pr] = __builtin_bit_cast(bf16x8, wa); qr[9 + 2 * pr] = __builtin_bit_cast(bf16x8, wb);
    }
  }
#pragma unroll
  for (int d = 0; d < 4; ++d)
#pragma unroll
    for (int r = 0; r < 16; ++r) o[d][r] = 0.f;
  float m = -1e30f, l = 0.f;
  const int nt0 = s0.n >> 6, ntile = nt0 + (s1.n >> 6);
  const int rs = min(max(gr - 4, 0), 24), cs_ = min(max(gc - 8, 0), 48);
  const int vbase = ((hh * 4 + ((lane & 15) >> 2)) * VROW) + (16 * ((lane >> 4) & 1) + 4 * (lane & 3)) * 2;
  for (int j = 0; j < ntile; ++j) {
    const bool in0 = j < nt0;
    const bfu* Kp = in0 ? s0.K + (size_t)(j * 64) * s0.ldk : s1.K + (size_t)((j - nt0) * 64) * s1.ldk;
    const bfu* Vp = in0 ? s0.V + (size_t)(j * 64) * s0.ldv : s1.V + (size_t)((j - nt0) * 64) * s1.ldv;
    const int ldk = in0 ? s0.ldk : s1.ldk, ldv = in0 ? s0.ldv : s1.ldv;
    __syncthreads();
    __builtin_amdgcn_sched_barrier(0);
#pragma unroll
    for (int hb = 0; hb < DQK / 64; ++hb) {
      bf16x8 kv[2];
#pragma unroll
      for (int i = 0; i < 2; ++i) {
        int c = tid + 256 * (hb * 2 + i), key = c / (DQK / 8), cc = c % (DQK / 8);
        kv[i] = *(const bf16x8*)(Kp + (size_t)key * ldk + cc * 8);
      }
#pragma unroll
      for (int i = 0; i < 2; ++i) {
        int c = tid + 256 * (hb * 2 + i), key = c / (DQK / 8), cc = c % (DQK / 8);
        *(bf16x8*)(Ksm + key * KROW + cc * 16) = kv[i];
      }
      __builtin_amdgcn_sched_barrier(0);
    }
#pragma unroll
    for (int hb = 0; hb < 2; ++hb) {
      bf16x8 vv[2];
#pragma unroll
      for (int i = 0; i < 2; ++i) {
        int c = tid + 256 * (hb * 2 + i), key = c >> 4, cc = c & 15;
        vv[i] = *(const bf16x8*)(Vp + (size_t)key * ldv + cc * 8);
      }
#pragma unroll
      for (int i = 0; i < 2; ++i) {
        int c = tid + 256 * (hb * 2 + i), key = c >> 4, cc = c & 15;
        *(bf16x8*)(Vsm + key * VROW + cc * 16) = vv[i];
      }
      __builtin_amdgcn_sched_barrier(0);
    }
    __syncthreads();
    f32x16 p0, p1;
#pragma unroll
    for (int r = 0; r < 16; ++r) { p0[r] = 0.f; p1[r] = 0.f; }
#pragma unroll
    for (int d0 = 0; d0 < ND; ++d0) {
      bf16x8 k0 = *(const bf16x8*)(Ksm + r32 * KROW + d0 * 32 + hh * 16);
      bf16x8 k1 = *(const bf16x8*)(Ksm + (32 + r32) * KROW + d0 * 32 + hh * 16);
      p0 = mfma(k0, qr[d0], p0);
      p1 = mfma(k1, qr[d0], p1);
    }
    if (NA && !in0) {
      const int kr = kr0 + (j - nt0);
      const bool rowok = (kr >= rs) && (kr < rs + 8);
      const int brow = (kr - gr + 7) * 31 - gc + 15;
#pragma unroll
      for (int r = 0; r < 16; ++r) {
        int kc0 = crow(r, hh), kc1 = 32 + kc0;
        bool ok0 = rowok && (kc0 >= cs_) && (kc0 < cs_ + 16);
        bool ok1 = rowok && (kc1 >= cs_) && (kc1 < cs_ + 16);
        float b0 = sbias[ok0 ? brow + kc0 : 0], b1 = sbias[ok1 ? brow + kc1 : 0];
        p0[r] = ok0 ? p0[r] * C + b0 : -1e30f;
        p1[r] = ok1 ? p1[r] * C + b1 : -1e30f;
      }
    } else {
#pragma unroll
      for (int r = 0; r < 16; ++r) { p0[r] *= C; p1[r] *= C; }
    }
    float mx = p0[0];
#pragma unroll
    for (int r = 1; r < 16; ++r) mx = fmaxf(mx, p0[r]);
#pragma unroll
    for (int r = 0; r < 16; ++r) mx = fmaxf(mx, p1[r]);
    mx = fmaxf(mx, __shfl_xor(mx, 32));
    const float mn = fmaxf(m, mx);
    const float alpha = __builtin_amdgcn_exp2f(m - mn);
    m = mn;
    float ps = 0.f;
#pragma unroll
    for (int r = 0; r < 16; ++r) { p0[r] = __builtin_amdgcn_exp2f(p0[r] - mn); ps += p0[r]; }
#pragma unroll
    for (int r = 0; r < 16; ++r) { p1[r] = __builtin_amdgcn_exp2f(p1[r] - mn); ps += p1[r]; }
    ps += __shfl_xor(ps, 32);
    l = l * alpha + ps;
#pragma unroll
    for (int d = 0; d < 4; ++d)
#pragma unroll
      for (int r = 0; r < 16; ++r) o[d][r] *= alpha;
    bf16x8 pa[4];
    {
      u32x4 w0 = {cvtpk(p0[0], p0[1]), cvtpk(p0[2], p0[3]), cvtpk(p0[4], p0[5]), cvtpk(p0[6], p0[7])};
      u32x4 w1 = {cvtpk(p0[8], p0[9]), cvtpk(p0[10], p0[11]), cvtpk(p0[12], p0[13]), cvtpk(p0[14], p0[15])};
      u32x4 w2 = {cvtpk(p1[0], p1[1]), cvtpk(p1[2], p1[3]), cvtpk(p1[4], p1[5]), cvtpk(p1[6], p1[7])};
      u32x4 w3 = {cvtpk(p1[8], p1[9]), cvtpk(p1[10], p1[11]), cvtpk(p1[12], p1[13]), cvtpk(p1[14], p1[15])};
      pa[0] = __builtin_bit_cast(bf16x8, w0); pa[1] = __builtin_bit_cast(bf16x8, w1);
      pa[2] = __builtin_bit_cast(bf16x8, w2); pa[3] = __builtin_bit_cast(bf16x8, w3);
    }
#pragma unroll
    for (int d = 0; d < 4; ++d) {
#pragma unroll
      for (int s = 0; s < 4; ++s) {
        const int offlo = (16 * s) * VROW + d * 64, offhi = (16 * s + 8) * VROW + d * 64;
        s16x4 lo = __builtin_amdgcn_ds_read_tr16_b64_v4i16((s16x4 __attribute__((address_space(3)))*)(Vsm + vbase + offlo));
        s16x4 hi = __builtin_amdgcn_ds_read_tr16_b64_v4i16((s16x4 __attribute__((address_space(3)))*)(Vsm + vbase + offhi));
        bf16x8 vb = {lo[0], lo[1], lo[2], lo[3], hi[0], hi[1], hi[2], hi[3]};
        o[d] = mfma(vb, pa[s], o[d]);
      }
    }
  }
  const float linv = 1.f / l;
#pragma unroll
  for (int d = 0; d < 4; ++d)
#pragma unroll
    for (int r = 0; r < 16; ++r) o[d][r] *= linv;
}

DI float* tr_stage(const int tid, const f32x16* o, char* lds) {
  const int lane = tid & 63, wid = tid >> 6, r32 = lane & 31, hh = lane >> 5;
  float* tr = (float*)lds + wid * (32 * ATT_TR_ROW);
  __syncthreads();
#pragma unroll
  for (int d = 0; d < 4; ++d)
#pragma unroll
    for (int g = 0; g < 4; ++g) {
      f32x4 v = {o[d][4 * g], o[d][4 * g + 1], o[d][4 * g + 2], o[d][4 * g + 3]};
      *(f32x4*)(tr + r32 * ATT_TR_ROW + d * 32 + 8 * g + 4 * hh) = v;
    }
  return tr;
}

DI void store_gated(const int tid, const Params& p, const f32x16* o, int t0, int gcol, int ocol, char* lds) {
  const int lane = tid & 63, wid = tid >> 6;
  const bfu* P = (const bfu*)(p.ws + WS_PBUF);
  bfu* O = (bfu*)(p.ws + WS_HBUF);
  const float* tr = tr_stage(tid, o, lds);
  for (int rr = 0; rr < 32; ++rr) {
    size_t t = (size_t)(t0 + wid * 32 + rr);
    f2_t v = *(const f2_t*)(tr + rr * ATT_TR_ROW + lane * 2);
    unsigned g = *(const unsigned*)(P + t * EVEN_IN + gcol + lane * 2);
    *(unsigned*)(O + t * D + ocol + lane * 2) = cvtpk(v[0] * silu(bflo(g)), v[1] * silu(bfhi(g)));
  }
}


DI void phase_attn_even(const Params& p, int li, char* lds0) {
  const bfu* P = (const bfu*)(p.ws + WS_PBUF);
  const bfu* Qm = (const bfu*)(p.ws + WS_QM);
  const bfu* Km = (const bfu*)(p.ws + WS_KMLA);
  const bfu* Vm = (const bfu*)(p.ws + WS_VMLA);
  const bfu* cnk = (const bfu*)(p.ws + WS_C_NAK);
  const bfu* cnv = (const bfu*)(p.ws + WS_C_NAV);
  const float CM = 0.07216878364870322f * LOG2E;
  const float CN = 0.08838834764831845f * LOG2E;
  int pair = blockIdx.x;
  for (; pair < 512; pair += gridDim.x) {
    const int tf = opaque(threadIdx.x), half = tf >> 8, tid = tf & 255, lane = tid & 63, wid = tid >> 6, r32 = lane & 31, hh = lane >> 5;
    char* lds = lds0 + half * ATT_HALF_LDS;
    const int item = pair * 2 + half;
    f32x16 o[4];
    int b = item >> 7, hd = (item >> 4) & 7, qb = item & 15;
    int t0 = TP + b * 2048 + qb * 128;
    int trow = t0 + wid * 32 + r32;
    int s = qb * 128 + wid * 32 + r32;
    Seg s0 = {Km + (size_t)(T + b * 512) * 1536 + hd * 192, Vm + (size_t)(T + b * 512) * 1024 + hd * 128, 1536, 1024, 512};
    Seg s1 = {Km + (size_t)(TP + b * 2048) * 1536 + hd * 192, Vm + (size_t)(TP + b * 2048) * 1024 + hd * 128, 1536, 1024, 2048};
    attn_core<192, false, true>(tid, o, Qm + (size_t)trow * 1536 + hd * 192 + hh * 8, s0, s1, CM, lds, 0, 0, 0, (float)(s >> 6), (float)(s & 63));
    store_gated(tid, p, o, t0, 4928 + hd * 128, 1024 + hd * 128, lds);
  }
  for (; pair < 1024; pair += gridDim.x) {
    const int tf = opaque(threadIdx.x), half = tf >> 8, tid = tf & 255, lane = tid & 63, wid = tid >> 6, r32 = lane & 31, hh = lane >> 5;
    char* lds = lds0 + half * ATT_HALF_LDS;
    const int it = (pair - 512) * 2 + half;
    f32x16 o[4];
    int b = it >> 7, qb = (it >> 3) & 15, hd = it & 7;
    int t0 = TP + b * 2048 + qb * 128;
    int trow = t0 + wid * 32 + r32;
    int qi = wid * 32 + r32;
    int gr = qb * 2 + (qi >> 6), gc = qi & 63;
    int kr0 = min(max(qb * 2 - 4, 0), 24);
    int kr1 = min(max(qb * 2 + 1 - 4, 0), 24) + 8;
    __syncthreads();
    float* sb = (float*)(lds + ATT_BIAS_OFF);
    for (int idx = tid; idx < 465; idx += 256) sb[idx] = p.in[16][(size_t)(li * 8 + hd) * 465 + idx] * LOG2E;
    Seg s0 = {cnk + (size_t)((b * 2 + li) * 512) * 1024 + hd * 128, cnv + (size_t)((b * 2 + li) * 512) * 1024 + hd * 128, 1024, 1024, 512};
    const bfu* Pl = P + (size_t)(TP + b * 2048 + kr0 * 64) * EVEN_IN;
    Seg s1 = {Pl + 1024 + hd * 128, Pl + 2048 + hd * 128, EVEN_IN, EVEN_IN, (kr1 - kr0) * 64};
    attn_core<128, true, false>(tid, o, P + (size_t)trow * EVEN_IN + hd * 128 + hh * 8, s0, s1, CN, lds, gr, gc, kr0, 0.f, 0.f);
    store_gated(tid, p, o, t0, 3072 + hd * 128, hd * 128, lds);
  }
  for (; pair < 1280; pair += gridDim.x) {
    const int tf = opaque(threadIdx.x), half = tf >> 8, tid = tf & 255, lane = tid & 63, wid = tid >> 6, r32 = lane & 31, hh = lane >> 5;
    char* lds = lds0 + half * ATT_HALF_LDS;
    const int it = (pair - 1024) * 2 + half;
    f32x16 o[4];
    int b = it >> 4, hd = (it >> 1) & 7, qb = it & 1;
    int t0 = b * 256 + qb * 128;
    int trow = t0 + wid * 32 + r32;
    Seg s0 = {Km + (size_t)(b * 256) * 1536 + hd * 192, Vm + (size_t)(b * 256) * 1024 + hd * 128, 1536, 1024, 256};
    Seg s1 = {s0.K, s0.V, 1536, 1024, 0};
    attn_core<192, false, false>(tid, o, Qm + (size_t)trow * 1536 + hd * 192 + hh * 8, s0, s1, CM, lds, 0, 0, 0, 0.f, 0.f);
    store_gated(tid, p, o, t0, 4928 + hd * 128, 1024 + hd * 128, lds);
  }
  for (; pair < 1536; pair += gridDim.x) {
    const int tf = opaque(threadIdx.x), half = tf >> 8, tid = tf & 255, lane = tid & 63, wid = tid >> 6, r32 = lane & 31, hh = lane >> 5;
    char* lds = lds0 + half * ATT_HALF_LDS;
    const int it = (pair - 1280) * 2 + half;
    f32x16 o[4];
    int b = it >> 4, hd = (it >> 1) & 7, qb = it & 1;
    int t0 = b * 256 + qb * 128;
    int trow = t0 + wid * 32 + r32;
    const bfu* Pb = P + (size_t)(b * 256) * EVEN_IN;
    Seg s0 = {Pb + 1024 + hd * 128, Pb + 2048 + hd * 128, EVEN_IN, EVEN_IN, 256};
    Seg s1 = {s0.K, s0.V, EVEN_IN, EVEN_IN, 0};
    attn_core<128, false, false>(tid, o, P + (size_t)trow * EVEN_IN + hd * 128 + hh * 8, s0, s1, CN, lds, 0, 0, 0, 0.f, 0.f);
    store_gated(tid, p, o, t0, 3072 + hd * 128, hd * 128, lds);
  }
}

DI void phase_attn_odd(const Params& p, int l, char* lds0) {
  const int li = l >> 1;
  const bfu* P = (const bfu*)(p.ws + WS_PBUF);
  bfu* O = (bfu*)(p.ws + WS_HBUF);
  const bfu* cdk = (const bfu*)(p.ws + WS_C_DK);
  const bfu* cdv = (const bfu*)(p.ws + WS_C_DV);
  const float CD = 0.08838834764831845f * LOG2E;
  const float lam_init = 0.8f - 0.6f * expf(-0.3f * (float)l);
  float lam;
  {
    const float* lp = p.in[23] + li * 512;
    float s1 = 0.f, s2 = 0.f;
    for (int k = 0; k < 128; ++k) { s1 += lp[k] * lp[128 + k]; s2 += lp[256 + k] * lp[384 + k]; }
    lam = expf(s1) - expf(s2) + lam_init;
  }
  const float* gsub = p.in[24] + li * 256;
  for (int pair = blockIdx.x; pair < 768; pair += gridDim.x) {
    const int tf = opaque(threadIdx.x), half_ = tf >> 8, tid = tf & 255, lane = tid & 63, wid = tid >> 6, r32 = lane & 31, hh = lane >> 5;
    char* lds = lds0 + half_ * ATT_HALF_LDS;
    const int item = pair * 2 + half_;
    float* scr = (float*)(p.ws + WS_SCR) + (size_t)(blockIdx.x * 2 + half_) * 32768;
    int b, hd, qb, t0; Seg s0, s1;
    if (item < 1024) {
      b = item >> 7; hd = (item >> 4) & 7; qb = item & 15;
      t0 = TP + b * 2048 + qb * 128;
      const bfu* Pl = P + (size_t)(TP + b * 2048) * ODD_IN;
      s0 = Seg{cdk + (size_t)((b * 2 + li) * 512) * 2048 + hd * 256, cdv + (size_t)((b * 2 + li) * 512) * 2048 + hd * 256, 2048, 2048, 512};
      s1 = Seg{Pl + 2048 + hd * 256, Pl + 4096 + hd * 256, ODD_IN, ODD_IN, 2048};
    } else {
      int it = item - 1024;
      b = it >> 4; hd = (it >> 1) & 7; qb = it & 1;
      t0 = b * 256 + qb * 128;
      const bfu* Pb = P + (size_t)(b * 256) * ODD_IN;
      s0 = Seg{Pb + 2048 + hd * 256, Pb + 4096 + hd * 256, ODD_IN, ODD_IN, 256};
      s1 = Seg{s0.K, s0.V, ODD_IN, ODD_IN, 0};
    }
    const int trow = t0 + wid * 32 + r32;
    float ssq = 0.f;
    for (int pass = 0; pass < 4; ++pass) {
      const int vh = pass >> 1, c = pass & 1;
      f32x16 o[4];
      Seg a0 = s0, a1 = s1;
      a0.K += c * 128; a1.K += c * 128; a0.V += vh * 128; a1.V += vh * 128;
      attn_core<128, false, false>(tid, o, P + (size_t)trow * ODD_IN + hd * 256 + c * 128 + hh * 8, a0, a1, CD, lds, 0, 0, 0, 0.f, 0.f);
      float* sc = scr + vh * 16384 + tid;
      if (c == 1) {
        float ss = 0.f;
#pragma unroll
        for (int d = 0; d < 4; ++d)
#pragma unroll
          for (int r = 0; r < 16; ++r) {
            float dd = sc[(d * 16 + r) * 256] - lam * o[d][r];
            o[d][r] = dd; ss += dd * dd;
          }
        ssq += ss;
      }
#pragma unroll
      for (int d = 0; d < 4; ++d)
#pragma unroll
        for (int r = 0; r < 16; ++r) sc[(d * 16 + r) * 256] = o[d][r];
    }
    ssq += __shfl_xor(ssq, 32);
    const float rstd = rsqrtf(ssq * (1.f / 256.f) + EPS) * (1.f - lam_init);
    for (int half = 0; half < 2; ++half) {
      f32x16 o[4];
      const float* sc = scr + half * 16384 + tid;
#pragma unroll
      for (int d = 0; d < 4; ++d)
#pragma unroll
        for (int r = 0; r < 16; ++r) o[d][r] = sc[(d * 16 + r) * 256] * rstd;
      const float* tr = tr_stage(tid, o, lds);
      const int colb = hd * 256 + half * 128 + lane * 2;
      const float g0 = gsub[half * 128 + lane * 2], g1 = gsub[half * 128 + lane * 2 + 1];
      for (int rr = 0; rr < 32; ++rr) {
        size_t t = (size_t)(t0 + wid * 32 + rr);
        f2_t v = *(const f2_t*)(tr + rr * ATT_TR_ROW + lane * 2);
        unsigned g = *(const unsigned*)(P + t * ODD_IN + 6144 + colb);
        *(unsigned*)(O + t * D + colb) = cvtpk(v[0] * g0 * silu(bflo(g)), v[1] * g1 * silu(bfhi(g)));
      }
    }
  }
}

#ifndef PM
#define PM 0xffff
#endif
template <int EPI>
DI void gemm_phase(const Params& p, const bfu* A, const bfu* Bt, int K, int nM, int nN, int li, char* lds) {
  const int ntiles = nM * nN;
  for (int it = 0; it * (int)gridDim.x < ntiles; ++it) {
    int id = tile_id(it);
    if (id >= ntiles) continue;
    int m, n; tile_mn(id, nN, m, n);
    gemm256<EPI>(p, A, Bt, K, m * 256, n * 256, li, lds);
  }
}

DI void run_phase(const Params& p, int ph, char* lds) {
  if (ph == 0) { if (PM & 1) phase_prep(p, lds); return; }
  if (ph == 1) { if (PM & 2) phase_rows(p, 0, 0, lds); return; }
  const int q = ph - 2, pair = q / 10, r = q % 10;
  const bfu* hbuf = (const bfu*)(p.ws + WS_HBUF);
  if (r < 6) {
    const int l = 2 * pair, li = pair;
    if (r == 0 && (PM & 4)) {
      gemm_phase<EPI_E1>(p, hbuf, (const bfu*)(p.ws + WS_WT_IN_E) + (size_t)li * EVEN_PAD * D, D, 96, 24, li, lds);
    } else if (r == 1 && (PM & 8)) {
      phase_mid(p, li);
    } else if (r == 2 && (PM & 16)) {
      gemm_phase<EPI_QM>(p, (const bfu*)(p.ws + WS_CQN), (const bfu*)(p.ws + WS_WT_UQ) + (size_t)li * 1536 * 512, 512, 96, 6, li, lds);
      gemm_phase<EPI_KV>(p, (const bfu*)(p.ws + WS_CKVN), (const bfu*)(p.ws + WS_WT_UKV) + (size_t)li * 2048 * 256, 256, 112, 8, li, lds);
    } else if (r == 3 && (PM & 32)) {
      phase_attn_even(p, li, lds);
    } else if (r == 4 && (PM & 64)) {
      gemm_phase<EPI_Y>(p, hbuf, (const bfu*)(p.ws + WS_WT_OUT_E) + (size_t)li * D * D, D, 96, 8, li, lds);
    } else if (r == 5 && (PM & 128)) {
      phase_rows(p, 1, l, lds);
    }
  } else {
    const int l = 2 * pair + 1, li = pair, k = r - 6;
    if (k == 0 && (PM & 256)) {
      gemm_phase<EPI_O1>(p, hbuf, (const bfu*)(p.ws + WS_WT_IN_O) + (size_t)li * ODD_IN * D, D, 96, 32, li, lds);
    } else if (k == 1 && (PM & 512)) {
      phase_attn_odd(p, l, lds);
    } else if (k == 2 && (PM & 1024)) {
      gemm_phase<EPI_Y>(p, hbuf, (const bfu*)(p.ws + WS_WT_OUT_O) + (size_t)li * D * D, D, 96, 8, li, lds);
    } else if (k == 3 && (PM & 2048)) {
      phase_rows(p, 1, l, lds);
    }
  }
}

constexpr int N_PHASES = 22;
constexpr int LDS_BYTES = 2 * ATT_HALF_LDS;

__global__ void __launch_bounds__(512, 2) fwd_megakernel(Params p) {
  __shared__ __attribute__((aligned(16))) char lds[LDS_BYTES];
  cg::grid_group grid = cg::this_grid();
  for (int ph = p.lo; ph < p.hi; ++ph) {
    run_phase(p, ph, lds);
    if (ph + 1 < p.hi) grid.sync();
  }
}

extern "C" void kernel_launch(void* const* d_in, const int* in_sizes, int n_in, void* d_out, int out_size, void* d_ws, size_t ws_size,
                              hipStream_t stream) {
  static int grid_blocks = 0;
  if (!grid_blocks) {
    int dev = 0, cus = 0, per_cu = 0;
    (void)hipGetDevice(&dev);
    (void)hipDeviceGetAttribute(&cus, hipDeviceAttributeMultiprocessorCount, dev);
    (void)hipOccupancyMaxActiveBlocksPerMultiprocessor(&per_cu, fwd_megakernel, 512, 0);
    if (per_cu < 1) per_cu = 1;
    per_cu = 1;
    grid_blocks = cus * per_cu;
    if (grid_blocks > 512) grid_blocks = 512;
  }
  if (n_in != 25 || ws_size < WS_NEED) {
    fprintf(stderr, "kernel_launch: bad n_in %d or ws_size %zu < %zu\n", n_in, ws_size, (size_t)WS_NEED);
    return;
  }
  Params p{};
  for (int i = 0; i < 25; ++i) p.in[i] = (const float*)d_in[i];
  p.out = (float*)d_out;
  p.ws = (char*)d_ws;
  p.lo = 0; p.hi = N_PHASES;
  void* args[] = {&p};
  hipError_t e = hipLaunchCooperativeKernel((void*)fwd_megakernel, dim3(grid_blocks), dim3(512), args, 0, stream);
  if (e != hipSuccess) fprintf(stderr, "cooperative launch failed: %s (grid %d)\n", hipGetErrorString(e), grid_blocks);
}
```

```cpp
#include <hip/hip_runtime.h>
#include <hip/hip_cooperative_groups.h>
#include <cstdio>
#include <cstdint>
namespace cg = cooperative_groups;

#define DI __device__ __forceinline__
typedef unsigned short bfu;
using bf16x8 = __attribute__((ext_vector_type(8))) short;
using s16x4  = __attribute__((ext_vector_type(4))) short;
using f32x16 = __attribute__((ext_vector_type(16))) float;
using f32x4  = __attribute__((ext_vector_type(4))) float;
using u32x4  = __attribute__((ext_vector_type(4))) unsigned;
using u32x2  = __attribute__((ext_vector_type(2))) unsigned;
typedef __bf16 bf2_t __attribute__((ext_vector_type(2)));
typedef float f2_t __attribute__((ext_vector_type(2)));

constexpr int D = 2048, TP = 8192, TS = 16384, T = 24576, TALL = 28672;
constexpr int EVEN_IN = 5952, ODD_IN = 8192;
constexpr float EPS = 1e-6f;
constexpr float LOG2E = 1.4426950408889634f;
constexpr float LOG2_ROPE = 13.287712379549449f;

constexpr size_t OUT_YP = 0, OUT_YS = 16777216, OUT_NAK = 50331648, OUT_NAV = 67108864, OUT_CKV = 83886080,
                 OUT_KPE = 88080384, OUT_DK = 89128960, OUT_DV = 122683392;

constexpr size_t al256(size_t x) { return (x + 255) / 256 * 256; }
constexpr size_t WS_WT_IN_E = 0;
constexpr int EVEN_PAD = 6144;
constexpr size_t WS_WT_IN_O = WS_WT_IN_E + al256((size_t)2 * EVEN_PAD * D * 2);
constexpr size_t WS_WT_OUT_E = WS_WT_IN_O + al256((size_t)2 * ODD_IN * D * 2);
constexpr size_t WS_WT_OUT_O = WS_WT_OUT_E + al256((size_t)2 * D * D * 2);
constexpr size_t WS_WT_UQ = WS_WT_OUT_O + al256((size_t)2 * D * D * 2);
constexpr size_t WS_WT_UKV = WS_WT_UQ + al256((size_t)2 * 1536 * 512 * 2);
constexpr size_t WS_C_NAK = WS_WT_UKV + al256((size_t)2 * 2048 * 256 * 2);
constexpr size_t WS_C_NAV = WS_C_NAK + al256((size_t)8 * 2 * 512 * 1024 * 2);
constexpr size_t WS_C_DK = WS_C_NAV + al256((size_t)8 * 2 * 512 * 1024 * 2);
constexpr size_t WS_C_DV = WS_C_DK + al256((size_t)8 * 2 * 512 * 2048 * 2);
constexpr size_t WS_MODP = WS_C_DV + al256((size_t)8 * 2 * 512 * 2048 * 2);
constexpr size_t WS_HBUF = WS_MODP + al256((size_t)4 * 4 * 9 * 6144 * 4);
constexpr size_t WS_CQN = WS_HBUF;
constexpr size_t WS_CKVN = WS_HBUF + al256((size_t)T * 512 * 2);
constexpr size_t WS_PBUF = WS_HBUF + al256((size_t)T * D * 2);
constexpr size_t WS_YBUF = WS_PBUF;
constexpr size_t WS_QM = WS_PBUF + al256((size_t)T * EVEN_IN * 2);
constexpr size_t WS_KMLA = WS_QM + al256((size_t)T * 1536 * 2);
constexpr size_t WS_VMLA = WS_KMLA + al256((size_t)TALL * 1536 * 2);
constexpr size_t WS_END_EVEN = WS_VMLA + al256((size_t)TALL * 1024 * 2);
constexpr size_t WS_SCR = WS_PBUF + al256((size_t)T * ODD_IN * 2);
constexpr size_t WS_END_ODD = WS_SCR + (size_t)1024 * 131072;
constexpr size_t WS_NEED = WS_END_EVEN > WS_END_ODD ? WS_END_EVEN : WS_END_ODD;

struct Params {
  const float* in[25];
  float* out;
  char* ws;
  int lo, hi;
};

DI unsigned cvtpk(float lo, float hi) {
  f2_t v = {lo, hi};
  bf2_t b = __builtin_convertvector(v, bf2_t);
  return __builtin_bit_cast(unsigned, b);
}
DI bfu f2bf(float x) { return (bfu)(cvtpk(x, 0.f) & 0xffffu); }
DI float bf2f(bfu b) { return __uint_as_float(((unsigned)b) << 16); }
DI float bflo(unsigned u) { return __uint_as_float(u << 16); }
DI float bfhi(unsigned u) { return __uint_as_float(u & 0xffff0000u); }
DI int opaque(int x) { asm volatile("" : "+v"(x)); return x; }
DI int crow(int r, int hi) { return (r & 3) + 8 * (r >> 2) + 4 * hi; }
DI float silu(float x) { return x / (1.f + __expf(-x)); }
DI f32x16 mfma(bf16x8 a, bf16x8 b, f32x16 c) { return __builtin_amdgcn_mfma_f32_32x32x16_bf16(a, b, c, 0, 0, 0); }
DI float wave_sum(float v) {
#pragma unroll
  for (int o = 32; o >= 1; o >>= 1) v += __shfl_xor(v, o);
  return v;
}
DI float block_sum(float v, float* red, int tid) {
  v = wave_sum(v);
  __syncthreads();
  if ((tid & 63) == 0) red[tid >> 6] = v;
  __syncthreads();
  const int hb = (tid >> 8) * 4;
  return red[hb] + red[hb + 1] + red[hb + 2] + red[hb + 3];
}
DI float modval(const Params& p, int l, int r, int n) {
  const float* mp = (const float*)(p.ws + WS_MODP);
  float s = p.in[11][l * 6144 + n];
#pragma unroll
  for (int ks = 0; ks < 4; ++ks) s += mp[((size_t)(ks * 4 + l) * 9 + r) * 6144 + n];
  return s;
}

DI void prep_mod_item(const Params& p, int item, char* lds) {
  const int tid = opaque(threadIdx.x), lane = tid & 63, wid = tid >> 6;
  const int ks = item & 3, cgp = (item >> 2) % 24, l = item / 96;
  float* scond = (float*)lds;
  float* red = (float*)(lds + 18432);
  for (int idx = tid; idx < 9 * 512; idx += 512) {
    int r = idx >> 9, kk = idx & 511;
    float cv = r < 8 ? p.in[8][r * 2048 + ks * 512 + kk] : p.in[9][ks * 512 + kk];
    scond[idx] = silu(cv);
  }
  __syncthreads();
  const float* W = p.in[10] + ((size_t)l * 2048 + ks * 512 + wid * 64) * 6144 + cgp * 256 + lane * 4;
  float acc[9][4];
#pragma unroll
  for (int r = 0; r < 9; ++r) { acc[r][0] = 0; acc[r][1] = 0; acc[r][2] = 0; acc[r][3] = 0; }
  for (int kk = 0; kk < 64; kk += 4) {
    f32x4 w[4];
#pragma unroll
    for (int u = 0; u < 4; ++u) w[u] = *(const f32x4*)(W + (size_t)(kk + u) * 6144);
#pragma unroll
    for (int u = 0; u < 4; ++u) {
#pragma unroll
      for (int r = 0; r < 9; ++r) {
        float s = scond[r * 512 + wid * 64 + kk + u];
        acc[r][0] += s * w[u][0]; acc[r][1] += s * w[u][1]; acc[r][2] += s * w[u][2]; acc[r][3] += s * w[u][3];
      }
    }
  }
#pragma unroll
  for (int r = 0; r < 9; ++r) {
    f32x4 v = {acc[r][0], acc[r][1], acc[r][2], acc[r][3]};
    *(f32x4*)(red + (wid * 9 + r) * 256 + lane * 4) = v;
  }
  __syncthreads();
  float* mp = (float*)(p.ws + WS_MODP);
  for (int idx = tid; idx < 9 * 256; idx += 512) {
    int r = idx >> 8, cc = idx & 255;
    float s = 0.f;
#pragma unroll
    for (int w = 0; w < 8; ++w) s += red[(w * 9 + r) * 256 + cc];
    mp[((size_t)(ks * 4 + l) * 9 + r) * 6144 + cgp * 256 + cc] = s;
  }
  __syncthreads();
}

DI int swap45(int n) { return (n & ~0x30) | ((n & 0x10) << 1) | ((n & 0x20) >> 1); }

DI void prep_transpose_tile(const float* __restrict__ src, bfu* __restrict__ dst, int K, int N, int k0, int n0, char* lds, int tid) {
  float* tl = (float*)lds + (tid >> 8) * (64 * 65);
  const int t4 = tid & 255;
#pragma unroll
  for (int i = 0; i < 4; ++i) {
    int kr = (t4 >> 4) + 16 * i, nc = (t4 & 15) * 4;
    f32x4 v = *(const f32x4*)(src + (size_t)(k0 + kr) * N + n0 + nc);
    tl[kr * 65 + nc + 0] = v[0]; tl[kr * 65 + nc + 1] = v[1]; tl[kr * 65 + nc + 2] = v[2]; tl[kr * 65 + nc + 3] = v[3];
  }
  __syncthreads();
  {
    int n = t4 >> 2, kseg = (t4 & 3) * 16;
    unsigned w[8];
#pragma unroll
    for (int e = 0; e < 8; ++e) w[e] = cvtpk(tl[(kseg + 2 * e) * 65 + n], tl[(kseg + 2 * e + 1) * 65 + n]);
    u32x4 a = {w[0], w[1], w[2], w[3]}, b = {w[4], w[5], w[6], w[7]};
    bfu* d = dst + (size_t)swap45(n0 + n) * K + k0 + kseg;
    *(u32x4*)d = a; *(u32x4*)(d + 8) = b;
  }
  __syncthreads();
}

DI void phase_prep(const Params& p, char* lds) {
  constexpr int N_MOD = 384, N_TR_L = 9440, N_TRP = N_TR_L, N_CV = 1536;
  for (int item = blockIdx.x; item < N_MOD + N_TRP + N_CV; item += gridDim.x) {
    if (item < N_MOD) { prep_mod_item(p, item, lds); continue; }
    const int tid = opaque(threadIdx.x);
    int it = item - N_MOD;
    if (it < N_TRP) {
      int tl = it * 2 + (tid >> 8);
      int i = tl / N_TR_L, r = tl % N_TR_L;
      const float* src; bfu* dst; int K, N;
      if (r < 2976) { src = p.in[14] + (size_t)i * 2048 * EVEN_IN; dst = (bfu*)(p.ws + WS_WT_IN_E) + (size_t)i * EVEN_PAD * 2048; K = 2048; N = EVEN_IN; }
      else if ((r -= 2976) < 1024) { src = p.in[15] + (size_t)i * 2048 * 2048; dst = (bfu*)(p.ws + WS_WT_OUT_E) + (size_t)i * 2048 * 2048; K = 2048; N = 2048; }
      else if ((r -= 1024) < 192) { src = p.in[18] + (size_t)i * 512 * 1536; dst = (bfu*)(p.ws + WS_WT_UQ) + (size_t)i * 1536 * 512; K = 512; N = 1536; }
      else if ((r -= 192) < 128) { src = p.in[20] + (size_t)i * 256 * 2048; dst = (bfu*)(p.ws + WS_WT_UKV) + (size_t)i * 2048 * 256; K = 256; N = 2048; }
      else if ((r -= 128) < 4096) { src = p.in[21] + (size_t)i * 2048 * ODD_IN; dst = (bfu*)(p.ws + WS_WT_IN_O) + (size_t)i * ODD_IN * 2048; K = 2048; N = ODD_IN; }
      else { r -= 4096; src = p.in[22] + (size_t)i * 2048 * 2048; dst = (bfu*)(p.ws + WS_WT_OUT_O) + (size_t)i * 2048 * 2048; K = 2048; N = 2048; }
      int nN = N / 64;
      int kt = r / nN, nt = r % nN;
      prep_transpose_tile(src, dst, K, N, kt * 64, nt * 64, lds, tid);
      continue;
    }
    it -= N_TRP;
    {
      size_t ch = (size_t)it * 4096;
      const float* src; bfu* dst;
      if (ch < 1048576) { src = p.in[2]; dst = (bfu*)(p.ws + WS_C_NAK); }
      else if ((ch -= 1048576) < 1048576) { src = p.in[3]; dst = (bfu*)(p.ws + WS_C_NAV); }
      else if ((ch -= 1048576) < 2097152) { src = p.in[6]; dst = (bfu*)(p.ws + WS_C_DK); }
      else { ch -= 2097152; src = p.in[7]; dst = (bfu*)(p.ws + WS_C_DV); }
#pragma unroll
      for (int u = 0; u < 8; ++u) {
        size_t c = ch + u * 512 + tid;
        f32x4 a = *(const f32x4*)(src + c * 8), b = *(const f32x4*)(src + c * 8 + 4);
        u32x4 w = {cvtpk(a[0], a[1]), cvtpk(a[2], a[3]), cvtpk(b[0], b[1]), cvtpk(b[2], b[3])};
        *(u32x4*)(dst + c * 8) = w;
      }
    }
  }
}

DI void phase_rows(const Params& p, int kind, int l, char* lds) {
  float* red = (float*)lds;
  const int tid = opaque(threadIdx.x), col = (tid & 255) * 8;
  const int rows_per = ((T / 2 + gridDim.x - 1) / gridDim.x) * 2;
  const int t_begin = blockIdx.x * rows_per;
  const int t_end = min(T, t_begin + rows_per);
  const int ln = kind == 0 ? 0 : l + 1;
  const bool do_h = ln < 4;
  int cur_r = -1;
  float sc[8], sh[8], gp[8], gate[8], gpo[8];
  bfu* hbuf = (bfu*)(p.ws + WS_HBUF);
  const float* ybuf = (const float*)(p.ws + WS_YBUF);
  for (int tt = t_begin; tt < t_end; tt += 2) {
    const int t = tt + (tid >> 8);
    const int r = t < TP ? 8 : (t - TP) >> 11;
    if (r != cur_r) {
      cur_r = r;
#pragma unroll
      for (int e = 0; e < 8; ++e) {
        if (do_h) {
          sh[e] = modval(p, ln, r, col + e);
          sc[e] = 1.f + modval(p, ln, r, 2048 + col + e);
          gp[e] = p.in[12][ln * 2048 + col + e];
        }
        if (kind == 1) {
          gate[e] = modval(p, l, r, 4096 + col + e);
          gpo[e] = p.in[13][l * 2048 + col + e];
        }
      }
    }
    const float* xin = (kind == 0 || l == 0) ? (t < TP ? p.in[0] + (size_t)t * D : p.in[1] + (size_t)(t - TP) * D) : p.out + (size_t)t * D;
    float x[8];
    { f32x4 a = *(const f32x4*)(xin + col), b = *(const f32x4*)(xin + col + 4);
      x[0] = a[0]; x[1] = a[1]; x[2] = a[2]; x[3] = a[3]; x[4] = b[0]; x[5] = b[1]; x[6] = b[2]; x[7] = b[3]; }
    if (kind == 1) {
      float y[8];
      { f32x4 a = *(const f32x4*)(ybuf + (size_t)t * D + col), b = *(const f32x4*)(ybuf + (size_t)t * D + col + 4);
        y[0] = a[0]; y[1] = a[1]; y[2] = a[2]; y[3] = a[3]; y[4] = b[0]; y[5] = b[1]; y[6] = b[2]; y[7] = b[3]; }
      float ss = 0;
#pragma unroll
      for (int e = 0; e < 8; ++e) ss += y[e] * y[e];
      ss = block_sum(ss, red, tid);
      float rstd = rsqrtf(ss * (1.f / 2048.f) + EPS);
#pragma unroll
      for (int e = 0; e < 8; ++e) x[e] = x[e] + gate[e] * (y[e] * rstd * gpo[e]);
      f32x4 a = {x[0], x[1], x[2], x[3]}, b = {x[4], x[5], x[6], x[7]};
      *(f32x4*)(p.out + (size_t)t * D + col) = a; *(f32x4*)(p.out + (size_t)t * D + col + 4) = b;
    }
    if (do_h) {
      float ss = 0;
#pragma unroll
      for (int e = 0; e < 8; ++e) ss += x[e] * x[e];
      ss = block_sum(ss, red, tid);
      float rstd = rsqrtf(ss * (1.f / 2048.f) + EPS);
      float h[8];
#pragma unroll
      for (int e = 0; e < 8; ++e) h[e] = x[e] * rstd * gp[e] * sc[e] + sh[e];
      u32x4 w = {cvtpk(h[0], h[1]), cvtpk(h[2], h[3]), cvtpk(h[4], h[5]), cvtpk(h[6], h[7])};
      *(u32x4*)(hbuf + (size_t)t * D + col) = w;
    }
  }
}

constexpr int GBM = 256, GBK = 64, GHALF = 128, GHT = GHALF * GBK;
enum { EPI_E1 = 0, EPI_O1 = 1, EPI_QM = 2, EPI_KV = 3, EPI_Y = 4 };

DI int lds_byte(int r, int c) {
  int st = (r >> 4) * 2 + (c >> 5), rr = r & 15, cc = c & 31, ob = rr * 64 + cc * 2;
  return st * 1024 + (ob ^ (((ob >> 9) & 1) << 5));
}
DI void stage_rc(int b, int& R, int& C) {
  int st = b / 1024, sb = b % 1024, swz = sb ^ (((sb >> 9) & 1) << 5);
  R = (st >> 1) * 16 + swz / 64; C = (st & 1) * 32 + (swz % 64) / 2;
}

template <int EPI>
DI void gemm256(const Params& p, const bfu* __restrict__ A, const bfu* __restrict__ Bt, const int K, const int brow, const int bcol,
                const int li, char* lds) {
  const int tid = opaque(threadIdx.x);
  bfu* shm = (bfu*)lds;
#define SA(b, h) (shm + ((b) * 2 + (h)) * GHT)
#define SB(b, h) (shm + (4 + (b) * 2 + (h)) * GHT)
#define STAGE(P_, BASE, br, kt) do { long _g = (long)(br) * K + (long)(kt) * GBK;                          \
    for (int _i = 0; _i < 2; ++_i) { int _b = tid * 16 + _i * 8192; int _r, _c; stage_rc(_b, _r, _c);      \
      __builtin_amdgcn_global_load_lds((const unsigned*)(BASE + _g + (long)_r * K + _c),                    \
        (__attribute__((address_space(3))) unsigned*)((char*)(P_) + _b), 16, 0, 0); } } while (0)
#define LDA(dst, b, h) for (int m = 0; m < 4; ++m) for (int k = 0; k < 2; ++k)                              \
    dst[m][k] = *reinterpret_cast<const bf16x8*>((char*)SA(b, h) + lds_byte(wr * 64 + m * 16 + fr, k * 32 + fq * 8))
#define LDB(dst, b, h) for (int n = 0; n < 2; ++n) for (int k = 0; k < 2; ++k)                              \
    dst[n][k] = *reinterpret_cast<const bf16x8*>((char*)SB(b, h) + lds_byte(wc * 32 + n * 16 + fr, k * 32 + fq * 8))
#define MMA(ai, bj, At_, Bt_) do { __builtin_amdgcn_s_setprio(1);                                            \
    for (int m = 0; m < 4; ++m) for (int n = 0; n < 2; ++n) for (int k = 0; k < 2; ++k)                      \
      acc[ai][bj][m][n] = __builtin_amdgcn_mfma_f32_16x16x32_bf16(At_[m][k], Bt_[n][k], acc[ai][bj][m][n], 0, 0, 0); \
    __builtin_amdgcn_s_setprio(0); } while (0)
#define WAIT_V(n) asm volatile("s_waitcnt vmcnt(" #n ")" ::: "memory")
#define WAIT_L(n) asm volatile("s_waitcnt lgkmcnt(" #n ")" ::: "memory")
#define BAR __builtin_amdgcn_s_barrier()
#define SCHED __builtin_amdgcn_sched_barrier(0)
  const int wid = tid >> 6, lane = tid & 63, wr = wid >> 2, wc = wid & 3, fr = lane & 15, fq = lane >> 4;
  f32x4 acc[2][2][4][2];
#pragma unroll
  for (int a_ = 0; a_ < 2; ++a_)
#pragma unroll
    for (int b_ = 0; b_ < 2; ++b_)
#pragma unroll
      for (int m = 0; m < 4; ++m)
#pragma unroll
        for (int n = 0; n < 2; ++n) { acc[a_][b_][m][n][0] = 0.f; acc[a_][b_][m][n][1] = 0.f; acc[a_][b_][m][n][2] = 0.f; acc[a_][b_][m][n][3] = 0.f; }
  bf16x8 At[4][2], B0[2][2], B1[2][2];
  const int nt = K / GBK;
  WAIT_V(0); BAR;
  STAGE(SB(0, 0), Bt, bcol, 0); STAGE(SA(0, 0), A, brow, 0);
  STAGE(SB(0, 1), Bt, bcol + GHALF, 0); STAGE(SA(0, 1), A, brow + GHALF, 0);
  if (wr == 1) BAR;
  WAIT_V(4); BAR;
  STAGE(SB(1, 0), Bt, bcol, 1); STAGE(SA(1, 0), A, brow, 1); STAGE(SB(1, 1), Bt, bcol + GHALF, 1);
  WAIT_V(6); BAR;
  for (int t = 0; t < nt - 2; t += 2) {
    LDB(B0, 0, 0); SCHED; LDA(At, 0, 0); STAGE(SA(1, 1), A, brow + GHALF, t + 1);
    WAIT_L(8); BAR; WAIT_L(0); MMA(0, 0, At, B0); BAR; SCHED;
    LDB(B1, 0, 1); STAGE(SB(0, 0), Bt, bcol, t + 2);
    BAR; WAIT_L(0); MMA(0, 1, At, B1); BAR;
    LDA(At, 0, 1); STAGE(SA(0, 0), A, brow, t + 2);
    BAR; WAIT_L(0); MMA(1, 0, At, B0); BAR; SCHED;
    STAGE(SB(0, 1), Bt, bcol + GHALF, t + 2);
    WAIT_V(6); BAR; MMA(1, 1, At, B1); BAR;
    LDB(B0, 1, 0); SCHED; LDA(At, 1, 0); STAGE(SA(0, 1), A, brow + GHALF, t + 2);
    WAIT_L(8); BAR; WAIT_L(0); MMA(0, 0, At, B0); BAR; SCHED;
    LDB(B1, 1, 1); STAGE(SB(1, 0), Bt, bcol, t + 3);
    BAR; WAIT_L(0); MMA(0, 1, At, B1); BAR;
    LDA(At, 1, 1); STAGE(SA(1, 0), A, brow, t + 3);
    BAR; WAIT_L(0); MMA(1, 0, At, B0); BAR; SCHED;
    STAGE(SB(1, 1), Bt, bcol + GHALF, t + 3);
    WAIT_V(6); BAR; MMA(1, 1, At, B1); BAR;
  }
  { LDB(B0, 0, 0); LDA(At, 0, 0); STAGE(SA(1, 1), A, brow + GHALF, nt - 1);
    BAR; WAIT_L(0); MMA(0, 0, At, B0); BAR;
    LDB(B1, 0, 1); BAR; WAIT_L(0); MMA(0, 1, At, B1); BAR;
    LDA(At, 0, 1); WAIT_V(4); BAR; WAIT_L(0); MMA(1, 0, At, B0); MMA(1, 1, At, B1); BAR; }
  { LDB(B0, 1, 0); LDA(At, 1, 0); WAIT_V(2); BAR; WAIT_L(0); MMA(0, 0, At, B0); BAR;
    LDB(B1, 1, 1); WAIT_V(0); BAR; WAIT_L(0); MMA(0, 1, At, B1); BAR;
    LDA(At, 1, 1); BAR; WAIT_L(0); MMA(1, 0, At, B0); MMA(1, 1, At, B1); BAR; }
  if (wr == 0) BAR;
#undef SA
#undef SB
#undef STAGE
#undef LDA
#undef LDB
#undef MMA
#undef WAIT_V
#undef WAIT_L
#undef BAR
#undef SCHED

  const int jr = (wc & 1) * 16 + fr;
  if constexpr (EPI == EPI_O1) {
    if (brow >= TP && bcol < 4096) {
      const float inv = exp2f(-(float)jr * (LOG2_ROPE / 32.f));
      const bool colrope = (wc >> 1) & 1;
#pragma unroll
      for (int ai = 0; ai < 2; ++ai)
#pragma unroll
        for (int m = 0; m < 4; ++m)
#pragma unroll
          for (int j = 0; j < 4; ++j) {
            int row = brow + ai * 128 + wr * 64 + m * 16 + fq * 4 + j;
            int s = (row - TP) & 2047;
            float ang = (float)(colrope ? (s & 63) : (s >> 6)) * inv;
            float cs = __cosf(ang), sn = __sinf(ang);
#pragma unroll
            for (int bj = 0; bj < 2; ++bj) {
              float x1 = acc[ai][bj][m][0][j], x2 = acc[ai][bj][m][1][j];
              acc[ai][bj][m][0][j] = x1 * cs - x2 * sn;
              acc[ai][bj][m][1][j] = x2 * cs + x1 * sn;
            }
          }
    }
  }
#pragma unroll
  for (int ai = 0; ai < 2; ++ai)
#pragma unroll
    for (int bj = 0; bj < 2; ++bj)
#pragma unroll
      for (int n = 0; n < 2; ++n) {
        const int colg = bcol + bj * 128 + (wc >> 1) * 64 + n * 32 + (wc & 1) * 16;
        const int col = colg + fr;
#pragma unroll
        for (int m = 0; m < 4; ++m)
#pragma unroll
          for (int j = 0; j < 4; ++j) {
            const int row = brow + ai * 128 + wr * 64 + m * 16 + fq * 4 + j;
            const float v = acc[ai][bj][m][n][j];
            if constexpr (EPI == EPI_E1) {
              if (colg < EVEN_IN) {
                ((bfu*)(p.ws + WS_PBUF))[(size_t)row * EVEN_IN + col] = f2bf(v);
                if (brow < TP) {
                  size_t orow = (size_t)((row >> 8) * 2 + li) * 256 + (row & 255);
                  if (colg >= 1024 && colg < 2048) p.out[OUT_NAK + orow * 1024 + (col - 1024)] = v;
                  else if (colg >= 2048 && colg < 3072) p.out[OUT_NAV + orow * 1024 + (col - 2048)] = v;
                  else if (colg >= 4864 && colg < 4928) p.out[OUT_KPE + orow * 64 + (col - 4864)] = v;
                }
              }
            } else if constexpr (EPI == EPI_O1) {
              ((bfu*)(p.ws + WS_PBUF))[(size_t)row * ODD_IN + col] = f2bf(v);
              if (brow < TP) {
                size_t orow = (size_t)((row >> 8) * 2 + li) * 256 + (row & 255);
                if (colg >= 2048 && colg < 4096) p.out[OUT_DK + orow * 2048 + (col - 2048)] = v;
                else if (colg >= 4096 && colg < 6144) p.out[OUT_DV + orow * 2048 + (col - 4096)] = v;
              }
            } else if constexpr (EPI == EPI_QM) {
              ((bfu*)(p.ws + WS_QM))[(size_t)row * 1536 + col] = f2bf(v);
            } else if constexpr (EPI == EPI_KV) {
              int hd = col >> 8, jj = col & 255;
              if (jj < 128) ((bfu*)(p.ws + WS_KMLA))[(size_t)row * 1536 + hd * 192 + jj] = f2bf(v);
              else ((bfu*)(p.ws + WS_VMLA))[(size_t)row * 1024 + hd * 128 + (jj - 128)] = f2bf(v);
            } else {
              ((float*)(p.ws + WS_YBUF))[(size_t)row * D + col] = v;
            }
          }
      }
}

DI int tile_id(int it) {
  const int G = gridDim.x;
  const int pb = (G & 7) == 0 ? (blockIdx.x & 7) * (G >> 3) + (blockIdx.x >> 3) : blockIdx.x;
  return it * G + pb;
}
DI void tile_mn(int id, int nN, int& m, int& n) {
  int grp = id / (8 * nN), rem = id % (8 * nN);
  m = grp * 8 + (rem & 7); n = rem >> 3;
}

DI void phase_mid(const Params& p, int li) {
  const int tid = opaque(threadIdx.x), lane = tid & 63, wid = tid >> 6;
  const bfu* P = (const bfu*)(p.ws + WS_PBUF);
  bfu* cqn = (bfu*)(p.ws + WS_CQN);
  bfu* ckvn = (bfu*)(p.ws + WS_CKVN);
  bfu* kmla = (bfu*)(p.ws + WS_KMLA);
  const float* gq = p.in[17] + li * 512;
  const float* gkv = p.in[19] + li * 256;
  for (int t = blockIdx.x * 8 + wid; t < TALL; t += gridDim.x * 8) {
    float kp;
    if (t < T) {
      const bfu* Pr = P + (size_t)t * EVEN_IN;
      {
        u32x4 w = *(const u32x4*)(Pr + 4096 + lane * 8);
        float v[8] = {bflo(w[0]), bfhi(w[0]), bflo(w[1]), bfhi(w[1]), bflo(w[2]), bfhi(w[2]), bflo(w[3]), bfhi(w[3])};
        float ss = 0;
#pragma unroll
        for (int e = 0; e < 8; ++e) ss += v[e] * v[e];
        ss = wave_sum(ss);
        float rstd = rsqrtf(ss * (1.f / 512.f) + EPS);
#pragma unroll
        for (int e = 0; e < 8; ++e) v[e] = v[e] * rstd * gq[lane * 8 + e];
        u32x4 o = {cvtpk(v[0], v[1]), cvtpk(v[2], v[3]), cvtpk(v[4], v[5]), cvtpk(v[6], v[7])};
        *(u32x4*)(cqn + (size_t)t * 512 + lane * 8) = o;
      }
      {
        u32x2 w = *(const u32x2*)(Pr + 4608 + lane * 4);
        float v[4] = {bflo(w[0]), bfhi(w[0]), bflo(w[1]), bfhi(w[1])};
        float ss = v[0] * v[0] + v[1] * v[1] + v[2] * v[2] + v[3] * v[3];
        ss = wave_sum(ss);
        float rstd = rsqrtf(ss * (1.f / 256.f) + EPS);
#pragma unroll
        for (int e = 0; e < 4; ++e) v[e] = v[e] * rstd * gkv[lane * 4 + e];
        u32x2 o = {cvtpk(v[0], v[1]), cvtpk(v[2], v[3])};
        *(u32x2*)(ckvn + (size_t)t * 256 + lane * 4) = o;
        if (t < TP) {
          size_t orow = (size_t)((t >> 8) * 2 + li) * 256 + (t & 255);
          f32x4 f = {v[0], v[1], v[2], v[3]};
          *(f32x4*)(p.out + OUT_CKV + orow * 256 + lane * 4) = f;
        }
      }
      kp = bf2f(Pr[4864 + lane]);
      if (t >= TP) {
        int s = (t - TP) & 2047;
        float pos = (float)(lane < 32 ? (s >> 6) : (s & 63));
        int jj = lane & 15;
        float inv = exp2f(-(float)jj * (LOG2_ROPE / 16.f));
        float ang = pos * inv;
        float cs = __cosf(ang), sn = __sinf(ang);
        float pv = __shfl_xor(kp, 16);
        kp = (lane & 16) ? (kp * cs + pv * sn) : (kp * cs - pv * sn);
      }
    } else {
      int ci = t - T;
      int b = ci >> 9, j = ci & 511;
      size_t crow_ = (size_t)(b * 2 + li) * 512 + j;
      f32x4 f = *(const f32x4*)(p.in[4] + crow_ * 256 + lane * 4);
      u32x2 o = {cvtpk(f[0], f[1]), cvtpk(f[2], f[3])};
      *(u32x2*)(ckvn + (size_t)t * 256 + lane * 4) = o;
      kp = p.in[5][crow_ * 64 + lane];
    }
    bfu kb = f2bf(kp);
#pragma unroll
    for (int hd = 0; hd < 8; ++hd) kmla[(size_t)t * 1536 + hd * 192 + 128 + lane] = kb;
  }
}

struct Seg { const bfu* K; const bfu* V; int ldk, ldv, n; };
constexpr int ATT_KB = 24576, ATT_VB = 16384, ATT_BUF = ATT_KB + ATT_VB;
constexpr int ATT_BIAS_OFF = 2 * ATT_BUF;
constexpr int ATT_TR_ROW = 132;

template <int DQK>
DI void attn_issue(const int tid, const bfu* __restrict__ Kp, const bfu* __restrict__ Vp, int ldk, int ldv, char* buf) {
  constexpr int KROWB = DQK * 2;
#pragma unroll
  for (int i = 0; i < DQK / 64; ++i) {
    int bb = i * 8192 + tid * 16, row = bb / KROWB, cpos = (bb % KROWB) >> 4, c = cpos ^ (row & 7);
    __builtin_amdgcn_global_load_lds((const unsigned*)(Kp + (size_t)row * ldk + c * 8),
                                     (__attribute__((address_space(3))) unsigned*)(buf + bb), 16, 0, 0);
  }
#pragma unroll
  for (int i = 0; i < 2; ++i) {
    int bb = i * 8192 + tid * 16, row = bb >> 8, cpos = (bb & 255) >> 4, c = cpos ^ ((row & 3) << 2);
    __builtin_amdgcn_global_load_lds((const unsigned*)(Vp + (size_t)row * ldv + c * 8),
                                     (__attribute__((address_space(3))) unsigned*)(buf + ATT_KB + bb), 16, 0, 0);
  }
}

template <int DQK, bool NA, bool ROPEQ>
DI void attn_core(const int tid, f32x16* o, const bfu* __restrict__ Qrow, const Seg& s0, const Seg& s1, float C, char* lds,
                  int gr, int gc, int kr0, float prow, float pcol) {
  constexpr int KROWB = DQK * 2;
  constexpr int ND = DQK / 16;
  const int lane = tid & 63, r32 = lane & 31, hh = lane >> 5;
  const float* sbias = (const float*)(lds + ATT_BIAS_OFF);
  const int nt0 = s0.n >> 6, ntile = nt0 + (s1.n >> 6);
  __syncthreads();
  attn_issue<DQK>(tid, s0.K, s0.V, s0.ldk, s0.ldv, lds);
  bf16x8 qr[ND];
#pragma unroll
  for (int d0 = 0; d0 < ND; ++d0) qr[d0] = *(const bf16x8*)(Qrow + d0 * 16);
  if constexpr (ROPEQ) {
#pragma unroll
    for (int pr = 0; pr < 2; ++pr) {
      float pos = pr == 0 ? prow : pcol;
      bf16x8 a = qr[8 + 2 * pr], b = qr[9 + 2 * pr];
      float xa[8], xb[8];
#pragma unroll
      for (int e = 0; e < 8; ++e) {
        float inv = exp2f(-(float)(8 * hh + e) * (LOG2_ROPE / 16.f));
        float ang = pos * inv;
        float cs = __cosf(ang), sn = __sinf(ang);
        float x1 = bf2f((bfu)a[e]), x2 = bf2f((bfu)b[e]);
        xa[e] = x1 * cs - x2 * sn; xb[e] = x2 * cs + x1 * sn;
      }
      u32x4 wa = {cvtpk(xa[0], xa[1]), cvtpk(xa[2], xa[3]), cvtpk(xa[4], xa[5]), cvtpk(xa[6], xa[7])};
      u32x4 wb = {cvtpk(xb[0], xb[1]), cvtpk(xb[2], xb[3]), cvtpk(xb[4], xb[5]), cvtpk(xb[6], xb[7])};
      qr[8 + 2 * pr] = __builtin_bit_cast(bf16x8, wa); qr[9 + 2 * pr] = __builtin_bit_cast(bf16x8, wb);
    }
  }
#pragma unroll
  for (int d = 0; d < 4; ++d)
#pragma unroll
    for (int r = 0; r < 16; ++r) o[d][r] = 0.f;
  float m = -1e30f, l = 0.f;
  const int rs = min(max(gr - 4, 0), 24), cs_ = min(max(gc - 8, 0), 48);
  int kad[4];
#pragma unroll
  for (int q = 0; q < 4; ++q) kad[q] = r32 * KROWB + (((q * 2 + hh) ^ (r32 & 7)) << 4);
  const int q_ = (lane & 15) >> 2;
  int vad[4];
#pragma unroll
  for (int d = 0; d < 4; ++d) vad[d] = ATT_KB + (hh * 4 + q_) * 256 + ((d ^ q_) << 6) + (16 * ((lane >> 4) & 1) + 4 * (lane & 3)) * 2;
  for (int j = 0; j < ntile; ++j) {
    asm volatile("s_waitcnt vmcnt(0)" ::: "memory");
    __builtin_amdgcn_s_barrier();
    if (j + 1 < ntile) {
      const int jn = j + 1;
      const bool in0 = jn < nt0;
      const bfu* Kp = in0 ? s0.K + (size_t)(jn * 64) * s0.ldk : s1.K + (size_t)((jn - nt0) * 64) * s1.ldk;
      const bfu* Vp = in0 ? s0.V + (size_t)(jn * 64) * s0.ldv : s1.V + (size_t)((jn - nt0) * 64) * s1.ldv;
      attn_issue<DQK>(tid, Kp, Vp, in0 ? s0.ldk : s1.ldk, in0 ? s0.ldv : s1.ldv, lds + (jn & 1) * ATT_BUF);
    }
    const char* buf = lds + (j & 1) * ATT_BUF;
    f32x16 p0, p1;
#pragma unroll
    for (int r = 0; r < 16; ++r) { p0[r] = 0.f; p1[r] = 0.f; }
#pragma unroll
    for (int d0 = 0; d0 < ND; ++d0) {
      bf16x8 k0 = *(const bf16x8*)(buf + kad[d0 & 3] + (d0 >> 2) * 128);
      bf16x8 k1 = *(const bf16x8*)(buf + kad[d0 & 3] + (d0 >> 2) * 128 + 32 * KROWB);
      p0 = mfma(k0, qr[d0], p0);
      p1 = mfma(k1, qr[d0], p1);
    }
    if (NA && j >= nt0) {
      const int kr = kr0 + (j - nt0);
      const bool rowok = (kr >= rs) && (kr < rs + 8);
      const int brow = (kr - gr + 7) * 31 - gc + 15;
#pragma unroll
      for (int r = 0; r < 16; ++r) {
        int kc0 = crow(r, hh), kc1 = 32 + kc0;
        bool ok0 = rowok && (kc0 >= cs_) && (kc0 < cs_ + 16);
        bool ok1 = rowok && (kc1 >= cs_) && (kc1 < cs_ + 16);
        float b0 = sbias[ok0 ? brow + kc0 : 0], b1 = sbias[ok1 ? brow + kc1 : 0];
        p0[r] = ok0 ? p0[r] * C + b0 : -1e30f;
        p1[r] = ok1 ? p1[r] * C + b1 : -1e30f;
      }
    } else {
#pragma unroll
      for (int r = 0; r < 16; ++r) { p0[r] *= C; p1[r] *= C; }
    }
    float mx = p0[0];
#pragma unroll
    for (int r = 1; r < 16; ++r) mx = fmaxf(mx, p0[r]);
#pragma unroll
    for (int r = 0; r < 16; ++r) mx = fmaxf(mx, p1[r]);
    mx = fmaxf(mx, __shfl_xor(mx, 32));
    const float mn = fmaxf(m, mx);
    const float alpha = __builtin_amdgcn_exp2f(m - mn);
    m = mn;
    float ps = 0.f;
#pragma unroll
    for (int r = 0; r < 16; ++r) { p0[r] = __builtin_amdgcn_exp2f(p0[r] - mn); ps += p0[r]; }
#pragma unroll
    for (int r = 0; r < 16; ++r) { p1[r] = __builtin_amdgcn_exp2f(p1[r] - mn); ps += p1[r]; }
    ps += __shfl_xor(ps, 32);
    l = l * alpha + ps;
    if (__any(alpha != 1.f)) {
#pragma unroll
      for (int d = 0; d < 4; ++d)
#pragma unroll
        for (int r = 0; r < 16; ++r) o[d][r] *= alpha;
    }
    bf16x8 pa[4];
    {
      u32x4 w0 = {cvtpk(p0[0], p0[1]), cvtpk(p0[2], p0[3]), cvtpk(p0[4], p0[5]), cvtpk(p0[6], p0[7])};
      u32x4 w1 = {cvtpk(p0[8], p0[9]), cvtpk(p0[10], p0[11]), cvtpk(p0[12], p0[13]), cvtpk(p0[14], p0[15])};
      u32x4 w2 = {cvtpk(p1[0], p1[1]), cvtpk(p1[2], p1[3]), cvtpk(p1[4], p1[5]), cvtpk(p1[6], p1[7])};
      u32x4 w3 = {cvtpk(p1[8], p1[9]), cvtpk(p1[10], p1[11]), cvtpk(p1[12], p1[13]), cvtpk(p1[14], p1[15])};
      pa[0] = __builtin_bit_cast(bf16x8, w0); pa[1] = __builtin_bit_cast(bf16x8, w1);
      pa[2] = __builtin_bit_cast(bf16x8, w2); pa[3] = __builtin_bit_cast(bf16x8, w3);
    }
#pragma unroll
    for (int d = 0; d < 4; ++d) {
#pragma unroll
      for (int s = 0; s < 4; ++s) {
        s16x4 lo = __builtin_amdgcn_ds_read_tr16_b64_v4i16((s16x4 __attribute__((address_space(3)))*)(buf + vad[d] + (16 * s) * 256));
        s16x4 hi = __builtin_amdgcn_ds_read_tr16_b64_v4i16((s16x4 __attribute__((address_space(3)))*)(buf + vad[d] + (16 * s + 8) * 256));
        bf16x8 vb = {lo[0], lo[1], lo[2], lo[3], hi[0], hi[1], hi[2], hi[3]};
        o[d] = mfma(vb, pa[s], o[d]);
      }
    }
  }
  const float linv = 1.f / l;
#pragma unroll
  for (int d = 0; d < 4; ++d)
#pragma unroll
    for (int r = 0; r < 16; ++r) o[d][r] *= linv;
}

DI float* tr_stage(const int tid, const f32x16* o, char* lds) {
  const int lane = tid & 63, wid = tid >> 6, r32 = lane & 31, hh = lane >> 5;
  float* tr = (float*)lds + wid * (32 * ATT_TR_ROW);
  __syncthreads();
#pragma unroll
  for (int d = 0; d < 4; ++d)
#pragma unroll
    for (int g = 0; g < 4; ++g) {
      f32x4 v = {o[d][4 * g], o[d][4 * g + 1], o[d][4 * g + 2], o[d][4 * g + 3]};
      *(f32x4*)(tr + r32 * ATT_TR_ROW + d * 32 + 8 * g + 4 * hh) = v;
    }
  return tr;
}

DI void store_gated(const int tid, const Params& p, const f32x16* o, int t0, int gcol, int ocol, char* lds) {
  const int lane = tid & 63, wid = tid >> 6;
  const bfu* P = (const bfu*)(p.ws + WS_PBUF);
  bfu* O = (bfu*)(p.ws + WS_HBUF);
  const float* tr = tr_stage(tid, o, lds);
  for (int rr = 0; rr < 32; ++rr) {
    size_t t = (size_t)(t0 + wid * 32 + rr);
    f2_t v = *(const f2_t*)(tr + rr * ATT_TR_ROW + lane * 2);
    unsigned g = *(const unsigned*)(P + t * EVEN_IN + gcol + lane * 2);
    *(unsigned*)(O + t * D + ocol + lane * 2) = cvtpk(v[0] * silu(bflo(g)), v[1] * silu(bfhi(g)));
  }
}

DI void phase_attn_even(const Params& p, int li, char* lds) {
  const bfu* P = (const bfu*)(p.ws + WS_PBUF);
  const bfu* Qm = (const bfu*)(p.ws + WS_QM);
  const bfu* Km = (const bfu*)(p.ws + WS_KMLA);
  const bfu* Vm = (const bfu*)(p.ws + WS_VMLA);
  const bfu* cnk = (const bfu*)(p.ws + WS_C_NAK);
  const bfu* cnv = (const bfu*)(p.ws + WS_C_NAV);
  const float CM = 0.07216878364870322f * LOG2E;
  const float CN = 0.08838834764831845f * LOG2E;
  int item = blockIdx.x;
  for (; item < 512; item += gridDim.x) {
    const int tid = opaque(threadIdx.x), lane = tid & 63, wid = tid >> 6, r32 = lane & 31, hh = lane >> 5;
    f32x16 o[4];
    int b = item >> 6, hd = (item >> 3) & 7, qb = item & 7;
    int t0 = TP + b * 2048 + qb * 256;
    int trow = t0 + wid * 32 + r32;
    int s = qb * 256 + wid * 32 + r32;
    Seg s0 = {Km + (size_t)(T + b * 512) * 1536 + hd * 192, Vm + (size_t)(T + b * 512) * 1024 + hd * 128, 1536, 1024, 512};
    Seg s1 = {Km + (size_t)(TP + b * 2048) * 1536 + hd * 192, Vm + (size_t)(TP + b * 2048) * 1024 + hd * 128, 1536, 1024, 2048};
    attn_core<192, false, true>(tid, o, Qm + (size_t)trow * 1536 + hd * 192 + hh * 8, s0, s1, CM, lds, 0, 0, 0, (float)(s >> 6), (float)(s & 63));
    store_gated(tid, p, o, t0, 4928 + hd * 128, 1024 + hd * 128, lds);
  }
  for (; item < 1024; item += gridDim.x) {
    const int tid = opaque(threadIdx.x), lane = tid & 63, wid = tid >> 6, r32 = lane & 31, hh = lane >> 5;
    const int it = item - 512;
    f32x16 o[4];
    int b = it >> 6, hd = (it >> 3) & 7, qb = it & 7;
    int t0 = TP + b * 2048 + qb * 256;
    int trow = t0 + wid * 32 + r32;
    int qi = wid * 32 + r32;
    int gr = qb * 4 + (qi >> 6), gc = qi & 63;
    int kr0 = min(max(qb * 4 - 4, 0), 24);
    int kr1 = min(max(qb * 4 + 3 - 4, 0), 24) + 8;
    __syncthreads();
    float* sb = (float*)(lds + ATT_BIAS_OFF);
    for (int idx = tid; idx < 465; idx += 512) sb[idx] = p.in[16][(size_t)(li * 8 + hd) * 465 + idx] * LOG2E;
    Seg s0 = {cnk + (size_t)((b * 2 + li) * 512) * 1024 + hd * 128, cnv + (size_t)((b * 2 + li) * 512) * 1024 + hd * 128, 1024, 1024, 512};
    const bfu* Pl = P + (size_t)(TP + b * 2048 + kr0 * 64) * EVEN_IN;
    Seg s1 = {Pl + 1024 + hd * 128, Pl + 2048 + hd * 128, EVEN_IN, EVEN_IN, (kr1 - kr0) * 64};
    attn_core<128, true, false>(tid, o, P + (size_t)trow * EVEN_IN + hd * 128 + hh * 8, s0, s1, CN, lds, gr, gc, kr0, 0.f, 0.f);
    store_gated(tid, p, o, t0, 3072 + hd * 128, hd * 128, lds);
  }
  for (; item < 1280; item += gridDim.x) {
    const int tid = opaque(threadIdx.x), lane = tid & 63, wid = tid >> 6, r32 = lane & 31, hh = lane >> 5;
    const int it = item - 1024;
    f32x16 o[4];
    int b = it >> 3, hd = it & 7;
    int t0 = b * 256;
    int trow = t0 + wid * 32 + r32;
    Seg s0 = {Km + (size_t)(b * 256) * 1536 + hd * 192, Vm + (size_t)(b * 256) * 1024 + hd * 128, 1536, 1024, 256};
    Seg s1 = {s0.K, s0.V, 1536, 1024, 0};
    attn_core<192, false, false>(tid, o, Qm + (size_t)trow * 1536 + hd * 192 + hh * 8, s0, s1, CM, lds, 0, 0, 0, 0.f, 0.f);
    store_gated(tid, p, o, t0, 4928 + hd * 128, 1024 + hd * 128, lds);
  }
  for (; item < 1536; item += gridDim.x) {
    const int tid = opaque(threadIdx.x), lane = tid & 63, wid = tid >> 6, r32 = lane & 31, hh = lane >> 5;
    const int it = item - 1280;
    f32x16 o[4];
    int b = it >> 3, hd = it & 7;
    int t0 = b * 256;
    int trow = t0 + wid * 32 + r32;
    const bfu* Pb = P + (size_t)(b * 256) * EVEN_IN;
    Seg s0 = {Pb + 1024 + hd * 128, Pb + 2048 + hd * 128, EVEN_IN, EVEN_IN, 256};
    Seg s1 = {s0.K, s0.V, EVEN_IN, EVEN_IN, 0};
    attn_core<128, false, false>(tid, o, P + (size_t)trow * EVEN_IN + hd * 128 + hh * 8, s0, s1, CN, lds, 0, 0, 0, 0.f, 0.f);
    store_gated(tid, p, o, t0, 3072 + hd * 128, hd * 128, lds);
  }
}

DI void phase_attn_odd(const Params& p, int l, char* lds) {
  const int li = l >> 1;
  const bfu* P = (const bfu*)(p.ws + WS_PBUF);
  bfu* O = (bfu*)(p.ws + WS_HBUF);
  const bfu* cdk = (const bfu*)(p.ws + WS_C_DK);
  const bfu* cdv = (const bfu*)(p.ws + WS_C_DV);
  float* scr = (float*)(p.ws + WS_SCR) + (size_t)blockIdx.x * 65536;
  const float CD = 0.08838834764831845f * LOG2E;
  const float lam_init = 0.8f - 0.6f * expf(-0.3f * (float)l);
  float lam;
  {
    const float* lp = p.in[23] + li * 512;
    float s1 = 0.f, s2 = 0.f;
    for (int k = 0; k < 128; ++k) { s1 += lp[k] * lp[128 + k]; s2 += lp[256 + k] * lp[384 + k]; }
    lam = expf(s1) - expf(s2) + lam_init;
  }
  const float* gsub = p.in[24] + li * 256;
  for (int item = blockIdx.x; item < 768; item += gridDim.x) {
    const int tid = opaque(threadIdx.x), lane = tid & 63, wid = tid >> 6, r32 = lane & 31, hh = lane >> 5;
    int b, hd, t0; Seg s0, s1;
    if (item < 512) {
      b = item >> 6; hd = (item >> 3) & 7; int qb = item & 7;
      t0 = TP + b * 2048 + qb * 256;
      const bfu* Pl = P + (size_t)(TP + b * 2048) * ODD_IN;
      s0 = Seg{cdk + (size_t)((b * 2 + li) * 512) * 2048 + hd * 256, cdv + (size_t)((b * 2 + li) * 512) * 2048 + hd * 256, 2048, 2048, 512};
      s1 = Seg{Pl + 2048 + hd * 256, Pl + 4096 + hd * 256, ODD_IN, ODD_IN, 2048};
    } else {
      int it = item - 512;
      b = it >> 3; hd = it & 7;
      t0 = b * 256;
      const bfu* Pb = P + (size_t)(b * 256) * ODD_IN;
      s0 = Seg{Pb + 2048 + hd * 256, Pb + 4096 + hd * 256, ODD_IN, ODD_IN, 256};
      s1 = Seg{s0.K, s0.V, ODD_IN, ODD_IN, 0};
    }
    const int trow = t0 + wid * 32 + r32;
    float ssq = 0.f;
    for (int pass = 0; pass < 4; ++pass) {
      const int vh = pass >> 1, c = pass & 1;
      f32x16 o[4];
      Seg a0 = s0, a1 = s1;
      a0.K += c * 128; a1.K += c * 128; a0.V += vh * 128; a1.V += vh * 128;
      attn_core<128, false, false>(tid, o, P + (size_t)trow * ODD_IN + hd * 256 + c * 128 + hh * 8, a0, a1, CD, lds, 0, 0, 0, 0.f, 0.f);
      float* sc = scr + vh * 32768 + tid;
      if (c == 1) {
        float ss = 0.f;
#pragma unroll
        for (int d = 0; d < 4; ++d)
#pragma unroll
          for (int r = 0; r < 16; ++r) {
            float dd = sc[(d * 16 + r) * 512] - lam * o[d][r];
            o[d][r] = dd; ss += dd * dd;
          }
        ssq += ss;
      }
#pragma unroll
      for (int d = 0; d < 4; ++d)
#pragma unroll
        for (int r = 0; r < 16; ++r) sc[(d * 16 + r) * 512] = o[d][r];
    }
    ssq += __shfl_xor(ssq, 32);
    const float rstd = rsqrtf(ssq * (1.f / 256.f) + EPS) * (1.f - lam_init);
    for (int half = 0; half < 2; ++half) {
      f32x16 o[4];
      const float* sc = scr + half * 32768 + tid;
#pragma unroll
      for (int d = 0; d < 4; ++d)
#pragma unroll
        for (int r = 0; r < 16; ++r) o[d][r] = sc[(d * 16 + r) * 512] * rstd;
      const float* tr = tr_stage(tid, o, lds);
      const int colb = hd * 256 + half * 128 + lane * 2;
      const float g0 = gsub[half * 128 + lane * 2], g1 = gsub[half * 128 + lane * 2 + 1];
      for (int rr = 0; rr < 32; ++rr) {
        size_t t = (size_t)(t0 + wid * 32 + rr);
        f2_t v = *(const f2_t*)(tr + rr * ATT_TR_ROW + lane * 2);
        unsigned g = *(const unsigned*)(P + t * ODD_IN + 6144 + colb);
        *(unsigned*)(O + t * D + colb) = cvtpk(v[0] * g0 * silu(bflo(g)), v[1] * g1 * silu(bfhi(g)));
      }
    }
  }
}

#ifndef PM
#define PM 0xffff
#endif
template <int EPI>
DI void gemm_phase(const Params& p, const bfu* A, const bfu* Bt, int K, int nM, int nN, int li, char* lds) {
  const int ntiles = nM * nN;
  for (int it = 0; it * (int)gridDim.x < ntiles; ++it) {
    int id = tile_id(it);
    if (id >= ntiles) continue;
    int m, n; tile_mn(id, nN, m, n);
    gemm256<EPI>(p, A, Bt, K, m * 256, n * 256, li, lds);
  }
}

DI void run_phase(const Params& p, int ph, char* lds) {
  if (ph == 0) { if (PM & 1) phase_prep(p, lds); return; }
  if (ph == 1) { if (PM & 2) phase_rows(p, 0, 0, lds); return; }
  const int q = ph - 2, pair = q / 10, r = q % 10;
  const bfu* hbuf = (const bfu*)(p.ws + WS_HBUF);
  if (r < 6) {
    const int l = 2 * pair, li = pair;
    if (r == 0 && (PM & 4)) {
      gemm_phase<EPI_E1>(p, hbuf, (const bfu*)(p.ws + WS_WT_IN_E) + (size_t)li * EVEN_PAD * D, D, 96, 24, li, lds);
    } else if (r == 1 && (PM & 8)) {
      phase_mid(p, li);
    } else if (r == 2 && (PM & 16)) {
      gemm_phase<EPI_QM>(p, (const bfu*)(p.ws + WS_CQN), (const bfu*)(p.ws + WS_WT_UQ) + (size_t)li * 1536 * 512, 512, 96, 6, li, lds);
      gemm_phase<EPI_KV>(p, (const bfu*)(p.ws + WS_CKVN), (const bfu*)(p.ws + WS_WT_UKV) + (size_t)li * 2048 * 256, 256, 112, 8, li, lds);
    } else if (r == 3 && (PM & 32)) {
      phase_attn_even(p, li, lds);
    } else if (r == 4 && (PM & 64)) {
      gemm_phase<EPI_Y>(p, hbuf, (const bfu*)(p.ws + WS_WT_OUT_E) + (size_t)li * D * D, D, 96, 8, li, lds);
    } else if (r == 5 && (PM & 128)) {
      phase_rows(p, 1, l, lds);
    }
  } else {
    const int l = 2 * pair + 1, li = pair, k = r - 6;
    if (k == 0 && (PM & 256)) {
      gemm_phase<EPI_O1>(p, hbuf, (const bfu*)(p.ws + WS_WT_IN_O) + (size_t)li * ODD_IN * D, D, 96, 32, li, lds);
    } else if (k == 1 && (PM & 512)) {
      phase_attn_odd(p, l, lds);
    } else if (k == 2 && (PM & 1024)) {
      gemm_phase<EPI_Y>(p, hbuf, (const bfu*)(p.ws + WS_WT_OUT_O) + (size_t)li * D * D, D, 96, 8, li, lds);
    } else if (k == 3 && (PM & 2048)) {
      phase_rows(p, 1, l, lds);
    }
  }
}

constexpr int N_PHASES = 22;
constexpr int LDS_BYTES = 8 * 32 * ATT_TR_ROW * 4;

__global__ void __launch_bounds__(512, 2) fwd_megakernel(Params p) {
  __shared__ __attribute__((aligned(16))) char lds[LDS_BYTES];
  cg::grid_group grid = cg::this_grid();
  for (int ph = p.lo; ph < p.hi; ++ph) {
    run_phase(p, ph, lds);
    if (ph + 1 < p.hi) grid.sync();
  }
}

extern "C" void kernel_launch(void* const* d_in, const int* in_sizes, int n_in, void* d_out, int out_size, void* d_ws, size_t ws_size,
                              hipStream_t stream) {
  static int grid_blocks = 0;
  if (!grid_blocks) {
    int dev = 0, cus = 0, per_cu = 0;
    (void)hipGetDevice(&dev);
    (void)hipDeviceGetAttribute(&cus, hipDeviceAttributeMultiprocessorCount, dev);
    (void)hipOccupancyMaxActiveBlocksPerMultiprocessor(&per_cu, fwd_megakernel, 512, 0);
    if (per_cu < 1) per_cu = 1;
    per_cu = 1;
    grid_blocks = cus * per_cu;
    if (grid_blocks > 512) grid_blocks = 512;
  }
  if (n_in != 25 || ws_size < WS_NEED) {
    fprintf(stderr, "kernel_launch: bad n_in %d or ws_size %zu < %zu\n", n_in, ws_size, (size_t)WS_NEED);
    return;
  }
  Params p{};
  for (int i = 0; i < 25; ++i) p.in[i] = (const float*)d_in[i];
  p.out = (float*)d_out;
  p.ws = (char*)d_ws;
  p.lo = 0; p.hi = N_PHASES;
  void* args[] = {&p};
  hipError_t e = hipLaunchCooperativeKernel((void*)fwd_megakernel, dim3(grid_blocks), dim3(512), args, 0, stream);
  if (e != hipSuccess) fprintf(stderr, "cooperative launch failed: %s (grid %d)\n", hipGetErrorString(e), grid_blocks);
}
```

```cpp
#include <hip/hip_runtime.h>
#include <hip/hip_cooperative_groups.h>
#include <cstdio>
#include <cstdint>
namespace cg = cooperative_groups;

#define DI __device__ __forceinline__
typedef unsigned short bfu;
using bf16x8 = __attribute__((ext_vector_type(8))) short;
using s16x4  = __attribute__((ext_vector_type(4))) short;
using f32x16 = __attribute__((ext_vector_type(16))) float;
using f32x4  = __attribute__((ext_vector_type(4))) float;
using u32x4  = __attribute__((ext_vector_type(4))) unsigned;
using u32x2  = __attribute__((ext_vector_type(2))) unsigned;
typedef __bf16 bf2_t __attribute__((ext_vector_type(2)));
typedef float f2_t __attribute__((ext_vector_type(2)));

constexpr int D = 2048, TP = 8192, TS = 16384, T = 24576, TALL = 28672;
constexpr int EVEN_IN = 5952, ODD_IN = 8192;
constexpr float EPS = 1e-6f;
constexpr float LOG2E = 1.4426950408889634f;
constexpr float LOG2_ROPE = 13.287712379549449f;

constexpr size_t OUT_YP = 0, OUT_YS = 16777216, OUT_NAK = 50331648, OUT_NAV = 67108864, OUT_CKV = 83886080,
                 OUT_KPE = 88080384, OUT_DK = 89128960, OUT_DV = 122683392;

constexpr size_t al256(size_t x) { return (x + 255) / 256 * 256; }
constexpr size_t WS_WT_IN_E = 0;
constexpr int EVEN_PAD = 6144;
constexpr size_t WS_WT_IN_O = WS_WT_IN_E + al256((size_t)2 * EVEN_PAD * D * 2);
constexpr size_t WS_WT_OUT_E = WS_WT_IN_O + al256((size_t)2 * ODD_IN * D * 2);
constexpr size_t WS_WT_OUT_O = WS_WT_OUT_E + al256((size_t)2 * D * D * 2);
constexpr size_t WS_WT_UQ = WS_WT_OUT_O + al256((size_t)2 * D * D * 2);
constexpr size_t WS_WT_UKV = WS_WT_UQ + al256((size_t)2 * 1536 * 512 * 2);
constexpr size_t WS_C_NAK = WS_WT_UKV + al256((size_t)2 * 2048 * 256 * 2);
constexpr size_t WS_C_NAV = WS_C_NAK + al256((size_t)8 * 2 * 512 * 1024 * 2);
constexpr size_t WS_C_DK = WS_C_NAV + al256((size_t)8 * 2 * 512 * 1024 * 2);
constexpr size_t WS_C_DV = WS_C_DK + al256((size_t)8 * 2 * 512 * 2048 * 2);
constexpr size_t WS_MODP = WS_C_DV + al256((size_t)8 * 2 * 512 * 2048 * 2);
constexpr size_t WS_BAR = WS_MODP + al256((size_t)4 * 4 * 9 * 6144 * 4);
constexpr size_t WS_HBUF = WS_BAR + 16384;
constexpr size_t WS_CQN = WS_HBUF;
constexpr size_t WS_CKVN = WS_HBUF + al256((size_t)T * 512 * 2);
constexpr size_t WS_PBUF = WS_HBUF + al256((size_t)T * D * 2);
constexpr size_t WS_YBUF = WS_PBUF;
constexpr size_t WS_QM = WS_PBUF + al256((size_t)T * EVEN_IN * 2);
constexpr size_t WS_KMLA = WS_QM + al256((size_t)T * 1536 * 2);
constexpr size_t WS_VMLA = WS_KMLA + al256((size_t)TALL * 1536 * 2);
constexpr size_t WS_END_EVEN = WS_VMLA + al256((size_t)TALL * 1024 * 2);
constexpr size_t WS_SCR = WS_PBUF + al256((size_t)T * ODD_IN * 2);
constexpr size_t WS_END_ODD = WS_SCR + (size_t)1024 * 131072;
constexpr size_t WS_NEED = WS_END_EVEN > WS_END_ODD ? WS_END_EVEN : WS_END_ODD;

struct Params {
  const float* in[25];
  float* out;
  char* ws;
  int lo, hi;
  int nrep, pad;
};

DI unsigned cvtpk(float lo, float hi) {
  f2_t v = {lo, hi};
  bf2_t b = __builtin_convertvector(v, bf2_t);
  return __builtin_bit_cast(unsigned, b);
}
DI bfu f2bf(float x) { return (bfu)(cvtpk(x, 0.f) & 0xffffu); }
DI float bf2f(bfu b) { return __uint_as_float(((unsigned)b) << 16); }
DI float bflo(unsigned u) { return __uint_as_float(u << 16); }
DI float bfhi(unsigned u) { return __uint_as_float(u & 0xffff0000u); }
DI int opaque(int x) { asm volatile("" : "+v"(x)); return x; }
DI int crow(int r, int hi) { return (r & 3) + 8 * (r >> 2) + 4 * hi; }
DI float silu(float x) { return x * __builtin_amdgcn_rcpf(1.f + __expf(-x)); }
DI f32x16 mfma(bf16x8 a, bf16x8 b, f32x16 c) { return __builtin_amdgcn_mfma_f32_32x32x16_bf16(a, b, c, 0, 0, 0); }
DI float xor32(float v) {
  auto rr = __builtin_amdgcn_permlane32_swap(__float_as_uint(v), __float_as_uint(v), false, false);
  return __uint_as_float((threadIdx.x & 32) ? rr[0] : rr[1]);
}
DI float wave_sum(float v) {
#pragma unroll
  for (int o = 32; o >= 1; o >>= 1) v += __shfl_xor(v, o);
  return v;
}
DI float block_sum(float v, float* red, int tid) {
  v = wave_sum(v);
  __syncthreads();
  if ((tid & 63) == 0) red[tid >> 6] = v;
  __syncthreads();
  const int hb = (tid >> 8) * 4;
  return red[hb] + red[hb + 1] + red[hb + 2] + red[hb + 3];
}
DI float modval(const Params& p, int l, int r, int n) {
  const float* mp = (const float*)(p.ws + WS_MODP);
  float s = p.in[11][l * 6144 + n];
#pragma unroll
  for (int ks = 0; ks < 4; ++ks) s += mp[((size_t)(ks * 4 + l) * 9 + r) * 6144 + n];
  return s;
}

DI void prep_mod_item(const Params& p, int item, char* lds) {
  const int tid = opaque(threadIdx.x), lane = tid & 63, wid = tid >> 6;
  const int ks = item & 3, cgp = (item >> 2) % 24, l = item / 96;
  float* scond = (float*)lds;
  float* red = (float*)(lds + 18432);
  for (int idx = tid; idx < 9 * 512; idx += 512) {
    int r = idx >> 9, kk = idx & 511;
    float cv = r < 8 ? p.in[8][r * 2048 + ks * 512 + kk] : p.in[9][ks * 512 + kk];
    scond[idx] = silu(cv);
  }
  __syncthreads();
  const float* W = p.in[10] + ((size_t)l * 2048 + ks * 512 + wid * 64) * 6144 + cgp * 256 + lane * 4;
  float acc[9][4];
#pragma unroll
  for (int r = 0; r < 9; ++r) { acc[r][0] = 0; acc[r][1] = 0; acc[r][2] = 0; acc[r][3] = 0; }
  for (int kk = 0; kk < 64; kk += 4) {
    f32x4 w[4];
#pragma unroll
    for (int u = 0; u < 4; ++u) w[u] = *(const f32x4*)(W + (size_t)(kk + u) * 6144);
#pragma unroll
    for (int u = 0; u < 4; ++u) {
#pragma unroll
      for (int r = 0; r < 9; ++r) {
        float s = scond[r * 512 + wid * 64 + kk + u];
        acc[r][0] += s * w[u][0]; acc[r][1] += s * w[u][1]; acc[r][2] += s * w[u][2]; acc[r][3] += s * w[u][3];
      }
    }
  }
#pragma unroll
  for (int r = 0; r < 9; ++r) {
    f32x4 v = {acc[r][0], acc[r][1], acc[r][2], acc[r][3]};
    *(f32x4*)(red + (wid * 9 + r) * 256 + lane * 4) = v;
  }
  __syncthreads();
  float* mp = (float*)(p.ws + WS_MODP);
  for (int idx = tid; idx < 9 * 256; idx += 512) {
    int r = idx >> 8, cc = idx & 255;
    float s = 0.f;
#pragma unroll
    for (int w = 0; w < 8; ++w) s += red[(w * 9 + r) * 256 + cc];
    mp[((size_t)(ks * 4 + l) * 9 + r) * 6144 + cgp * 256 + cc] = s;
  }
  __syncthreads();
}

DI int swap45(int n) { return (n & ~0x30) | ((n & 0x10) << 1) | ((n & 0x20) >> 1); }

DI void prep_transpose_tile(const float* __restrict__ src, bfu* __restrict__ dst, int K, int N, int k0, int n0, char* lds, int tid) {
  float* tl = (float*)lds + (tid >> 8) * (64 * 65);
  const int t4 = tid & 255;
#pragma unroll
  for (int i = 0; i < 4; ++i) {
    int kr = (t4 >> 4) + 16 * i, nc = (t4 & 15) * 4;
    f32x4 v = *(const f32x4*)(src + (size_t)(k0 + kr) * N + n0 + nc);
    tl[kr * 65 + nc + 0] = v[0]; tl[kr * 65 + nc + 1] = v[1]; tl[kr * 65 + nc + 2] = v[2]; tl[kr * 65 + nc + 3] = v[3];
  }
  __syncthreads();
  {
    int n = t4 >> 2, kseg = (t4 & 3) * 16;
    unsigned w[8];
#pragma unroll
    for (int e = 0; e < 8; ++e) w[e] = cvtpk(tl[(kseg + 2 * e) * 65 + n], tl[(kseg + 2 * e + 1) * 65 + n]);
    u32x4 a = {w[0], w[1], w[2], w[3]}, b = {w[4], w[5], w[6], w[7]};
    bfu* d = dst + (size_t)swap45(n0 + n) * K + k0 + kseg;
    *(u32x4*)d = a; *(u32x4*)(d + 8) = b;
  }
  __syncthreads();
}

DI void phase_prep(const Params& p, char* lds) {
  constexpr int N_MOD = 384, N_TR_L = 9440, N_TRP = N_TR_L, N_CV = 1536;
  for (int item = blockIdx.x; item < N_MOD + N_TRP + N_CV; item += gridDim.x) {
    if (item < N_MOD) { prep_mod_item(p, item, lds); continue; }
    const int tid = opaque(threadIdx.x);
    int it = item - N_MOD;
    if (it < N_TRP) {
      int tl = it * 2 + (tid >> 8);
      int i = tl / N_TR_L, r = tl % N_TR_L;
      const float* src; bfu* dst; int K, N;
      if (r < 2976) { src = p.in[14] + (size_t)i * 2048 * EVEN_IN; dst = (bfu*)(p.ws + WS_WT_IN_E) + (size_t)i * EVEN_PAD * 2048; K = 2048; N = EVEN_IN; }
      else if ((r -= 2976) < 1024) { src = p.in[15] + (size_t)i * 2048 * 2048; dst = (bfu*)(p.ws + WS_WT_OUT_E) + (size_t)i * 2048 * 2048; K = 2048; N = 2048; }
      else if ((r -= 1024) < 192) { src = p.in[18] + (size_t)i * 512 * 1536; dst = (bfu*)(p.ws + WS_WT_UQ) + (size_t)i * 1536 * 512; K = 512; N = 1536; }
      else if ((r -= 192) < 128) { src = p.in[20] + (size_t)i * 256 * 2048; dst = (bfu*)(p.ws + WS_WT_UKV) + (size_t)i * 2048 * 256; K = 256; N = 2048; }
      else if ((r -= 128) < 4096) { src = p.in[21] + (size_t)i * 2048 * ODD_IN; dst = (bfu*)(p.ws + WS_WT_IN_O) + (size_t)i * ODD_IN * 2048; K = 2048; N = ODD_IN; }
      else { r -= 4096; src = p.in[22] + (size_t)i * 2048 * 2048; dst = (bfu*)(p.ws + WS_WT_OUT_O) + (size_t)i * 2048 * 2048; K = 2048; N = 2048; }
      int nN = N / 64;
      int kt = r / nN, nt = r % nN;
      prep_transpose_tile(src, dst, K, N, kt * 64, nt * 64, lds, tid);
      continue;
    }
    it -= N_TRP;
    {
      size_t ch = (size_t)it * 4096;
      const float* src; bfu* dst;
      if (ch < 1048576) { src = p.in[2]; dst = (bfu*)(p.ws + WS_C_NAK); }
      else if ((ch -= 1048576) < 1048576) { src = p.in[3]; dst = (bfu*)(p.ws + WS_C_NAV); }
      else if ((ch -= 1048576) < 2097152) { src = p.in[6]; dst = (bfu*)(p.ws + WS_C_DK); }
      else { ch -= 2097152; src = p.in[7]; dst = (bfu*)(p.ws + WS_C_DV); }
#pragma unroll
      for (int u = 0; u < 8; ++u) {
        size_t c = ch + u * 512 + tid;
        f32x4 a = *(const f32x4*)(src + c * 8), b = *(const f32x4*)(src + c * 8 + 4);
        u32x4 w = {cvtpk(a[0], a[1]), cvtpk(a[2], a[3]), cvtpk(b[0], b[1]), cvtpk(b[2], b[3])};
        *(u32x4*)(dst + c * 8) = w;
      }
    }
  }
}

DI void phase_rows(const Params& p, int kind, int l, char* lds) {
  float* vA = (float*)lds; float* vSH = vA + 2048; float* vG = vSH + 2048;
  const int tid = opaque(threadIdx.x), lane = tid & 63, wid = tid >> 6;
  const int rows_per = ((T / 8 + gridDim.x - 1) / gridDim.x) * 8;
  const int t_begin = blockIdx.x * rows_per;
  const int t_end = min(T, t_begin + rows_per);
  const int ln = kind == 0 ? 0 : l + 1;
  const bool do_h = ln < 4;
  int cur_r = -1;
  bfu* hbuf = (bfu*)(p.ws + WS_HBUF);
  const float* ybuf = (const float*)(p.ws + WS_YBUF);
  for (int base = t_begin; base < t_end; base += 8) {
    const int r = base < TP ? 8 : (base - TP) >> 11;
    if (r != cur_r) {
      cur_r = r;
      __syncthreads();
#pragma unroll
      for (int e = 0; e < 4; ++e) {
        const int col = tid * 4 + e;
        if (do_h) {
          vSH[col] = modval(p, ln, r, col);
          vA[col] = (1.f + modval(p, ln, r, 2048 + col)) * p.in[12][ln * 2048 + col];
        }
        if (kind == 1) vG[col] = modval(p, l, r, 4096 + col) * p.in[13][l * 2048 + col];
      }
      __syncthreads();
    }
    const int t = base + wid;
    if (t < t_end) {
      const float* xin = (kind == 0 || l == 0) ? (t < TP ? p.in[0] + (size_t)t * D : p.in[1] + (size_t)(t - TP) * D) : p.out + (size_t)t * D;
      f32x4 x[8];
#pragma unroll
      for (int i = 0; i < 8; ++i) x[i] = *(const f32x4*)(xin + i * 256 + lane * 4);
      if (kind == 1) {
        f32x4 y[8];
#pragma unroll
        for (int i = 0; i < 8; ++i) y[i] = *(const f32x4*)(ybuf + (size_t)t * D + i * 256 + lane * 4);
        float ss = 0.f;
#pragma unroll
        for (int i = 0; i < 8; ++i) ss += y[i][0] * y[i][0] + y[i][1] * y[i][1] + y[i][2] * y[i][2] + y[i][3] * y[i][3];
        ss = wave_sum(ss);
        const float rstd = rsqrtf(ss * (1.f / 2048.f) + EPS);
#pragma unroll
        for (int i = 0; i < 8; ++i) {
          f32x4 g = *(const f32x4*)(vG + i * 256 + lane * 4);
          x[i][0] += g[0] * (y[i][0] * rstd); x[i][1] += g[1] * (y[i][1] * rstd);
          x[i][2] += g[2] * (y[i][2] * rstd); x[i][3] += g[3] * (y[i][3] * rstd);
          *(f32x4*)(p.out + (size_t)t * D + i * 256 + lane * 4) = x[i];
        }
      }
      if (do_h) {
        float ss = 0.f;
#pragma unroll
        for (int i = 0; i < 8; ++i) ss += x[i][0] * x[i][0] + x[i][1] * x[i][1] + x[i][2] * x[i][2] + x[i][3] * x[i][3];
        ss = wave_sum(ss);
        const float rstd = rsqrtf(ss * (1.f / 2048.f) + EPS);
#pragma unroll
        for (int i = 0; i < 8; ++i) {
          f32x4 a = *(const f32x4*)(vA + i * 256 + lane * 4), s = *(const f32x4*)(vSH + i * 256 + lane * 4);
          u32x2 w = {cvtpk(x[i][0] * rstd * a[0] + s[0], x[i][1] * rstd * a[1] + s[1]), cvtpk(x[i][2] * rstd * a[2] + s[2], x[i][3] * rstd * a[3] + s[3])};
          *(u32x2*)(hbuf + (size_t)t * D + i * 256 + lane * 4) = w;
        }
      }
    }
  }
}

constexpr int GBM = 256, GBK = 64, GHALF = 128, GHT = GHALF * GBK;
enum { EPI_E1 = 0, EPI_O1 = 1, EPI_QM = 2, EPI_KV = 3, EPI_Y = 4 };

DI int lds_byte(int r, int c) {
  int st = (r >> 4) * 2 + (c >> 5), rr = r & 15, cc = c & 31, ob = rr * 64 + cc * 2;
  return st * 1024 + (ob ^ (((ob >> 9) & 1) << 5));
}
DI void stage_rc(int b, int& R, int& C) {
  int st = b / 1024, sb = b % 1024, swz = sb ^ (((sb >> 9) & 1) << 5);
  R = (st >> 1) * 16 + swz / 64; C = (st & 1) * 32 + (swz % 64) / 2;
}

template <int EPI>
DI void gemm256(const Params& p, const bfu* __restrict__ A, const bfu* __restrict__ Bt, const int K, const int brow, const int bcol,
                const int li, char* lds) {
  const int tid = opaque(threadIdx.x);
  bfu* shm = (bfu*)lds;
#define SA(b, h) (shm + ((b) * 2 + (h)) * GHT)
#define SB(b, h) (shm + (4 + (b) * 2 + (h)) * GHT)
#define STAGE(P_, BASE, br, kt) do { long _g = (long)(br) * K + (long)(kt) * GBK;                          \
    for (int _i = 0; _i < 2; ++_i) { int _b = tid * 16 + _i * 8192; int _r, _c; stage_rc(_b, _r, _c);      \
      __builtin_amdgcn_global_load_lds((const unsigned*)(BASE + _g + (long)_r * K + _c),                    \
        (__attribute__((address_space(3))) unsigned*)((char*)(P_) + _b), 16, 0, 0); } } while (0)
#define LDA(dst, b, h) for (int m = 0; m < 4; ++m) for (int k = 0; k < 2; ++k)                              \
    dst[m][k] = *reinterpret_cast<const bf16x8*>((char*)SA(b, h) + lds_byte(wr * 64 + m * 16 + fr, k * 32 + fq * 8))
#define LDB(dst, b, h) for (int n = 0; n < 2; ++n) for (int k = 0; k < 2; ++k)                              \
    dst[n][k] = *reinterpret_cast<const bf16x8*>((char*)SB(b, h) + lds_byte(wc * 32 + n * 16 + fr, k * 32 + fq * 8))
#define MMA(ai, bj, At_, Bt_) do { __builtin_amdgcn_s_setprio(1);                                            \
    for (int m = 0; m < 4; ++m) for (int n = 0; n < 2; ++n) for (int k = 0; k < 2; ++k)                      \
      acc[ai][bj][m][n] = __builtin_amdgcn_mfma_f32_16x16x32_bf16(At_[m][k], Bt_[n][k], acc[ai][bj][m][n], 0, 0, 0); \
    __builtin_amdgcn_s_setprio(0); } while (0)
#define WAIT_V(n) asm volatile("s_waitcnt vmcnt(" #n ")" ::: "memory")
#define WAIT_L(n) asm volatile("s_waitcnt lgkmcnt(" #n ")" ::: "memory")
#define BAR __builtin_amdgcn_s_barrier()
#define SCHED __builtin_amdgcn_sched_barrier(0)
  const int wid = tid >> 6, lane = tid & 63, wr = wid >> 2, wc = wid & 3, fr = lane & 15, fq = lane >> 4;
  f32x4 acc[2][2][4][2];
#pragma unroll
  for (int a_ = 0; a_ < 2; ++a_)
#pragma unroll
    for (int b_ = 0; b_ < 2; ++b_)
#pragma unroll
      for (int m = 0; m < 4; ++m)
#pragma unroll
        for (int n = 0; n < 2; ++n) { acc[a_][b_][m][n][0] = 0.f; acc[a_][b_][m][n][1] = 0.f; acc[a_][b_][m][n][2] = 0.f; acc[a_][b_][m][n][3] = 0.f; }
  bf16x8 At[4][2], B0[2][2], B1[2][2];
  const int nt = K / GBK;
  WAIT_V(0); BAR;
  STAGE(SB(0, 0), Bt, bcol, 0); STAGE(SA(0, 0), A, brow, 0);
  STAGE(SB(0, 1), Bt, bcol + GHALF, 0); STAGE(SA(0, 1), A, brow + GHALF, 0);
  if (wr == 1) BAR;
  WAIT_V(4); BAR;
  STAGE(SB(1, 0), Bt, bcol, 1); STAGE(SA(1, 0), A, brow, 1); STAGE(SB(1, 1), Bt, bcol + GHALF, 1);
  WAIT_V(6); BAR;
  for (int t = 0; t < nt - 2; t += 2) {
    LDB(B0, 0, 0); SCHED; LDA(At, 0, 0); STAGE(SA(1, 1), A, brow + GHALF, t + 1);
    WAIT_L(8); BAR; WAIT_L(0); MMA(0, 0, At, B0); BAR; SCHED;
    LDB(B1, 0, 1); STAGE(SB(0, 0), Bt, bcol, t + 2);
    BAR; WAIT_L(0); MMA(0, 1, At, B1); BAR;
    LDA(At, 0, 1); STAGE(SA(0, 0), A, brow, t + 2);
    BAR; WAIT_L(0); MMA(1, 0, At, B0); BAR; SCHED;
    STAGE(SB(0, 1), Bt, bcol + GHALF, t + 2);
    WAIT_V(6); BAR; MMA(1, 1, At, B1); BAR;
    LDB(B0, 1, 0); SCHED; LDA(At, 1, 0); STAGE(SA(0, 1), A, brow + GHALF, t + 2);
    WAIT_L(8); BAR; WAIT_L(0); MMA(0, 0, At, B0); BAR; SCHED;
    LDB(B1, 1, 1); STAGE(SB(1, 0), Bt, bcol, t + 3);
    BAR; WAIT_L(0); MMA(0, 1, At, B1); BAR;
    LDA(At, 1, 1); STAGE(SA(1, 0), A, brow, t + 3);
    BAR; WAIT_L(0); MMA(1, 0, At, B0); BAR; SCHED;
    STAGE(SB(1, 1), Bt, bcol + GHALF, t + 3);
    WAIT_V(6); BAR; MMA(1, 1, At, B1); BAR;
  }
  { LDB(B0, 0, 0); LDA(At, 0, 0); STAGE(SA(1, 1), A, brow + GHALF, nt - 1);
    BAR; WAIT_L(0); MMA(0, 0, At, B0); BAR;
    LDB(B1, 0, 1); BAR; WAIT_L(0); MMA(0, 1, At, B1); BAR;
    LDA(At, 0, 1); WAIT_V(4); BAR; WAIT_L(0); MMA(1, 0, At, B0); MMA(1, 1, At, B1); BAR; }
  { LDB(B0, 1, 0); LDA(At, 1, 0); WAIT_V(2); BAR; WAIT_L(0); MMA(0, 0, At, B0); BAR;
    LDB(B1, 1, 1); WAIT_V(0); BAR; WAIT_L(0); MMA(0, 1, At, B1); BAR;
    LDA(At, 1, 1); BAR; WAIT_L(0); MMA(1, 0, At, B0); MMA(1, 1, At, B1); BAR; }
  if (wr == 0) BAR;
#undef SA
#undef SB
#undef STAGE
#undef LDA
#undef LDB
#undef MMA
#undef WAIT_V
#undef WAIT_L
#undef BAR
#undef SCHED

  const int jr = (wc & 1) * 16 + fr;
  if constexpr (EPI == EPI_O1) {
    if (brow >= TP && bcol < 4096) {
      const float inv = exp2f(-(float)jr * (LOG2_ROPE / 32.f));
      const bool colrope = (wc >> 1) & 1;
#pragma unroll
      for (int ai = 0; ai < 2; ++ai)
#pragma unroll
        for (int m = 0; m < 4; ++m)
#pragma unroll
          for (int j = 0; j < 4; ++j) {
            int row = brow + ai * 128 + wr * 64 + m * 16 + fq * 4 + j;
            int s = (row - TP) & 2047;
            float ang = (float)(colrope ? (s & 63) : (s >> 6)) * inv;
            float cs = __cosf(ang), sn = __sinf(ang);
#pragma unroll
            for (int bj = 0; bj < 2; ++bj) {
              float x1 = acc[ai][bj][m][0][j], x2 = acc[ai][bj][m][1][j];
              acc[ai][bj][m][0][j] = x1 * cs - x2 * sn;
              acc[ai][bj][m][1][j] = x2 * cs + x1 * sn;
            }
          }
    }
  }
#pragma unroll
  for (int ai = 0; ai < 2; ++ai)
#pragma unroll
    for (int bj = 0; bj < 2; ++bj)
#pragma unroll
      for (int n = 0; n < 2; ++n) {
        const int colg = bcol + bj * 128 + (wc >> 1) * 64 + n * 32 + (wc & 1) * 16;
        const int col = colg + fr;
#pragma unroll
        for (int m = 0; m < 4; ++m)
#pragma unroll
          for (int j = 0; j < 4; ++j) {
            const int row = brow + ai * 128 + wr * 64 + m * 16 + fq * 4 + j;
            const float v = acc[ai][bj][m][n][j];
            if constexpr (EPI == EPI_E1) {
              if (colg < EVEN_IN) {
                ((bfu*)(p.ws + WS_PBUF))[(size_t)row * EVEN_IN + col] = f2bf(v);
                if (brow < TP) {
                  size_t orow = (size_t)((row >> 8) * 2 + li) * 256 + (row & 255);
                  if (colg >= 1024 && colg < 2048) p.out[OUT_NAK + orow * 1024 + (col - 1024)] = v;
                  else if (colg >= 2048 && colg < 3072) p.out[OUT_NAV + orow * 1024 + (col - 2048)] = v;
                  else if (colg >= 4864 && colg < 4928) p.out[OUT_KPE + orow * 64 + (col - 4864)] = v;
                }
              }
            } else if constexpr (EPI == EPI_O1) {
              ((bfu*)(p.ws + WS_PBUF))[(size_t)row * ODD_IN + col] = f2bf(v);
              if (brow < TP) {
                size_t orow = (size_t)((row >> 8) * 2 + li) * 256 + (row & 255);
                if (colg >= 2048 && colg < 4096) p.out[OUT_DK + orow * 2048 + (col - 2048)] = v;
                else if (colg >= 4096 && colg < 6144) p.out[OUT_DV + orow * 2048 + (col - 4096)] = v;
              }
            } else if constexpr (EPI == EPI_QM) {
              ((bfu*)(p.ws + WS_QM))[(size_t)row * 1536 + col] = f2bf(v);
            } else if constexpr (EPI == EPI_KV) {
              int hd = col >> 8, jj = col & 255;
              if (jj < 128) ((bfu*)(p.ws + WS_KMLA))[(size_t)row * 1536 + hd * 192 + jj] = f2bf(v);
              else ((bfu*)(p.ws + WS_VMLA))[(size_t)row * 1024 + hd * 128 + (jj - 128)] = f2bf(v);
            } else {
              ((float*)(p.ws + WS_YBUF))[(size_t)row * D + col] = v;
            }
          }
      }
}

DI int tile_id(int it) {
  const int G = gridDim.x;
  const int pb = (G & 7) == 0 ? (blockIdx.x & 7) * (G >> 3) + (blockIdx.x >> 3) : blockIdx.x;
  return it * G + pb;
}
DI void tile_mn(int id, int nN, int& m, int& n) {
  int grp = id / (8 * nN), rem = id % (8 * nN);
  m = grp * 8 + (rem & 7); n = rem >> 3;
}

DI void phase_mid(const Params& p, int li) {
  const int tid = opaque(threadIdx.x), lane = tid & 63, wid = tid >> 6;
  const bfu* P = (const bfu*)(p.ws + WS_PBUF);
  bfu* cqn = (bfu*)(p.ws + WS_CQN);
  bfu* ckvn = (bfu*)(p.ws + WS_CKVN);
  bfu* kmla = (bfu*)(p.ws + WS_KMLA);
  const float* gq = p.in[17] + li * 512;
  const float* gkv = p.in[19] + li * 256;
  for (int t = blockIdx.x * 8 + wid; t < TALL; t += gridDim.x * 8) {
    float kp;
    if (t < T) {
      const bfu* Pr = P + (size_t)t * EVEN_IN;
      {
        u32x4 w = *(const u32x4*)(Pr + 4096 + lane * 8);
        float v[8] = {bflo(w[0]), bfhi(w[0]), bflo(w[1]), bfhi(w[1]), bflo(w[2]), bfhi(w[2]), bflo(w[3]), bfhi(w[3])};
        float ss = 0;
#pragma unroll
        for (int e = 0; e < 8; ++e) ss += v[e] * v[e];
        ss = wave_sum(ss);
        float rstd = rsqrtf(ss * (1.f / 512.f) + EPS);
#pragma unroll
        for (int e = 0; e < 8; ++e) v[e] = v[e] * rstd * gq[lane * 8 + e];
        u32x4 o = {cvtpk(v[0], v[1]), cvtpk(v[2], v[3]), cvtpk(v[4], v[5]), cvtpk(v[6], v[7])};
        *(u32x4*)(cqn + (size_t)t * 512 + lane * 8) = o;
      }
      {
        u32x2 w = *(const u32x2*)(Pr + 4608 + lane * 4);
        float v[4] = {bflo(w[0]), bfhi(w[0]), bflo(w[1]), bfhi(w[1])};
        float ss = v[0] * v[0] + v[1] * v[1] + v[2] * v[2] + v[3] * v[3];
        ss = wave_sum(ss);
        float rstd = rsqrtf(ss * (1.f / 256.f) + EPS);
#pragma unroll
        for (int e = 0; e < 4; ++e) v[e] = v[e] * rstd * gkv[lane * 4 + e];
        u32x2 o = {cvtpk(v[0], v[1]), cvtpk(v[2], v[3])};
        *(u32x2*)(ckvn + (size_t)t * 256 + lane * 4) = o;
        if (t < TP) {
          size_t orow = (size_t)((t >> 8) * 2 + li) * 256 + (t & 255);
          f32x4 f = {v[0], v[1], v[2], v[3]};
          *(f32x4*)(p.out + OUT_CKV + orow * 256 + lane * 4) = f;
        }
      }
      kp = bf2f(Pr[4864 + lane]);
      if (t >= TP) {
        int s = (t - TP) & 2047;
        float pos = (float)(lane < 32 ? (s >> 6) : (s & 63));
        int jj = lane & 15;
        float inv = exp2f(-(float)jj * (LOG2_ROPE / 16.f));
        float ang = pos * inv;
        float cs = __cosf(ang), sn = __sinf(ang);
        float pv = __shfl_xor(kp, 16);
        kp = (lane & 16) ? (kp * cs + pv * sn) : (kp * cs - pv * sn);
      }
    } else {
      int ci = t - T;
      int b = ci >> 9, j = ci & 511;
      size_t crow_ = (size_t)(b * 2 + li) * 512 + j;
      f32x4 f = *(const f32x4*)(p.in[4] + crow_ * 256 + lane * 4);
      u32x2 o = {cvtpk(f[0], f[1]), cvtpk(f[2], f[3])};
      *(u32x2*)(ckvn + (size_t)t * 256 + lane * 4) = o;
      kp = p.in[5][crow_ * 64 + lane];
    }
    bfu kb = f2bf(kp);
#pragma unroll
    for (int hd = 0; hd < 8; ++hd) kmla[(size_t)t * 1536 + hd * 192 + 128 + lane] = kb;
  }
}

struct Seg { const bfu* K; const bfu* V; int ldk, ldv, n; };
constexpr int ATT_KB = 24576, ATT_VB = 16384, ATT_BUF = ATT_KB + ATT_VB;
constexpr int ATT_BIAS_OFF = 3 * ATT_BUF;
constexpr int ATT_TR_ROW = 132;

template <int DQK>
DI void attn_issue(const int tid, const bfu* __restrict__ Kp, const bfu* __restrict__ Vp, int ldk, int ldv, char* buf) {
  constexpr int KROWB = DQK * 2;
#pragma unroll
  for (int i = 0; i < DQK / 64; ++i) {
    int bb = i * 8192 + tid * 16, row = bb / KROWB, cpos = (bb % KROWB) >> 4, c = cpos ^ (row & 7);
    __builtin_amdgcn_global_load_lds((const unsigned*)(Kp + (size_t)row * ldk + c * 8),
                                     (__attribute__((address_space(3))) unsigned*)(buf + bb), 16, 0, 0);
  }
#pragma unroll
  for (int i = 0; i < 2; ++i) {
    int bb = i * 8192 + tid * 16, row = bb >> 8, cpos = (bb & 255) >> 4, c = cpos ^ ((row & 3) << 2);
    __builtin_amdgcn_global_load_lds((const unsigned*)(Vp + (size_t)row * ldv + c * 8),
                                     (__attribute__((address_space(3))) unsigned*)(buf + ATT_KB + bb), 16, 0, 0);
  }
}

template <int DQK, bool NA, bool ROPEQ>
DI void attn_core(const int tid, f32x16* o, const bfu* __restrict__ Qrow, const Seg& s0, const Seg& s1, float C, char* lds,
                  int gr, int gc, int kr0, float prow, float pcol) {
  constexpr int KROWB = DQK * 2;
  constexpr int ND = DQK / 16;
  const int lane = tid & 63, r32 = lane & 31, hh = lane >> 5;
  const bool lag = __builtin_amdgcn_readfirstlane(tid >> 8) != 0;
  const float* sbias = (const float*)(lds + ATT_BIAS_OFF);
  const int nt0 = s0.n >> 6, ntile = nt0 + (s1.n >> 6);
  auto issue_tile = [&](int jt, int slot) {
    const bool in0 = jt < nt0;
    const bfu* Kp = in0 ? s0.K + (size_t)(jt * 64) * s0.ldk : s1.K + (size_t)((jt - nt0) * 64) * s1.ldk;
    const bfu* Vp = in0 ? s0.V + (size_t)(jt * 64) * s0.ldv : s1.V + (size_t)((jt - nt0) * 64) * s1.ldv;
    attn_issue<DQK>(tid, Kp, Vp, in0 ? s0.ldk : s1.ldk, in0 ? s0.ldv : s1.ldv, lds + slot * ATT_BUF);
  };
  __syncthreads();
  issue_tile(0, 0);
  bf16x8 qr[ND];
#pragma unroll
  for (int d0 = 0; d0 < ND; ++d0) qr[d0] = *(const bf16x8*)(Qrow + d0 * 16);
  if constexpr (ROPEQ) {
#pragma unroll
    for (int pr = 0; pr < 2; ++pr) {
      float pos = pr == 0 ? prow : pcol;
      bf16x8 a = qr[8 + 2 * pr], b = qr[9 + 2 * pr];
      float xa[8], xb[8];
#pragma unroll
      for (int e = 0; e < 8; ++e) {
        float inv = exp2f(-(float)(8 * hh + e) * (LOG2_ROPE / 16.f));
        float ang = pos * inv;
        float cs = __cosf(ang), sn = __sinf(ang);
        float x1 = bf2f((bfu)a[e]), x2 = bf2f((bfu)b[e]);
        xa[e] = x1 * cs - x2 * sn; xb[e] = x2 * cs + x1 * sn;
      }
      u32x4 wa = {cvtpk(xa[0], xa[1]), cvtpk(xa[2], xa[3]), cvtpk(xa[4], xa[5]), cvtpk(xa[6], xa[7])};
      u32x4 wb = {cvtpk(xb[0], xb[1]), cvtpk(xb[2], xb[3]), cvtpk(xb[4], xb[5]), cvtpk(xb[6], xb[7])};
      qr[8 + 2 * pr] = __builtin_bit_cast(bf16x8, wa); qr[9 + 2 * pr] = __builtin_bit_cast(bf16x8, wb);
    }
  }
#pragma unroll
  for (int d = 0; d < 4; ++d)
#pragma unroll
    for (int r = 0; r < 16; ++r) o[d][r] = 0.f;
  float m = -1e30f, l = 0.f;
  const int rs = min(max(gr - 4, 0), 24), cs_ = min(max(gc - 8, 0), 48);
  int kad[4];
#pragma unroll
  for (int q = 0; q < 4; ++q) kad[q] = r32 * KROWB + (((q * 2 + hh) ^ (r32 & 7)) << 4);
  const int q_ = (lane & 15) >> 2;
  int vad[4];
#pragma unroll
  for (int d = 0; d < 4; ++d) vad[d] = ATT_KB + (hh * 4 + q_) * 256 + ((d ^ q_) << 6) + (16 * ((lane >> 4) & 1) + 4 * (lane & 3)) * 2;

  auto qk_sm = [&](bf16x8* pa, const char* buf, const int j) {
    f32x16 p0, p1;
#pragma unroll
    for (int r = 0; r < 16; ++r) { p0[r] = 0.f; p1[r] = 0.f; }
#pragma unroll
    for (int hb = 0; hb < ND; hb += 4) {
      bf16x8 k0[4], k1[4];
#pragma unroll
      for (int d = 0; d < 4; ++d) {
        k0[d] = *(const bf16x8*)(buf + kad[d] + (hb >> 2) * 128);
        k1[d] = *(const bf16x8*)(buf + kad[d] + (hb >> 2) * 128 + 32 * KROWB);
      }
      __builtin_amdgcn_sched_barrier(0);
#pragma unroll
      for (int d = 0; d < 4; ++d) {
        p0 = mfma(k0[d], qr[hb + d], p0);
        p1 = mfma(k1[d], qr[hb + d], p1);
      }
      __builtin_amdgcn_sched_barrier(0);
    }
    float mx;
    if (NA && j >= nt0) {
      const int kr = kr0 + (j - nt0);
      const bool rowok = (kr >= rs) && (kr < rs + 8);
      const int brow = (kr - gr + 7) * 31 - gc + 15;
#pragma unroll
      for (int r = 0; r < 16; ++r) {
        int kc0 = crow(r, hh), kc1 = 32 + kc0;
        bool ok0 = rowok && (kc0 >= cs_) && (kc0 < cs_ + 16);
        bool ok1 = rowok && (kc1 >= cs_) && (kc1 < cs_ + 16);
        float b0 = sbias[ok0 ? brow + kc0 : 0], b1 = sbias[ok1 ? brow + kc1 : 0];
        p0[r] = ok0 ? p0[r] * C + b0 : -1e30f;
        p1[r] = ok1 ? p1[r] * C + b1 : -1e30f;
      }
      mx = p0[0];
#pragma unroll
      for (int r = 1; r < 16; ++r) mx = fmaxf(mx, p0[r]);
#pragma unroll
      for (int r = 0; r < 16; ++r) mx = fmaxf(mx, p1[r]);
      mx = fmaxf(mx, xor32(mx));
    } else {
      mx = p0[0];
#pragma unroll
      for (int r = 1; r < 16; ++r) mx = fmaxf(mx, p0[r]);
#pragma unroll
      for (int r = 0; r < 16; ++r) mx = fmaxf(mx, p1[r]);
      mx = fmaxf(mx, xor32(mx)) * C;
    }
    const float mn = fmaxf(m, mx);
    const float alpha = __builtin_amdgcn_exp2f(m - mn);
    m = mn;
    f2_t ps2 = {0.f, 0.f};
    if (NA && j >= nt0) {
#pragma unroll
      for (int r = 0; r < 16; r += 2) {
        p0[r] = __builtin_amdgcn_exp2f(p0[r] - mn); p0[r + 1] = __builtin_amdgcn_exp2f(p0[r + 1] - mn);
        p1[r] = __builtin_amdgcn_exp2f(p1[r] - mn); p1[r + 1] = __builtin_amdgcn_exp2f(p1[r + 1] - mn);
        f2_t a = {p0[r], p0[r + 1]}, b = {p1[r], p1[r + 1]};
        ps2 += a; ps2 += b;
      }
    } else {
      const f2_t c2 = {C, C}, nm2 = {-mn, -mn};
#pragma unroll
      for (int r = 0; r < 16; r += 2) {
        f2_t a = {p0[r], p0[r + 1]}, b = {p1[r], p1[r + 1]};
        a = a * c2 + nm2; b = b * c2 + nm2;
        p0[r] = __builtin_amdgcn_exp2f(a[0]); p0[r + 1] = __builtin_amdgcn_exp2f(a[1]);
        p1[r] = __builtin_amdgcn_exp2f(b[0]); p1[r + 1] = __builtin_amdgcn_exp2f(b[1]);
        f2_t ea = {p0[r], p0[r + 1]}, eb = {p1[r], p1[r + 1]};
        ps2 += ea; ps2 += eb;
      }
    }
    float ps = ps2[0] + ps2[1];
    ps += xor32(ps);
    l = l * alpha + ps;
    if (__any(alpha != 1.f)) {
#pragma unroll
      for (int d = 0; d < 4; ++d)
#pragma unroll
        for (int r = 0; r < 16; ++r) o[d][r] *= alpha;
    }
    u32x4 w0 = {cvtpk(p0[0], p0[1]), cvtpk(p0[2], p0[3]), cvtpk(p0[4], p0[5]), cvtpk(p0[6], p0[7])};
    u32x4 w1 = {cvtpk(p0[8], p0[9]), cvtpk(p0[10], p0[11]), cvtpk(p0[12], p0[13]), cvtpk(p0[14], p0[15])};
    u32x4 w2 = {cvtpk(p1[0], p1[1]), cvtpk(p1[2], p1[3]), cvtpk(p1[4], p1[5]), cvtpk(p1[6], p1[7])};
    u32x4 w3 = {cvtpk(p1[8], p1[9]), cvtpk(p1[10], p1[11]), cvtpk(p1[12], p1[13]), cvtpk(p1[14], p1[15])};
    pa[0] = __builtin_bit_cast(bf16x8, w0); pa[1] = __builtin_bit_cast(bf16x8, w1);
    pa[2] = __builtin_bit_cast(bf16x8, w2); pa[3] = __builtin_bit_cast(bf16x8, w3);
  };
  auto pv = [&](const bf16x8* pa, const char* buf) {
#pragma unroll
    for (int d = 0; d < 4; ++d) {
      s16x4 lo[4], hi[4];
#pragma unroll
      for (int s = 0; s < 4; ++s) {
        lo[s] = __builtin_amdgcn_ds_read_tr16_b64_v4i16((s16x4 __attribute__((address_space(3)))*)(buf + vad[d] + (16 * s) * 256));
        hi[s] = __builtin_amdgcn_ds_read_tr16_b64_v4i16((s16x4 __attribute__((address_space(3)))*)(buf + vad[d] + (16 * s + 8) * 256));
      }
#pragma unroll
      for (int s = 0; s < 4; ++s) {
        bf16x8 vb = {lo[s][0], lo[s][1], lo[s][2], lo[s][3], hi[s][0], hi[s][1], hi[s][2], hi[s][3]};
        o[d] = mfma(vb, pa[s], o[d]);
      }
    }
  };

  if (!lag) {
    int sl = 0;
    for (int j = 0; j <= ntile; ++j) {
      asm volatile("s_waitcnt vmcnt(0)" ::: "memory");
      __builtin_amdgcn_s_barrier();
      const int sn = sl == 2 ? 0 : sl + 1;
      if (j + 1 < ntile) issue_tile(j + 1, sn);
      if (j < ntile) { bf16x8 pa[4]; qk_sm(pa, lds + sl * ATT_BUF, j); pv(pa, lds + sl * ATT_BUF); }
      sl = sn;
    }
  } else {
    bf16x8 pa[4];
    int sl = 0;
    for (int j = 0; j <= ntile; ++j) {
      asm volatile("s_waitcnt vmcnt(0)" ::: "memory");
      __builtin_amdgcn_s_barrier();
      const int sn = sl == 2 ? 0 : sl + 1, sp = sl == 0 ? 2 : sl - 1;
      if (j + 1 < ntile) issue_tile(j + 1, sn);
      if (j > 0) pv(pa, lds + sp * ATT_BUF);
      if (j < ntile) qk_sm(pa, lds + sl * ATT_BUF, j);
      sl = sn;
    }
  }
  const float linv = 1.f / l;
#pragma unroll
  for (int d = 0; d < 4; ++d)
#pragma unroll
    for (int r = 0; r < 16; ++r) o[d][r] *= linv;
}

DI float* tr_stage(const int tid, const f32x16* o, char* lds) {
  const int lane = tid & 63, wid = tid >> 6, r32 = lane & 31, hh = lane >> 5;
  float* tr = (float*)lds + wid * (32 * ATT_TR_ROW);
  __syncthreads();
#pragma unroll
  for (int d = 0; d < 4; ++d)
#pragma unroll
    for (int g = 0; g < 4; ++g) {
      f32x4 v = {o[d][4 * g], o[d][4 * g + 1], o[d][4 * g + 2], o[d][4 * g + 3]};
      *(f32x4*)(tr + r32 * ATT_TR_ROW + d * 32 + 8 * g + 4 * hh) = v;
    }
  return tr;
}

DI void store_gated(const int tid, const Params& p, const f32x16* o, int t0, int gcol, int ocol, char* lds) {
  const int lane = tid & 63, wid = tid >> 6;
  const bfu* P = (const bfu*)(p.ws + WS_PBUF);
  bfu* O = (bfu*)(p.ws + WS_HBUF);
  const float* tr = tr_stage(tid, o, lds);
#pragma unroll 1
  for (int r0 = 0; r0 < 32; r0 += 8) {
    unsigned g[8];
#pragma unroll
    for (int u = 0; u < 8; ++u) g[u] = *(const unsigned*)(P + (size_t)(t0 + wid * 32 + r0 + u) * EVEN_IN + gcol + lane * 2);
#pragma unroll
    for (int u = 0; u < 8; ++u) {
      f2_t v = *(const f2_t*)(tr + (r0 + u) * ATT_TR_ROW + lane * 2);
      *(unsigned*)(O + (size_t)(t0 + wid * 32 + r0 + u) * D + ocol + lane * 2) = cvtpk(v[0] * silu(bflo(g[u])), v[1] * silu(bfhi(g[u])));
    }
  }
}

DI int xcd_item(int item) {
  if (gridDim.x != 256) return item;
  const int blk = item & 255, sweep = item >> 8;
  const int xcd = blk & 7, slot = blk >> 3, gl = slot >> 3, qb = slot & 7;
  return sweep * 256 + ((gl * 8 + xcd) << 3) + qb;
}

DI void phase_attn_even(const Params& p, int li, char* lds) {
  const bfu* P = (const bfu*)(p.ws + WS_PBUF);
  const bfu* Qm = (const bfu*)(p.ws + WS_QM);
  const bfu* Km = (const bfu*)(p.ws + WS_KMLA);
  const bfu* Vm = (const bfu*)(p.ws + WS_VMLA);
  const bfu* cnk = (const bfu*)(p.ws + WS_C_NAK);
  const bfu* cnv = (const bfu*)(p.ws + WS_C_NAV);
  const float CM = 0.07216878364870322f * LOG2E;
  const float CN = 0.08838834764831845f * LOG2E;
  int item = blockIdx.x;
  for (; item < 512; item += gridDim.x) {
    const int tid = opaque(threadIdx.x), lane = tid & 63, wid = tid >> 6, r32 = lane & 31, hh = lane >> 5;
    f32x16 o[4];
    const int xi = xcd_item(item);
    int b = xi >> 6, hd = (xi >> 3) & 7, qb = xi & 7;
    int t0 = TP + b * 2048 + qb * 256;
    int trow = t0 + wid * 32 + r32;
    int s = qb * 256 + wid * 32 + r32;
    Seg s0 = {Km + (size_t)(T + b * 512) * 1536 + hd * 192, Vm + (size_t)(T + b * 512) * 1024 + hd * 128, 1536, 1024, 512};
    Seg s1 = {Km + (size_t)(TP + b * 2048) * 1536 + hd * 192, Vm + (size_t)(TP + b * 2048) * 1024 + hd * 128, 1536, 1024, 2048};
    attn_core<192, false, true>(tid, o, Qm + (size_t)trow * 1536 + hd * 192 + hh * 8, s0, s1, CM, lds, 0, 0, 0, (float)(s >> 6), (float)(s & 63));
    store_gated(tid, p, o, t0, 4928 + hd * 128, 1024 + hd * 128, lds);
  }
  for (; item < 1024; item += gridDim.x) {
    const int tid = opaque(threadIdx.x), lane = tid & 63, wid = tid >> 6, r32 = lane & 31, hh = lane >> 5;
    const int it = xcd_item(item - 512);
    f32x16 o[4];
    int b = it >> 6, hd = (it >> 3) & 7, qb = it & 7;
    int t0 = TP + b * 2048 + qb * 256;
    int trow = t0 + wid * 32 + r32;
    int qi = wid * 32 + r32;
    int gr = qb * 4 + (qi >> 6), gc = qi & 63;
    int kr0 = min(max(qb * 4 - 4, 0), 24);
    int kr1 = min(max(qb * 4 + 3 - 4, 0), 24) + 8;
    __syncthreads();
    float* sb = (float*)(lds + ATT_BIAS_OFF);
    for (int idx = tid; idx < 465; idx += 512) sb[idx] = p.in[16][(size_t)(li * 8 + hd) * 465 + idx] * LOG2E;
    Seg s0 = {cnk + (size_t)((b * 2 + li) * 512) * 1024 + hd * 128, cnv + (size_t)((b * 2 + li) * 512) * 1024 + hd * 128, 1024, 1024, 512};
    const bfu* Pl = P + (size_t)(TP + b * 2048 + kr0 * 64) * EVEN_IN;
    Seg s1 = {Pl + 1024 + hd * 128, Pl + 2048 + hd * 128, EVEN_IN, EVEN_IN, (kr1 - kr0) * 64};
    attn_core<128, true, false>(tid, o, P + (size_t)trow * EVEN_IN + hd * 128 + hh * 8, s0, s1, CN, lds, gr, gc, kr0, 0.f, 0.f);
    store_gated(tid, p, o, t0, 3072 + hd * 128, hd * 128, lds);
  }
  for (; item < 1280; item += gridDim.x) {
    const int tid = opaque(threadIdx.x), lane = tid & 63, wid = tid >> 6, r32 = lane & 31, hh = lane >> 5;
    const int it = item - 1024;
    f32x16 o[4];
    int b = it >> 3, hd = it & 7;
    int t0 = b * 256;
    int trow = t0 + wid * 32 + r32;
    Seg s0 = {Km + (size_t)(b * 256) * 1536 + hd * 192, Vm + (size_t)(b * 256) * 1024 + hd * 128, 1536, 1024, 256};
    Seg s1 = {s0.K, s0.V, 1536, 1024, 0};
    attn_core<192, false, false>(tid, o, Qm + (size_t)trow * 1536 + hd * 192 + hh * 8, s0, s1, CM, lds, 0, 0, 0, 0.f, 0.f);
    store_gated(tid, p, o, t0, 4928 + hd * 128, 1024 + hd * 128, lds);
  }
  for (; item < 1536; item += gridDim.x) {
    const int tid = opaque(threadIdx.x), lane = tid & 63, wid = tid >> 6, r32 = lane & 31, hh = lane >> 5;
    const int it = item - 1280;
    f32x16 o[4];
    int b = it >> 3, hd = it & 7;
    int t0 = b * 256;
    int trow = t0 + wid * 32 + r32;
    const bfu* Pb = P + (size_t)(b * 256) * EVEN_IN;
    Seg s0 = {Pb + 1024 + hd * 128, Pb + 2048 + hd * 128, EVEN_IN, EVEN_IN, 256};
    Seg s1 = {s0.K, s0.V, EVEN_IN, EVEN_IN, 0};
    attn_core<128, false, false>(tid, o, P + (size_t)trow * EVEN_IN + hd * 128 + hh * 8, s0, s1, CN, lds, 0, 0, 0, 0.f, 0.f);
    store_gated(tid, p, o, t0, 3072 + hd * 128, hd * 128, lds);
  }
}

DI void phase_attn_odd(const Params& p, int l, char* lds) {
  const int li = l >> 1;
  const bfu* P = (const bfu*)(p.ws + WS_PBUF);
  bfu* O = (bfu*)(p.ws + WS_HBUF);
  const bfu* cdk = (const bfu*)(p.ws + WS_C_DK);
  const bfu* cdv = (const bfu*)(p.ws + WS_C_DV);
  float* scr = (float*)(p.ws + WS_SCR) + (size_t)blockIdx.x * 65536;
  const float CD = 0.08838834764831845f * LOG2E;
  const float lam_init = 0.8f - 0.6f * expf(-0.3f * (float)l);
  float lam;
  {
    const float* lp = p.in[23] + li * 512;
    float s1 = 0.f, s2 = 0.f;
    for (int k = 0; k < 128; ++k) { s1 += lp[k] * lp[128 + k]; s2 += lp[256 + k] * lp[384 + k]; }
    lam = expf(s1) - expf(s2) + lam_init;
  }
  const float* gsub = p.in[24] + li * 256;
  for (int item = blockIdx.x; item < 768; item += gridDim.x) {
    const int tid = opaque(threadIdx.x), lane = tid & 63, wid = tid >> 6, r32 = lane & 31, hh = lane >> 5;
    int b, hd, t0; Seg s0, s1;
    if (item < 512) {
      const int xi = xcd_item(item);
      b = xi >> 6; hd = (xi >> 3) & 7; int qb = xi & 7;
      t0 = TP + b * 2048 + qb * 256;
      const bfu* Pl = P + (size_t)(TP + b * 2048) * ODD_IN;
      s0 = Seg{cdk + (size_t)((b * 2 + li) * 512) * 2048 + hd * 256, cdv + (size_t)((b * 2 + li) * 512) * 2048 + hd * 256, 2048, 2048, 512};
      s1 = Seg{Pl + 2048 + hd * 256, Pl + 4096 + hd * 256, ODD_IN, ODD_IN, 2048};
    } else {
      int it = item - 512;
      b = it >> 3; hd = it & 7;
      t0 = b * 256;
      const bfu* Pb = P + (size_t)(b * 256) * ODD_IN;
      s0 = Seg{Pb + 2048 + hd * 256, Pb + 4096 + hd * 256, ODD_IN, ODD_IN, 256};
      s1 = Seg{s0.K, s0.V, ODD_IN, ODD_IN, 0};
    }
    const int trow = t0 + wid * 32 + r32;
    float ssq = 0.f;
    for (int pass = 0; pass < 4; ++pass) {
      const int vh = pass >> 1, c = pass & 1;
      f32x16 o[4];
      Seg a0 = s0, a1 = s1;
      a0.K += c * 128; a1.K += c * 128; a0.V += vh * 128; a1.V += vh * 128;
      for (int rep = 0; rep < p.nrep; ++rep)
        attn_core<128, false, false>(tid, o, P + (size_t)trow * ODD_IN + hd * 256 + c * 128 + hh * 8, a0, a1, CD, lds, 0, 0, 0, 0.f, 0.f);
      float* sc = scr + vh * 32768 + tid;
      if (c == 1) {
        float ss = 0.f;
#pragma unroll
        for (int d = 0; d < 4; ++d)
#pragma unroll
          for (int r = 0; r < 16; ++r) {
            float dd = sc[(d * 16 + r) * 512] - lam * o[d][r];
            o[d][r] = dd; ss += dd * dd;
          }
        ssq += ss;
      }
#pragma unroll
      for (int d = 0; d < 4; ++d)
#pragma unroll
        for (int r = 0; r < 16; ++r) sc[(d * 16 + r) * 512] = o[d][r];
    }
    ssq += __shfl_xor(ssq, 32);
    const float rstd = rsqrtf(ssq * (1.f / 256.f) + EPS) * (1.f - lam_init);
    for (int half = 0; half < 2; ++half) {
      f32x16 o[4];
      const float* sc = scr + half * 32768 + tid;
#pragma unroll
      for (int d = 0; d < 4; ++d)
#pragma unroll
        for (int r = 0; r < 16; ++r) o[d][r] = sc[(d * 16 + r) * 512] * rstd;
      const float* tr = tr_stage(tid, o, lds);
      const int colb = hd * 256 + half * 128 + lane * 2;
      const float g0 = gsub[half * 128 + lane * 2], g1 = gsub[half * 128 + lane * 2 + 1];
#pragma unroll 1
      for (int r0 = 0; r0 < 32; r0 += 8) {
        unsigned g[8];
#pragma unroll
        for (int u = 0; u < 8; ++u) g[u] = *(const unsigned*)(P + (size_t)(t0 + wid * 32 + r0 + u) * ODD_IN + 6144 + colb);
#pragma unroll
        for (int u = 0; u < 8; ++u) {
          f2_t v = *(const f2_t*)(tr + (r0 + u) * ATT_TR_ROW + lane * 2);
          *(unsigned*)(O + (size_t)(t0 + wid * 32 + r0 + u) * D + colb) = cvtpk(v[0] * g0 * silu(bflo(g[u])), v[1] * g1 * silu(bfhi(g[u])));
        }
      }
    }
  }
}

#ifndef PM
#define PM 0xffff
#endif
template <int EPI>
DI void gemm_phase(const Params& p, const bfu* A, const bfu* Bt, int K, int nM, int nN, int li, char* lds) {
  const int ntiles = nM * nN;
  for (int it = 0; it * (int)gridDim.x < ntiles; ++it) {
    int id = tile_id(it);
    if (id >= ntiles) continue;
    int m, n; tile_mn(id, nN, m, n);
    gemm256<EPI>(p, A, Bt, K, m * 256, n * 256, li, lds);
  }
}

DI void run_phase(const Params& p, int ph, char* lds) {
  if (ph == 0) { if (PM & 1) phase_prep(p, lds); return; }
  if (ph == 1) { if (PM & 2) phase_rows(p, 0, 0, lds); return; }
  const int q = ph - 2, pair = q / 10, r = q % 10;
  const bfu* hbuf = (const bfu*)(p.ws + WS_HBUF);
  if (r < 6) {
    const int l = 2 * pair, li = pair;
    if (r == 0 && (PM & 4)) {
      gemm_phase<EPI_E1>(p, hbuf, (const bfu*)(p.ws + WS_WT_IN_E) + (size_t)li * EVEN_PAD * D, D, 96, 24, li, lds);
    } else if (r == 1 && (PM & 8)) {
      phase_mid(p, li);
    } else if (r == 2 && (PM & 16)) {
      gemm_phase<EPI_QM>(p, (const bfu*)(p.ws + WS_CQN), (const bfu*)(p.ws + WS_WT_UQ) + (size_t)li * 1536 * 512, 512, 96, 6, li, lds);
      gemm_phase<EPI_KV>(p, (const bfu*)(p.ws + WS_CKVN), (const bfu*)(p.ws + WS_WT_UKV) + (size_t)li * 2048 * 256, 256, 112, 8, li, lds);
    } else if (r == 3 && (PM & 32)) {
      phase_attn_even(p, li, lds);
    } else if (r == 4 && (PM & 64)) {
      gemm_phase<EPI_Y>(p, hbuf, (const bfu*)(p.ws + WS_WT_OUT_E) + (size_t)li * D * D, D, 96, 8, li, lds);
    } else if (r == 5 && (PM & 128)) {
      phase_rows(p, 1, l, lds);
    }
  } else {
    const int l = 2 * pair + 1, li = pair, k = r - 6;
    if (k == 0 && (PM & 256)) {
      gemm_phase<EPI_O1>(p, hbuf, (const bfu*)(p.ws + WS_WT_IN_O) + (size_t)li * ODD_IN * D, D, 96, 32, li, lds);
    } else if (k == 1 && (PM & 512)) {
      phase_attn_odd(p, l, lds);
    } else if (k == 2 && (PM & 1024)) {
      gemm_phase<EPI_Y>(p, hbuf, (const bfu*)(p.ws + WS_WT_OUT_O) + (size_t)li * D * D, D, 96, 8, li, lds);
    } else if (k == 3 && (PM & 2048)) {
      phase_rows(p, 1, l, lds);
    }
  }
}


#define XB_TMO      128
#define XB_XCNT(j)  (256  + 64 * (j))
#define XB_XSUB(j)  (1280 + 64 * (j))
#define XB_XGEN(j)  (2304 + 64 * (j))
#define XB_TOP      3328
#define XB_TOPGEN   3392
#define XCD_BAR_WORDS 3456
#define XB_SPIN_CAP (1u << 22)
#define LAS __attribute__((address_space(3)))
DI unsigned xb_ld(unsigned* p)              { return __hip_atomic_load(p, __ATOMIC_RELAXED, __HIP_MEMORY_SCOPE_AGENT); }
DI unsigned xb_add(unsigned* p, unsigned v) { return __hip_atomic_fetch_add(p, v, __ATOMIC_RELAXED, __HIP_MEMORY_SCOPE_AGENT); }
DI unsigned xb_xcc_id() { return (unsigned)__builtin_amdgcn_s_getreg((3 << 11) | 20) & 0xFu; }
#define XB_SPIN(cond, bar) do { unsigned _sp = 0; while (cond) { __builtin_amdgcn_s_sleep(1); \
    if ((++_sp & 255u) == 0u) { if (xb_ld(&(bar)[XB_TMO])) break; if (_sp > XB_SPIN_CAP) { atomicAdd(&(bar)[XB_TMO], 1u); break; } } } } while (0)
struct XcdBarrier { unsigned* bar; unsigned x; volatile LAS unsigned* st; };
DI XcdBarrier xcd_barrier_post(unsigned* bar, volatile LAS unsigned* st) {
  XcdBarrier b; b.bar = bar; b.x = xb_xcc_id(); b.st = st;
  if (threadIdx.x == 0) (void)xb_add(&bar[XB_XCNT(b.x)], 1u);
  return b;
}
DI void xcd_barrier_complete(unsigned* bar, unsigned x, unsigned& nloc, unsigned& nx) {
  const unsigned G = gridDim.x * gridDim.y * gridDim.z;
  unsigned sum, cnt, mine, sp = 0u;
  for (;;) {
    sum = 0u; cnt = 0u; mine = 0u;
#pragma unroll
    for (unsigned j = 0; j < 16; ++j) { const unsigned c = xb_ld(&bar[XB_XCNT(j)]); sum += c; cnt += (c > 0u) ? 1u : 0u; mine = (j == x) ? c : mine; }
    if (sum == G) break;
    __builtin_amdgcn_s_sleep(1);
    if ((++sp & 255u) == 0u) { if (xb_ld(&bar[XB_TMO])) break; if (sp > XB_SPIN_CAP) { atomicAdd(&bar[XB_TMO], 1u); break; } }
  }
  nloc = mine > 0u ? mine : 1u; nx = cnt > 0u ? cnt : 1u;
}
DI void xcd_barrier(const XcdBarrier& b) {
  asm volatile("s_waitcnt vmcnt(0)" ::: "memory");
  __syncthreads();
  if (threadIdx.x == 0) {
    unsigned* bar = b.bar;
    __builtin_amdgcn_s_waitcnt(0);
    unsigned nloc = b.st[0], nx = b.st[1];
    if (nloc == 0u) { xcd_barrier_complete(bar, b.x, nloc, nx); b.st[0] = nloc; b.st[1] = nx; }
    const unsigned old = xb_add(&bar[XB_XSUB(b.x)], 1u);
    const unsigned gen = old / nloc;
    if (old + 1u == (gen + 1u) * nloc) {
      __builtin_amdgcn_fence(__ATOMIC_RELEASE, "agent");
      asm volatile("s_waitcnt vmcnt(0)" ::: "memory");
      const unsigned og = xb_add(&bar[XB_TOP], 1u);
      const unsigned tg = og / nx;
      if (og + 1u == (tg + 1u) * nx) xb_add(&bar[XB_TOPGEN], 1u);
      else XB_SPIN(xb_ld(&bar[XB_TOPGEN]) == tg, bar);
      __builtin_amdgcn_fence(__ATOMIC_ACQUIRE, "agent");
      xb_add(&bar[XB_XGEN(b.x)], 1u);
      asm volatile("s_waitcnt vmcnt(0)" ::: "memory");
    } else {
      XB_SPIN(xb_ld(&bar[XB_XGEN(b.x)]) == gen, bar);
      __builtin_amdgcn_fence(__ATOMIC_ACQUIRE, "agent");
      asm volatile("s_waitcnt vmcnt(0)" ::: "memory");
    }
  }
  __syncthreads();
}

constexpr int N_PHASES = 22;
constexpr int LDS_BYTES = 8 * 32 * ATT_TR_ROW * 4;

__global__ void __launch_bounds__(512, 2) fwd_megakernel(Params p) {
  __shared__ __attribute__((aligned(16))) char lds[LDS_BYTES];
  __shared__ uint4 xb_words;
  cg::grid_group grid = cg::this_grid();
  if (threadIdx.x == 0) xb_words = make_uint4(0u, 0u, 0u, 0u);
  __syncthreads();
  XcdBarrier xb = xcd_barrier_post((unsigned*)(p.ws + WS_BAR), (volatile LAS unsigned*)&xb_words);
  for (int ph = p.lo; ph < p.hi; ++ph) {
    run_phase(p, ph, lds);
    if (ph + 1 < p.hi) { if (ph == 0) grid.sync(); else xcd_barrier(xb); }
  }
}

extern "C" void kernel_launch(void* const* d_in, const int* in_sizes, int n_in, void* d_out, int out_size, void* d_ws, size_t ws_size,
                              hipStream_t stream) {
  static int grid_blocks = 0;
  if (!grid_blocks) {
    int dev = 0, cus = 0, per_cu = 0;
    (void)hipGetDevice(&dev);
    (void)hipDeviceGetAttribute(&cus, hipDeviceAttributeMultiprocessorCount, dev);
    (void)hipOccupancyMaxActiveBlocksPerMultiprocessor(&per_cu, fwd_megakernel, 512, 0);
    if (per_cu < 1) per_cu = 1;
    per_cu = 1;
    grid_blocks = cus * per_cu;
    if (grid_blocks > 512) grid_blocks = 512;
  }
  if (n_in != 25 || ws_size < WS_NEED) {
    fprintf(stderr, "kernel_launch: bad n_in %d or ws_size %zu < %zu\n", n_in, ws_size, (size_t)WS_NEED);
    return;
  }
  Params p{};
  for (int i = 0; i < 25; ++i) p.in[i] = (const float*)d_in[i];
  p.out = (float*)d_out;
  p.ws = (char*)d_ws;
#ifndef NREP
#define NREP 1
#endif
  p.nrep = NREP; p.pad = 0;
#ifndef PROBE_PHASE
  p.lo = 0; p.hi = N_PHASES;
  void* args[] = {&p};
  (void)hipMemsetAsync((char*)d_ws + WS_BAR, 0, 16384, stream);
  hipError_t e = hipLaunchCooperativeKernel((void*)fwd_megakernel, dim3(grid_blocks), dim3(512), args, 0, stream);
  if (e != hipSuccess) fprintf(stderr, "cooperative launch failed: %s (grid %d)\n", hipGetErrorString(e), grid_blocks);
#else
  void* args[] = {&p};
  p.lo = 0; p.hi = PROBE_PHASE + 1;
  (void)hipMemsetAsync((char*)d_ws + WS_BAR, 0, 16384, stream);
  (void)hipLaunchCooperativeKernel((void*)fwd_megakernel, dim3(grid_blocks), dim3(512), args, 0, stream);
  p.lo = PROBE_PHASE; p.hi = N_PHASES;
  (void)hipMemsetAsync((char*)d_ws + WS_BAR, 0, 16384, stream);
  (void)hipLaunchCooperativeKernel((void*)fwd_megakernel, dim3(grid_blocks), dim3(512), args, 0, stream);
#endif
}
```

```cpp
#include <hip/hip_runtime.h>
#include <hip/hip_cooperative_groups.h>
#include <cstdio>
#include <cstdint>
namespace cg = cooperative_groups;

#define DI __device__ __forceinline__
typedef unsigned short bfu;
using bf16x8 = __attribute__((ext_vector_type(8))) short;
using s16x4  = __attribute__((ext_vector_type(4))) short;
using f32x16 = __attribute__((ext_vector_type(16))) float;
using f32x4  = __attribute__((ext_vector_type(4))) float;
using u32x4  = __attribute__((ext_vector_type(4))) unsigned;
using u32x2  = __attribute__((ext_vector_type(2))) unsigned;
typedef __bf16 bf2_t __attribute__((ext_vector_type(2)));
typedef float f2_t __attribute__((ext_vector_type(2)));

constexpr int D = 2048, TP = 8192, TS = 16384, T = 24576, TALL = 28672;
constexpr int EVEN_IN = 5952, ODD_IN = 8192;
constexpr float EPS = 1e-6f;
constexpr float LOG2E = 1.4426950408889634f;
constexpr float LOG2_ROPE = 13.287712379549449f;

constexpr size_t OUT_YP = 0, OUT_YS = 16777216, OUT_NAK = 50331648, OUT_NAV = 67108864, OUT_CKV = 83886080,
                 OUT_KPE = 88080384, OUT_DK = 89128960, OUT_DV = 122683392;

constexpr size_t al256(size_t x) { return (x + 255) / 256 * 256; }
constexpr size_t WS_WT_IN_E = 0;
constexpr int EVEN_PAD = 6144;
constexpr size_t WS_WT_IN_O = WS_WT_IN_E + al256((size_t)2 * EVEN_PAD * D * 2);
constexpr size_t WS_WT_OUT_E = WS_WT_IN_O + al256((size_t)2 * ODD_IN * D * 2);
constexpr size_t WS_WT_OUT_O = WS_WT_OUT_E + al256((size_t)2 * D * D * 2);
constexpr size_t WS_WT_UQ = WS_WT_OUT_O + al256((size_t)2 * D * D * 2);
constexpr size_t WS_WT_UKV = WS_WT_UQ + al256((size_t)2 * 1536 * 512 * 2);
constexpr size_t WS_C_NAK = WS_WT_UKV + al256((size_t)2 * 2048 * 256 * 2);
constexpr size_t WS_C_NAV = WS_C_NAK + al256((size_t)8 * 2 * 512 * 1024 * 2);
constexpr size_t WS_C_DK = WS_C_NAV + al256((size_t)8 * 2 * 512 * 1024 * 2);
constexpr size_t WS_C_DV = WS_C_DK + al256((size_t)8 * 2 * 512 * 2048 * 2);
constexpr size_t WS_MODP = WS_C_DV + al256((size_t)8 * 2 * 512 * 2048 * 2);
constexpr size_t WS_BAR = WS_MODP + al256((size_t)4 * 4 * 9 * 6144 * 4);
constexpr size_t WS_HBUF = WS_BAR + 16384;
constexpr size_t WS_CQN = WS_HBUF;
constexpr size_t WS_CKVN = WS_HBUF + al256((size_t)T * 512 * 2);
constexpr size_t WS_PBUF = WS_HBUF + al256((size_t)T * D * 2);
constexpr size_t WS_YBUF = WS_PBUF;
constexpr size_t WS_QM = WS_PBUF + al256((size_t)T * EVEN_IN * 2);
constexpr size_t WS_KMLA = WS_QM + al256((size_t)T * 1536 * 2);
constexpr size_t WS_VMLA = WS_KMLA + al256((size_t)TALL * 1536 * 2);
constexpr size_t WS_END_EVEN = WS_VMLA + al256((size_t)TALL * 1024 * 2);
constexpr size_t WS_SCR = WS_PBUF + al256((size_t)T * ODD_IN * 2);
constexpr size_t WS_END_ODD = WS_SCR + (size_t)1024 * 131072;
constexpr size_t WS_NEED = WS_END_EVEN > WS_END_ODD ? WS_END_EVEN : WS_END_ODD;

struct Params {
  const float* in[25];
  float* out;
  char* ws;
  int lo, hi;
  int nrep, pad;
};

DI unsigned cvtpk(float lo, float hi) {
  f2_t v = {lo, hi};
  bf2_t b = __builtin_convertvector(v, bf2_t);
  return __builtin_bit_cast(unsigned, b);
}
DI bfu f2bf(float x) { return (bfu)(cvtpk(x, 0.f) & 0xffffu); }
DI float bf2f(bfu b) { return __uint_as_float(((unsigned)b) << 16); }
DI float bflo(unsigned u) { return __uint_as_float(u << 16); }
DI float bfhi(unsigned u) { return __uint_as_float(u & 0xffff0000u); }
DI int opaque(int x) { asm volatile("" : "+v"(x)); return x; }
DI int crow(int r, int hi) { return (r & 3) + 8 * (r >> 2) + 4 * hi; }
DI float silu(float x) { return x * __builtin_amdgcn_rcpf(1.f + __expf(-x)); }
DI f32x16 mfma(bf16x8 a, bf16x8 b, f32x16 c) { return __builtin_amdgcn_mfma_f32_32x32x16_bf16(a, b, c, 0, 0, 0); }
DI float xor32(float v) {
  auto rr = __builtin_amdgcn_permlane32_swap(__float_as_uint(v), __float_as_uint(v), false, false);
  return __uint_as_float((threadIdx.x & 32) ? rr[0] : rr[1]);
}
DI float wave_sum(float v) {
#pragma unroll
  for (int o = 32; o >= 1; o >>= 1) v += __shfl_xor(v, o);
  return v;
}
DI float block_sum(float v, float* red, int tid) {
  v = wave_sum(v);
  __syncthreads();
  if ((tid & 63) == 0) red[tid >> 6] = v;
  __syncthreads();
  const int hb = (tid >> 8) * 4;
  return red[hb] + red[hb + 1] + red[hb + 2] + red[hb + 3];
}
DI float modval(const Params& p, int l, int r, int n) {
  const float* mp = (const float*)(p.ws + WS_MODP);
  float s = p.in[11][l * 6144 + n];
#pragma unroll
  for (int ks = 0; ks < 4; ++ks) s += mp[((size_t)(ks * 4 + l) * 9 + r) * 6144 + n];
  return s;
}

DI void prep_mod_item(const Params& p, int item, char* lds) {
  const int tid = opaque(threadIdx.x), lane = tid & 63, wid = tid >> 6;
  const int ks = item & 3, cgp = (item >> 2) % 24, l = item / 96;
  float* scond = (float*)lds;
  float* red = (float*)(lds + 18432);
  for (int idx = tid; idx < 9 * 512; idx += 512) {
    int r = idx >> 9, kk = idx & 511;
    float cv = r < 8 ? p.in[8][r * 2048 + ks * 512 + kk] : p.in[9][ks * 512 + kk];
    scond[idx] = silu(cv);
  }
  __syncthreads();
  const float* W = p.in[10] + ((size_t)l * 2048 + ks * 512 + wid * 64) * 6144 + cgp * 256 + lane * 4;
  float acc[9][4];
#pragma unroll
  for (int r = 0; r < 9; ++r) { acc[r][0] = 0; acc[r][1] = 0; acc[r][2] = 0; acc[r][3] = 0; }
  for (int kk = 0; kk < 64; kk += 4) {
    f32x4 w[4];
#pragma unroll
    for (int u = 0; u < 4; ++u) w[u] = *(const f32x4*)(W + (size_t)(kk + u) * 6144);
#pragma unroll
    for (int u = 0; u < 4; ++u) {
#pragma unroll
      for (int r = 0; r < 9; ++r) {
        float s = scond[r * 512 + wid * 64 + kk + u];
        acc[r][0] += s * w[u][0]; acc[r][1] += s * w[u][1]; acc[r][2] += s * w[u][2]; acc[r][3] += s * w[u][3];
      }
    }
  }
#pragma unroll
  for (int r = 0; r < 9; ++r) {
    f32x4 v = {acc[r][0], acc[r][1], acc[r][2], acc[r][3]};
    *(f32x4*)(red + (wid * 9 + r) * 256 + lane * 4) = v;
  }
  __syncthreads();
  float* mp = (float*)(p.ws + WS_MODP);
  for (int idx = tid; idx < 9 * 256; idx += 512) {
    int r = idx >> 8, cc = idx & 255;
    float s = 0.f;
#pragma unroll
    for (int w = 0; w < 8; ++w) s += red[(w * 9 + r) * 256 + cc];
    mp[((size_t)(ks * 4 + l) * 9 + r) * 6144 + cgp * 256 + cc] = s;
  }
  __syncthreads();
}

DI int swap45(int n) { return (n & ~0x30) | ((n & 0x10) << 1) | ((n & 0x20) >> 1); }

DI void prep_transpose_tile(const float* __restrict__ src, bfu* __restrict__ dst, int K, int N, int k0, int n0, char* lds, int tid) {
  float* tl = (float*)lds + (tid >> 8) * (64 * 65);
  const int t4 = tid & 255;
#pragma unroll
  for (int i = 0; i < 4; ++i) {
    int kr = (t4 >> 4) + 16 * i, nc = (t4 & 15) * 4;
    f32x4 v = *(const f32x4*)(src + (size_t)(k0 + kr) * N + n0 + nc);
    tl[kr * 65 + nc + 0] = v[0]; tl[kr * 65 + nc + 1] = v[1]; tl[kr * 65 + nc + 2] = v[2]; tl[kr * 65 + nc + 3] = v[3];
  }
  __syncthreads();
  {
    int n = t4 >> 2, kseg = (t4 & 3) * 16;
    unsigned w[8];
#pragma unroll
    for (int e = 0; e < 8; ++e) w[e] = cvtpk(tl[(kseg + 2 * e) * 65 + n], tl[(kseg + 2 * e + 1) * 65 + n]);
    u32x4 a = {w[0], w[1], w[2], w[3]}, b = {w[4], w[5], w[6], w[7]};
    bfu* d = dst + (size_t)swap45(n0 + n) * K + k0 + kseg;
    *(u32x4*)d = a; *(u32x4*)(d + 8) = b;
  }
  __syncthreads();
}

DI void phase_prep(const Params& p, char* lds) {
  constexpr int N_MOD = 384, N_TR_L = 9440, N_TRP = N_TR_L, N_CV = 1536;
  for (int item = blockIdx.x; item < N_MOD + N_TRP + N_CV; item += gridDim.x) {
    if (item < N_MOD) { prep_mod_item(p, item, lds); continue; }
    const int tid = opaque(threadIdx.x);
    int it = item - N_MOD;
    if (it < N_TRP) {
      int tl = it * 2 + (tid >> 8);
      int i = tl / N_TR_L, r = tl % N_TR_L;
      const float* src; bfu* dst; int K, N;
      if (r < 2976) { src = p.in[14] + (size_t)i * 2048 * EVEN_IN; dst = (bfu*)(p.ws + WS_WT_IN_E) + (size_t)i * EVEN_PAD * 2048; K = 2048; N = EVEN_IN; }
      else if ((r -= 2976) < 1024) { src = p.in[15] + (size_t)i * 2048 * 2048; dst = (bfu*)(p.ws + WS_WT_OUT_E) + (size_t)i * 2048 * 2048; K = 2048; N = 2048; }
      else if ((r -= 1024) < 192) { src = p.in[18] + (size_t)i * 512 * 1536; dst = (bfu*)(p.ws + WS_WT_UQ) + (size_t)i * 1536 * 512; K = 512; N = 1536; }
      else if ((r -= 192) < 128) { src = p.in[20] + (size_t)i * 256 * 2048; dst = (bfu*)(p.ws + WS_WT_UKV) + (size_t)i * 2048 * 256; K = 256; N = 2048; }
      else if ((r -= 128) < 4096) { src = p.in[21] + (size_t)i * 2048 * ODD_IN; dst = (bfu*)(p.ws + WS_WT_IN_O) + (size_t)i * ODD_IN * 2048; K = 2048; N = ODD_IN; }
      else { r -= 4096; src = p.in[22] + (size_t)i * 2048 * 2048; dst = (bfu*)(p.ws + WS_WT_OUT_O) + (size_t)i * 2048 * 2048; K = 2048; N = 2048; }
      int nN = N / 64;
      int kt = r / nN, nt = r % nN;
      prep_transpose_tile(src, dst, K, N, kt * 64, nt * 64, lds, tid);
      continue;
    }
    it -= N_TRP;
    {
      size_t ch = (size_t)it * 4096;
      const float* src; bfu* dst;
      if (ch < 1048576) { src = p.in[2]; dst = (bfu*)(p.ws + WS_C_NAK); }
      else if ((ch -= 1048576) < 1048576) { src = p.in[3]; dst = (bfu*)(p.ws + WS_C_NAV); }
      else if ((ch -= 1048576) < 2097152) { src = p.in[6]; dst = (bfu*)(p.ws + WS_C_DK); }
      else { ch -= 2097152; src = p.in[7]; dst = (bfu*)(p.ws + WS_C_DV); }
#pragma unroll
      for (int u = 0; u < 8; ++u) {
        size_t c = ch + u * 512 + tid;
        f32x4 a = *(const f32x4*)(src + c * 8), b = *(const f32x4*)(src + c * 8 + 4);
        u32x4 w = {cvtpk(a[0], a[1]), cvtpk(a[2], a[3]), cvtpk(b[0], b[1]), cvtpk(b[2], b[3])};
        *(u32x4*)(dst + c * 8) = w;
      }
    }
  }
}

DI void phase_rows(const Params& p, int kind, int l, char* lds) {
  float* vA = (float*)lds; float* vSH = vA + 2048; float* vG = vSH + 2048;
  const int tid = opaque(threadIdx.x), lane = tid & 63, wid = tid >> 6;
  const int rows_per = ((T / 8 + gridDim.x - 1) / gridDim.x) * 8;
  const int t_begin = blockIdx.x * rows_per;
  const int t_end = min(T, t_begin + rows_per);
  const int ln = kind == 0 ? 0 : l + 1;
  const bool do_h = ln < 4;
  int cur_r = -1;
  bfu* hbuf = (bfu*)(p.ws + WS_HBUF);
  const bfu* ybuf = (const bfu*)(p.ws + WS_YBUF);
  for (int base = t_begin; base < t_end; base += 8) {
    const int r = base < TP ? 8 : (base - TP) >> 11;
    if (r != cur_r) {
      cur_r = r;
      __syncthreads();
#pragma unroll
      for (int e = 0; e < 4; ++e) {
        const int col = tid * 4 + e;
        if (do_h) {
          vSH[col] = modval(p, ln, r, col);
          vA[col] = (1.f + modval(p, ln, r, 2048 + col)) * p.in[12][ln * 2048 + col];
        }
        if (kind == 1) vG[col] = modval(p, l, r, 4096 + col) * p.in[13][l * 2048 + col];
      }
      __syncthreads();
    }
    const int t = base + wid;
    if (t < t_end) {
      const float* xin = (kind == 0 || l == 0) ? (t < TP ? p.in[0] + (size_t)t * D : p.in[1] + (size_t)(t - TP) * D) : p.out + (size_t)t * D;
      f32x4 x[8];
#pragma unroll
      for (int i = 0; i < 8; ++i) x[i] = *(const f32x4*)(xin + i * 256 + lane * 4);
      if (kind == 1) {
        f32x4 y[8];
#pragma unroll
        for (int i = 0; i < 8; ++i) {
          u32x2 w = *(const u32x2*)(ybuf + (size_t)t * D + i * 256 + lane * 4);
          y[i][0] = bflo(w[0]); y[i][1] = bfhi(w[0]); y[i][2] = bflo(w[1]); y[i][3] = bfhi(w[1]);
        }
        float ss = 0.f;
#pragma unroll
        for (int i = 0; i < 8; ++i) ss += y[i][0] * y[i][0] + y[i][1] * y[i][1] + y[i][2] * y[i][2] + y[i][3] * y[i][3];
        ss = wave_sum(ss);
        const float rstd = rsqrtf(ss * (1.f / 2048.f) + EPS);
#pragma unroll
        for (int i = 0; i < 8; ++i) {
          f32x4 g = *(const f32x4*)(vG + i * 256 + lane * 4);
          x[i][0] += g[0] * (y[i][0] * rstd); x[i][1] += g[1] * (y[i][1] * rstd);
          x[i][2] += g[2] * (y[i][2] * rstd); x[i][3] += g[3] * (y[i][3] * rstd);
          *(f32x4*)(p.out + (size_t)t * D + i * 256 + lane * 4) = x[i];
        }
      }
      if (do_h) {
        float ss = 0.f;
#pragma unroll
        for (int i = 0; i < 8; ++i) ss += x[i][0] * x[i][0] + x[i][1] * x[i][1] + x[i][2] * x[i][2] + x[i][3] * x[i][3];
        ss = wave_sum(ss);
        const float rstd = rsqrtf(ss * (1.f / 2048.f) + EPS);
#pragma unroll
        for (int i = 0; i < 8; ++i) {
          f32x4 a = *(const f32x4*)(vA + i * 256 + lane * 4), s = *(const f32x4*)(vSH + i * 256 + lane * 4);
          u32x2 w = {cvtpk(x[i][0] * rstd * a[0] + s[0], x[i][1] * rstd * a[1] + s[1]), cvtpk(x[i][2] * rstd * a[2] + s[2], x[i][3] * rstd * a[3] + s[3])};
          *(u32x2*)(hbuf + (size_t)t * D + i * 256 + lane * 4) = w;
        }
      }
    }
  }
}

constexpr int GBM = 256, GBK = 64, GHALF = 128, GHT = GHALF * GBK;
enum { EPI_E1 = 0, EPI_O1 = 1, EPI_QM = 2, EPI_KV = 3, EPI_Y = 4 };

DI int lds_byte(int r, int c) {
  int st = (r >> 4) * 2 + (c >> 5), rr = r & 15, cc = c & 31, ob = rr * 64 + cc * 2;
  return st * 1024 + (ob ^ (((ob >> 9) & 1) << 5));
}
DI void stage_rc(int b, int& R, int& C) {
  int st = b / 1024, sb = b % 1024, swz = sb ^ (((sb >> 9) & 1) << 5);
  R = (st >> 1) * 16 + swz / 64; C = (st & 1) * 32 + (swz % 64) / 2;
}

template <int EPI>
DI void gemm256(const Params& p, const bfu* __restrict__ A, const bfu* __restrict__ Bt, const int K, const int brow, const int bcol,
                const int li, char* lds) {
  const int tid = opaque(threadIdx.x);
  bfu* shm = (bfu*)lds;
#define SA(b, h) (shm + ((b) * 2 + (h)) * GHT)
#define SB(b, h) (shm + (4 + (b) * 2 + (h)) * GHT)
#define STAGE(P_, BASE, br, kt) do { long _g = (long)(br) * K + (long)(kt) * GBK;                          \
    for (int _i = 0; _i < 2; ++_i) { int _b = tid * 16 + _i * 8192; int _r, _c; stage_rc(_b, _r, _c);      \
      __builtin_amdgcn_global_load_lds((const unsigned*)(BASE + _g + (long)_r * K + _c),                    \
        (__attribute__((address_space(3))) unsigned*)((char*)(P_) + _b), 16, 0, 0); } } while (0)
#define LDA(dst, b, h) for (int m = 0; m < 4; ++m) for (int k = 0; k < 2; ++k)                              \
    dst[m][k] = *reinterpret_cast<const bf16x8*>((char*)SA(b, h) + lds_byte(wr * 64 + m * 16 + fr, k * 32 + fq * 8))
#define LDB(dst, b, h) for (int n = 0; n < 2; ++n) for (int k = 0; k < 2; ++k)                              \
    dst[n][k] = *reinterpret_cast<const bf16x8*>((char*)SB(b, h) + lds_byte(wc * 32 + n * 16 + fr, k * 32 + fq * 8))
#define MMA(ai, bj, At_, Bt_) do { __builtin_amdgcn_s_setprio(1);                                            \
    for (int m = 0; m < 4; ++m) for (int n = 0; n < 2; ++n) for (int k = 0; k < 2; ++k)                      \
      acc[ai][bj][m][n] = __builtin_amdgcn_mfma_f32_16x16x32_bf16(At_[m][k], Bt_[n][k], acc[ai][bj][m][n], 0, 0, 0); \
    __builtin_amdgcn_s_setprio(0); } while (0)
#define WAIT_V(n) asm volatile("s_waitcnt vmcnt(" #n ")" ::: "memory")
#define WAIT_L(n) asm volatile("s_waitcnt lgkmcnt(" #n ")" ::: "memory")
#define BAR __builtin_amdgcn_s_barrier()
#define SCHED __builtin_amdgcn_sched_barrier(0)
  const int wid = tid >> 6, lane = tid & 63, wr = wid >> 2, wc = wid & 3, fr = lane & 15, fq = lane >> 4;
  f32x4 acc[2][2][4][2];
#pragma unroll
  for (int a_ = 0; a_ < 2; ++a_)
#pragma unroll
    for (int b_ = 0; b_ < 2; ++b_)
#pragma unroll
      for (int m = 0; m < 4; ++m)
#pragma unroll
        for (int n = 0; n < 2; ++n) { acc[a_][b_][m][n][0] = 0.f; acc[a_][b_][m][n][1] = 0.f; acc[a_][b_][m][n][2] = 0.f; acc[a_][b_][m][n][3] = 0.f; }
  bf16x8 At[4][2], B0[2][2], B1[2][2];
  const int nt = K / GBK;
  WAIT_V(0); BAR;
  STAGE(SB(0, 0), Bt, bcol, 0); STAGE(SA(0, 0), A, brow, 0);
  STAGE(SB(0, 1), Bt, bcol + GHALF, 0); STAGE(SA(0, 1), A, brow + GHALF, 0);
  if (wr == 1) BAR;
  WAIT_V(4); BAR;
  STAGE(SB(1, 0), Bt, bcol, 1); STAGE(SA(1, 0), A, brow, 1); STAGE(SB(1, 1), Bt, bcol + GHALF, 1);
  WAIT_V(6); BAR;
  for (int t = 0; t < nt - 2; t += 2) {
    LDB(B0, 0, 0); SCHED; LDA(At, 0, 0); STAGE(SA(1, 1), A, brow + GHALF, t + 1);
    WAIT_L(8); BAR; WAIT_L(0); MMA(0, 0, At, B0); BAR; SCHED;
    LDB(B1, 0, 1); STAGE(SB(0, 0), Bt, bcol, t + 2);
    BAR; WAIT_L(0); MMA(0, 1, At, B1); BAR;
    LDA(At, 0, 1); STAGE(SA(0, 0), A, brow, t + 2);
    BAR; WAIT_L(0); MMA(1, 0, At, B0); BAR; SCHED;
    STAGE(SB(0, 1), Bt, bcol + GHALF, t + 2);
    WAIT_V(6); BAR; MMA(1, 1, At, B1); BAR;
    LDB(B0, 1, 0); SCHED; LDA(At, 1, 0); STAGE(SA(0, 1), A, brow + GHALF, t + 2);
    WAIT_L(8); BAR; WAIT_L(0); MMA(0, 0, At, B0); BAR; SCHED;
    LDB(B1, 1, 1); STAGE(SB(1, 0), Bt, bcol, t + 3);
    BAR; WAIT_L(0); MMA(0, 1, At, B1); BAR;
    LDA(At, 1, 1); STAGE(SA(1, 0), A, brow, t + 3);
    BAR; WAIT_L(0); MMA(1, 0, At, B0); BAR; SCHED;
    STAGE(SB(1, 1), Bt, bcol + GHALF, t + 3);
    WAIT_V(6); BAR; MMA(1, 1, At, B1); BAR;
  }
  { LDB(B0, 0, 0); LDA(At, 0, 0); STAGE(SA(1, 1), A, brow + GHALF, nt - 1);
    BAR; WAIT_L(0); MMA(0, 0, At, B0); BAR;
    LDB(B1, 0, 1); BAR; WAIT_L(0); MMA(0, 1, At, B1); BAR;
    LDA(At, 0, 1); WAIT_V(4); BAR; WAIT_L(0); MMA(1, 0, At, B0); MMA(1, 1, At, B1); BAR; }
  { LDB(B0, 1, 0); LDA(At, 1, 0); WAIT_V(2); BAR; WAIT_L(0); MMA(0, 0, At, B0); BAR;
    LDB(B1, 1, 1); WAIT_V(0); BAR; WAIT_L(0); MMA(0, 1, At, B1); BAR;
    LDA(At, 1, 1); BAR; WAIT_L(0); MMA(1, 0, At, B0); MMA(1, 1, At, B1); BAR; }
  if (wr == 0) BAR;
#undef SA
#undef SB
#undef STAGE
#undef LDA
#undef LDB
#undef MMA
#undef WAIT_V
#undef WAIT_L
#undef BAR
#undef SCHED

  const int jr = (wc & 1) * 16 + fr;
  if constexpr (EPI == EPI_O1) {
    if (brow >= TP && bcol < 4096) {
      const float inv = exp2f(-(float)jr * (LOG2_ROPE / 32.f));
      const bool colrope = (wc >> 1) & 1;
#pragma unroll
      for (int ai = 0; ai < 2; ++ai)
#pragma unroll
        for (int m = 0; m < 4; ++m)
#pragma unroll
          for (int j = 0; j < 4; ++j) {
            int row = brow + ai * 128 + wr * 64 + m * 16 + fq * 4 + j;
            int s = (row - TP) & 2047;
            float ang = (float)(colrope ? (s & 63) : (s >> 6)) * inv;
            float cs = __cosf(ang), sn = __sinf(ang);
#pragma unroll
            for (int bj = 0; bj < 2; ++bj) {
              float x1 = acc[ai][bj][m][0][j], x2 = acc[ai][bj][m][1][j];
              acc[ai][bj][m][0][j] = x1 * cs - x2 * sn;
              acc[ai][bj][m][1][j] = x2 * cs + x1 * sn;
            }
          }
    }
  }
#pragma unroll
  for (int ai = 0; ai < 2; ++ai)
#pragma unroll
    for (int bj = 0; bj < 2; ++bj)
#pragma unroll
      for (int n = 0; n < 2; ++n) {
        const int colg = bcol + bj * 128 + (wc >> 1) * 64 + n * 32 + (wc & 1) * 16;
        const int col = colg + fr;
#pragma unroll
        for (int m = 0; m < 4; ++m)
#pragma unroll
          for (int j = 0; j < 4; ++j) {
            const int row = brow + ai * 128 + wr * 64 + m * 16 + fq * 4 + j;
            const float v = acc[ai][bj][m][n][j];
            if constexpr (EPI == EPI_E1) {
              if (colg < EVEN_IN) {
                ((bfu*)(p.ws + WS_PBUF))[(size_t)row * EVEN_IN + col] = f2bf(v);
                if (brow < TP) {
                  size_t orow = (size_t)((row >> 8) * 2 + li) * 256 + (row & 255);
                  if (colg >= 1024 && colg < 2048) p.out[OUT_NAK + orow * 1024 + (col - 1024)] = v;
                  else if (colg >= 2048 && colg < 3072) p.out[OUT_NAV + orow * 1024 + (col - 2048)] = v;
                  else if (colg >= 4864 && colg < 4928) p.out[OUT_KPE + orow * 64 + (col - 4864)] = v;
                }
              }
            } else if constexpr (EPI == EPI_O1) {
              ((bfu*)(p.ws + WS_PBUF))[(size_t)row * ODD_IN + col] = f2bf(v);
              if (brow < TP) {
                size_t orow = (size_t)((row >> 8) * 2 + li) * 256 + (row & 255);
                if (colg >= 2048 && colg < 4096) p.out[OUT_DK + orow * 2048 + (col - 2048)] = v;
                else if (colg >= 4096 && colg < 6144) p.out[OUT_DV + orow * 2048 + (col - 4096)] = v;
              }
            } else if constexpr (EPI == EPI_QM) {
              ((bfu*)(p.ws + WS_QM))[(size_t)row * 1536 + col] = f2bf(v);
            } else if constexpr (EPI == EPI_KV) {
              int hd = col >> 8, jj = col & 255;
              if (jj < 128) ((bfu*)(p.ws + WS_KMLA))[(size_t)row * 1536 + hd * 192 + jj] = f2bf(v);
              else ((bfu*)(p.ws + WS_VMLA))[(size_t)row * 1024 + hd * 128 + (jj - 128)] = f2bf(v);
            } else {
              ((bfu*)(p.ws + WS_YBUF))[(size_t)row * D + col] = f2bf(v);
            }
          }
      }
}

DI int tile_id(int it) {
  const int G = gridDim.x;
  const int pb = (G & 7) == 0 ? (blockIdx.x & 7) * (G >> 3) + (blockIdx.x >> 3) : blockIdx.x;
  return it * G + pb;
}
DI void tile_mn(int id, int nN, int& m, int& n) {
  int grp = id / (8 * nN), rem = id % (8 * nN);
  m = grp * 8 + (rem & 7); n = rem >> 3;
}

DI void phase_mid(const Params& p, int li) {
  const int tid = opaque(threadIdx.x), lane = tid & 63, wid = tid >> 6;
  const bfu* P = (const bfu*)(p.ws + WS_PBUF);
  bfu* cqn = (bfu*)(p.ws + WS_CQN);
  bfu* ckvn = (bfu*)(p.ws + WS_CKVN);
  bfu* kmla = (bfu*)(p.ws + WS_KMLA);
  const float* gq = p.in[17] + li * 512;
  const float* gkv = p.in[19] + li * 256;
  for (int t = blockIdx.x * 8 + wid; t < TALL; t += gridDim.x * 8) {
    float kp;
    if (t < T) {
      const bfu* Pr = P + (size_t)t * EVEN_IN;
      {
        u32x4 w = *(const u32x4*)(Pr + 4096 + lane * 8);
        float v[8] = {bflo(w[0]), bfhi(w[0]), bflo(w[1]), bfhi(w[1]), bflo(w[2]), bfhi(w[2]), bflo(w[3]), bfhi(w[3])};
        float ss = 0;
#pragma unroll
        for (int e = 0; e < 8; ++e) ss += v[e] * v[e];
        ss = wave_sum(ss);
        float rstd = rsqrtf(ss * (1.f / 512.f) + EPS);
#pragma unroll
        for (int e = 0; e < 8; ++e) v[e] = v[e] * rstd * gq[lane * 8 + e];
        u32x4 o = {cvtpk(v[0], v[1]), cvtpk(v[2], v[3]), cvtpk(v[4], v[5]), cvtpk(v[6], v[7])};
        *(u32x4*)(cqn + (size_t)t * 512 + lane * 8) = o;
      }
      {
        u32x2 w = *(const u32x2*)(Pr + 4608 + lane * 4);
        float v[4] = {bflo(w[0]), bfhi(w[0]), bflo(w[1]), bfhi(w[1])};
        float ss = v[0] * v[0] + v[1] * v[1] + v[2] * v[2] + v[3] * v[3];
        ss = wave_sum(ss);
        float rstd = rsqrtf(ss * (1.f / 256.f) + EPS);
#pragma unroll
        for (int e = 0; e < 4; ++e) v[e] = v[e] * rstd * gkv[lane * 4 + e];
        u32x2 o = {cvtpk(v[0], v[1]), cvtpk(v[2], v[3])};
        *(u32x2*)(ckvn + (size_t)t * 256 + lane * 4) = o;
        if (t < TP) {
          size_t orow = (size_t)((t >> 8) * 2 + li) * 256 + (t & 255);
          f32x4 f = {v[0], v[1], v[2], v[3]};
          *(f32x4*)(p.out + OUT_CKV + orow * 256 + lane * 4) = f;
        }
      }
      kp = bf2f(Pr[4864 + lane]);
      if (t >= TP) {
        int s = (t - TP) & 2047;
        float pos = (float)(lane < 32 ? (s >> 6) : (s & 63));
        int jj = lane & 15;
        float inv = exp2f(-(float)jj * (LOG2_ROPE / 16.f));
        float ang = pos * inv;
        float cs = __cosf(ang), sn = __sinf(ang);
        float pv = __shfl_xor(kp, 16);
        kp = (lane & 16) ? (kp * cs + pv * sn) : (kp * cs - pv * sn);
      }
    } else {
      int ci = t - T;
      int b = ci >> 9, j = ci & 511;
      size_t crow_ = (size_t)(b * 2 + li) * 512 + j;
      f32x4 f = *(const f32x4*)(p.in[4] + crow_ * 256 + lane * 4);
      u32x2 o = {cvtpk(f[0], f[1]), cvtpk(f[2], f[3])};
      *(u32x2*)(ckvn + (size_t)t * 256 + lane * 4) = o;
      kp = p.in[5][crow_ * 64 + lane];
    }
    bfu kb = f2bf(kp);
#pragma unroll
    for (int hd = 0; hd < 8; ++hd) kmla[(size_t)t * 1536 + hd * 192 + 128 + lane] = kb;
  }
}

struct Seg { const bfu* K; const bfu* V; int ldk, ldv, n; };
constexpr int ATT_KB = 24576, ATT_VB = 16384, ATT_BUF = ATT_KB + ATT_VB;
constexpr int ATT_BIAS_OFF = 3 * ATT_BUF;
constexpr int ATT_TR_ROW = 132;

template <int DQK>
DI void attn_issue(const int tid, const bfu* __restrict__ Kp, const bfu* __restrict__ Vp, int ldk, int ldv, char* buf) {
  constexpr int KROWB = DQK * 2;
#pragma unroll
  for (int i = 0; i < DQK / 64; ++i) {
    int bb = i * 8192 + tid * 16, row = bb / KROWB, cpos = (bb % KROWB) >> 4, c = cpos ^ (row & 7);
    __builtin_amdgcn_global_load_lds((const unsigned*)(Kp + (size_t)row * ldk + c * 8),
                                     (__attribute__((address_space(3))) unsigned*)(buf + bb), 16, 0, 0);
  }
#pragma unroll
  for (int i = 0; i < 2; ++i) {
    int bb = i * 8192 + tid * 16, row = bb >> 8, cpos = (bb & 255) >> 4, c = cpos ^ ((row & 3) << 2);
    __builtin_amdgcn_global_load_lds((const unsigned*)(Vp + (size_t)row * ldv + c * 8),
                                     (__attribute__((address_space(3))) unsigned*)(buf + ATT_KB + bb), 16, 0, 0);
  }
}

template <int DQK, bool NA, bool ROPEQ>
DI void attn_core(const int tid, f32x16* o, const bfu* __restrict__ Qrow, const Seg& s0, const Seg& s1, float C, char* lds,
                  int gr, int gc, int kr0, float prow, float pcol) {
  constexpr int KROWB = DQK * 2;
  constexpr int ND = DQK / 16;
  const int lane = tid & 63, r32 = lane & 31, hh = lane >> 5;
  const bool lag = __builtin_amdgcn_readfirstlane(tid >> 8) != 0;
  const float* sbias = (const float*)(lds + ATT_BIAS_OFF);
  const int nt0 = s0.n >> 6, ntile = nt0 + (s1.n >> 6);
  auto issue_tile = [&](int jt, int slot) {
    const bool in0 = jt < nt0;
    const bfu* Kp = in0 ? s0.K + (size_t)(jt * 64) * s0.ldk : s1.K + (size_t)((jt - nt0) * 64) * s1.ldk;
    const bfu* Vp = in0 ? s0.V + (size_t)(jt * 64) * s0.ldv : s1.V + (size_t)((jt - nt0) * 64) * s1.ldv;
    attn_issue<DQK>(tid, Kp, Vp, in0 ? s0.ldk : s1.ldk, in0 ? s0.ldv : s1.ldv, lds + slot * ATT_BUF);
  };
  __syncthreads();
  issue_tile(0, 0);
  bf16x8 qr[ND];
#pragma unroll
  for (int d0 = 0; d0 < ND; ++d0) qr[d0] = *(const bf16x8*)(Qrow + d0 * 16);
  if constexpr (ROPEQ) {
#pragma unroll
    for (int pr = 0; pr < 2; ++pr) {
      float pos = pr == 0 ? prow : pcol;
      bf16x8 a = qr[8 + 2 * pr], b = qr[9 + 2 * pr];
      float xa[8], xb[8];
#pragma unroll
      for (int e = 0; e < 8; ++e) {
        float inv = exp2f(-(float)(8 * hh + e) * (LOG2_ROPE / 16.f));
        float ang = pos * inv;
        float cs = __cosf(ang), sn = __sinf(ang);
        float x1 = bf2f((bfu)a[e]), x2 = bf2f((bfu)b[e]);
        xa[e] = x1 * cs - x2 * sn; xb[e] = x2 * cs + x1 * sn;
      }
      u32x4 wa = {cvtpk(xa[0], xa[1]), cvtpk(xa[2], xa[3]), cvtpk(xa[4], xa[5]), cvtpk(xa[6], xa[7])};
      u32x4 wb = {cvtpk(xb[0], xb[1]), cvtpk(xb[2], xb[3]), cvtpk(xb[4], xb[5]), cvtpk(xb[6], xb[7])};
      qr[8 + 2 * pr] = __builtin_bit_cast(bf16x8, wa); qr[9 + 2 * pr] = __builtin_bit_cast(bf16x8, wb);
    }
  }
#pragma unroll
  for (int d = 0; d < 4; ++d)
#pragma unroll
    for (int r = 0; r < 16; ++r) o[d][r] = 0.f;
  float m = -1e30f, l = 0.f;
  const int rs = min(max(gr - 4, 0), 24), cs_ = min(max(gc - 8, 0), 48);
  int kad[4];
#pragma unroll
  for (int q = 0; q < 4; ++q) kad[q] = r32 * KROWB + (((q * 2 + hh) ^ (r32 & 7)) << 4);
  const int q_ = (lane & 15) >> 2;
  int vad[4];
#pragma unroll
  for (int d = 0; d < 4; ++d) vad[d] = ATT_KB + (hh * 4 + q_) * 256 + ((d ^ q_) << 6) + (16 * ((lane >> 4) & 1) + 4 * (lane & 3)) * 2;

  auto qk_sm = [&](bf16x8* pa, const char* buf, const int j) {
    f32x16 p0, p1;
#pragma unroll
    for (int r = 0; r < 16; ++r) { p0[r] = 0.f; p1[r] = 0.f; }
#pragma unroll
    for (int hb = 0; hb < ND; hb += 4) {
      bf16x8 k0[4], k1[4];
#pragma unroll
      for (int d = 0; d < 4; ++d) {
        k0[d] = *(const bf16x8*)(buf + kad[d] + (hb >> 2) * 128);
        k1[d] = *(const bf16x8*)(buf + kad[d] + (hb >> 2) * 128 + 32 * KROWB);
      }
      __builtin_amdgcn_sched_barrier(0);
#pragma unroll
      for (int d = 0; d < 4; ++d) {
        p0 = mfma(k0[d], qr[hb + d], p0);
        p1 = mfma(k1[d], qr[hb + d], p1);
      }
      __builtin_amdgcn_sched_barrier(0);
    }
    float mx;
    if (NA && j >= nt0) {
      const int kr = kr0 + (j - nt0);
      const bool rowok = (kr >= rs) && (kr < rs + 8);
      const int brow = (kr - gr + 7) * 31 - gc + 15;
#pragma unroll
      for (int r = 0; r < 16; ++r) {
        int kc0 = crow(r, hh), kc1 = 32 + kc0;
        bool ok0 = rowok && (kc0 >= cs_) && (kc0 < cs_ + 16);
        bool ok1 = rowok && (kc1 >= cs_) && (kc1 < cs_ + 16);
        float b0 = sbias[ok0 ? brow + kc0 : 0], b1 = sbias[ok1 ? brow + kc1 : 0];
        p0[r] = ok0 ? p0[r] * C + b0 : -1e30f;
        p1[r] = ok1 ? p1[r] * C + b1 : -1e30f;
      }
      mx = p0[0];
#pragma unroll
      for (int r = 1; r < 16; ++r) mx = fmaxf(mx, p0[r]);
#pragma unroll
      for (int r = 0; r < 16; ++r) mx = fmaxf(mx, p1[r]);
      mx = fmaxf(mx, xor32(mx));
    } else {
      mx = p0[0];
#pragma unroll
      for (int r = 1; r < 16; ++r) mx = fmaxf(mx, p0[r]);
#pragma unroll
      for (int r = 0; r < 16; ++r) mx = fmaxf(mx, p1[r]);
      mx = fmaxf(mx, xor32(mx)) * C;
    }
    const float mn = fmaxf(m, mx);
    const float alpha = __builtin_amdgcn_exp2f(m - mn);
    m = mn;
    f2_t ps2 = {0.f, 0.f};
    if (NA && j >= nt0) {
#pragma unroll
      for (int r = 0; r < 16; r += 2) {
        p0[r] = __builtin_amdgcn_exp2f(p0[r] - mn); p0[r + 1] = __builtin_amdgcn_exp2f(p0[r + 1] - mn);
        p1[r] = __builtin_amdgcn_exp2f(p1[r] - mn); p1[r + 1] = __builtin_amdgcn_exp2f(p1[r + 1] - mn);
        f2_t a = {p0[r], p0[r + 1]}, b = {p1[r], p1[r + 1]};
        ps2 += a; ps2 += b;
      }
    } else {
      const f2_t c2 = {C, C}, nm2 = {-mn, -mn};
#pragma unroll
      for (int r = 0; r < 16; r += 2) {
        f2_t a = {p0[r], p0[r + 1]}, b = {p1[r], p1[r + 1]};
        a = a * c2 + nm2; b = b * c2 + nm2;
        p0[r] = __builtin_amdgcn_exp2f(a[0]); p0[r + 1] = __builtin_amdgcn_exp2f(a[1]);
        p1[r] = __builtin_amdgcn_exp2f(b[0]); p1[r + 1] = __builtin_amdgcn_exp2f(b[1]);
        f2_t ea = {p0[r], p0[r + 1]}, eb = {p1[r], p1[r + 1]};
        ps2 += ea; ps2 += eb;
      }
    }
    float ps = ps2[0] + ps2[1];
    ps += xor32(ps);
    l = l * alpha + ps;
    if (__any(alpha != 1.f)) {
#pragma unroll
      for (int d = 0; d < 4; ++d)
#pragma unroll
        for (int r = 0; r < 16; ++r) o[d][r] *= alpha;
    }
    u32x4 w0 = {cvtpk(p0[0], p0[1]), cvtpk(p0[2], p0[3]), cvtpk(p0[4], p0[5]), cvtpk(p0[6], p0[7])};
    u32x4 w1 = {cvtpk(p0[8], p0[9]), cvtpk(p0[10], p0[11]), cvtpk(p0[12], p0[13]), cvtpk(p0[14], p0[15])};
    u32x4 w2 = {cvtpk(p1[0], p1[1]), cvtpk(p1[2], p1[3]), cvtpk(p1[4], p1[5]), cvtpk(p1[6], p1[7])};
    u32x4 w3 = {cvtpk(p1[8], p1[9]), cvtpk(p1[10], p1[11]), cvtpk(p1[12], p1[13]), cvtpk(p1[14], p1[15])};
    pa[0] = __builtin_bit_cast(bf16x8, w0); pa[1] = __builtin_bit_cast(bf16x8, w1);
    pa[2] = __builtin_bit_cast(bf16x8, w2); pa[3] = __builtin_bit_cast(bf16x8, w3);
  };
  auto pv = [&](const bf16x8* pa, const char* buf) {
#pragma unroll
    for (int d = 0; d < 4; ++d) {
      s16x4 lo[4], hi[4];
#pragma unroll
      for (int s = 0; s < 4; ++s) {
        lo[s] = __builtin_amdgcn_ds_read_tr16_b64_v4i16((s16x4 __attribute__((address_space(3)))*)(buf + vad[d] + (16 * s) * 256));
        hi[s] = __builtin_amdgcn_ds_read_tr16_b64_v4i16((s16x4 __attribute__((address_space(3)))*)(buf + vad[d] + (16 * s + 8) * 256));
      }
#pragma unroll
      for (int s = 0; s < 4; ++s) {
        bf16x8 vb = {lo[s][0], lo[s][1], lo[s][2], lo[s][3], hi[s][0], hi[s][1], hi[s][2], hi[s][3]};
        o[d] = mfma(vb, pa[s], o[d]);
      }
    }
  };

  if (!lag) {
    int sl = 0;
    for (int j = 0; j <= ntile; ++j) {
      asm volatile("s_waitcnt vmcnt(0)" ::: "memory");
      __builtin_amdgcn_s_barrier();
      const int sn = sl == 2 ? 0 : sl + 1;
      if (j + 1 < ntile) issue_tile(j + 1, sn);
      if (j < ntile) { bf16x8 pa[4]; qk_sm(pa, lds + sl * ATT_BUF, j); pv(pa, lds + sl * ATT_BUF); }
      sl = sn;
    }
  } else {
    bf16x8 pa[4];
    int sl = 0;
    for (int j = 0; j <= ntile; ++j) {
      asm volatile("s_waitcnt vmcnt(0)" ::: "memory");
      __builtin_amdgcn_s_barrier();
      const int sn = sl == 2 ? 0 : sl + 1, sp = sl == 0 ? 2 : sl - 1;
      if (j + 1 < ntile) issue_tile(j + 1, sn);
      if (j > 0) pv(pa, lds + sp * ATT_BUF);
      if (j < ntile) qk_sm(pa, lds + sl * ATT_BUF, j);
      sl = sn;
    }
  }
  const float linv = 1.f / l;
#pragma unroll
  for (int d = 0; d < 4; ++d)
#pragma unroll
    for (int r = 0; r < 16; ++r) o[d][r] *= linv;
}

DI float* tr_stage(const int tid, const f32x16* o, char* lds) {
  const int lane = tid & 63, wid = tid >> 6, r32 = lane & 31, hh = lane >> 5;
  float* tr = (float*)lds + wid * (32 * ATT_TR_ROW);
  __syncthreads();
#pragma unroll
  for (int d = 0; d < 4; ++d)
#pragma unroll
    for (int g = 0; g < 4; ++g) {
      f32x4 v = {o[d][4 * g], o[d][4 * g + 1], o[d][4 * g + 2], o[d][4 * g + 3]};
      *(f32x4*)(tr + r32 * ATT_TR_ROW + d * 32 + 8 * g + 4 * hh) = v;
    }
  return tr;
}

DI void store_gated(const int tid, const Params& p, const f32x16* o, int t0, int gcol, int ocol, char* lds) {
  const int lane = tid & 63, wid = tid >> 6;
  const bfu* P = (const bfu*)(p.ws + WS_PBUF);
  bfu* O = (bfu*)(p.ws + WS_HBUF);
  const float* tr = tr_stage(tid, o, lds);
#pragma unroll 1
  for (int r0 = 0; r0 < 32; r0 += 8) {
    unsigned g[8];
#pragma unroll
    for (int u = 0; u < 8; ++u) g[u] = *(const unsigned*)(P + (size_t)(t0 + wid * 32 + r0 + u) * EVEN_IN + gcol + lane * 2);
#pragma unroll
    for (int u = 0; u < 8; ++u) {
      f2_t v = *(const f2_t*)(tr + (r0 + u) * ATT_TR_ROW + lane * 2);
      *(unsigned*)(O + (size_t)(t0 + wid * 32 + r0 + u) * D + ocol + lane * 2) = cvtpk(v[0] * silu(bflo(g[u])), v[1] * silu(bfhi(g[u])));
    }
  }
}

DI int xcd_item(int item) {
  if (gridDim.x != 256) return item;
  const int blk = item & 255, sweep = item >> 8;
  const int xcd = blk & 7, slot = blk >> 3, gl = slot >> 3, qb = slot & 7;
  return sweep * 256 + ((gl * 8 + xcd) << 3) + qb;
}

DI void phase_attn_even(const Params& p, int li, char* lds) {
  const bfu* P = (const bfu*)(p.ws + WS_PBUF);
  const bfu* Qm = (const bfu*)(p.ws + WS_QM);
  const bfu* Km = (const bfu*)(p.ws + WS_KMLA);
  const bfu* Vm = (const bfu*)(p.ws + WS_VMLA);
  const bfu* cnk = (const bfu*)(p.ws + WS_C_NAK);
  const bfu* cnv = (const bfu*)(p.ws + WS_C_NAV);
  const float CM = 0.07216878364870322f * LOG2E;
  const float CN = 0.08838834764831845f * LOG2E;
  int item = blockIdx.x;
  for (; item < 512; item += gridDim.x) {
    const int tid = opaque(threadIdx.x), lane = tid & 63, wid = tid >> 6, r32 = lane & 31, hh = lane >> 5;
    f32x16 o[4];
    const int xi = xcd_item(item);
    int b = xi >> 6, hd = (xi >> 3) & 7, qb = xi & 7;
    int t0 = TP + b * 2048 + qb * 256;
    int trow = t0 + wid * 32 + r32;
    int s = qb * 256 + wid * 32 + r32;
    Seg s0 = {Km + (size_t)(T + b * 512) * 1536 + hd * 192, Vm + (size_t)(T + b * 512) * 1024 + hd * 128, 1536, 1024, 512};
    Seg s1 = {Km + (size_t)(TP + b * 2048) * 1536 + hd * 192, Vm + (size_t)(TP + b * 2048) * 1024 + hd * 128, 1536, 1024, 2048};
    attn_core<192, false, true>(tid, o, Qm + (size_t)trow * 1536 + hd * 192 + hh * 8, s0, s1, CM, lds, 0, 0, 0, (float)(s >> 6), (float)(s & 63));
    store_gated(tid, p, o, t0, 4928 + hd * 128, 1024 + hd * 128, lds);
  }
  for (; item < 1024; item += gridDim.x) {
    const int tid = opaque(threadIdx.x), lane = tid & 63, wid = tid >> 6, r32 = lane & 31, hh = lane >> 5;
    const int it = xcd_item(item - 512);
    f32x16 o[4];
    int b = it >> 6, hd = (it >> 3) & 7, qb = it & 7;
    int t0 = TP + b * 2048 + qb * 256;
    int trow = t0 + wid * 32 + r32;
    int qi = wid * 32 + r32;
    int gr = qb * 4 + (qi >> 6), gc = qi & 63;
    int kr0 = min(max(qb * 4 - 4, 0), 24);
    int kr1 = min(max(qb * 4 + 3 - 4, 0), 24) + 8;
    __syncthreads();
    float* sb = (float*)(lds + ATT_BIAS_OFF);
    for (int idx = tid; idx < 465; idx += 512) sb[idx] = p.in[16][(size_t)(li * 8 + hd) * 465 + idx] * LOG2E;
    Seg s0 = {cnk + (size_t)((b * 2 + li) * 512) * 1024 + hd * 128, cnv + (size_t)((b * 2 + li) * 512) * 1024 + hd * 128, 1024, 1024, 512};
    const bfu* Pl = P + (size_t)(TP + b * 2048 + kr0 * 64) * EVEN_IN;
    Seg s1 = {Pl + 1024 + hd * 128, Pl + 2048 + hd * 128, EVEN_IN, EVEN_IN, (kr1 - kr0) * 64};
    attn_core<128, true, false>(tid, o, P + (size_t)trow * EVEN_IN + hd * 128 + hh * 8, s0, s1, CN, lds, gr, gc, kr0, 0.f, 0.f);
    store_gated(tid, p, o, t0, 3072 + hd * 128, hd * 128, lds);
  }
  for (; item < 1280; item += gridDim.x) {
    const int tid = opaque(threadIdx.x), lane = tid & 63, wid = tid >> 6, r32 = lane & 31, hh = lane >> 5;
    const int it = item - 1024;
    f32x16 o[4];
    int b = it >> 3, hd = it & 7;
    int t0 = b * 256;
    int trow = t0 + wid * 32 + r32;
    Seg s0 = {Km + (size_t)(b * 256) * 1536 + hd * 192, Vm + (size_t)(b * 256) * 1024 + hd * 128, 1536, 1024, 256};
    Seg s1 = {s0.K, s0.V, 1536, 1024, 0};
    attn_core<192, false, false>(tid, o, Qm + (size_t)trow * 1536 + hd * 192 + hh * 8, s0, s1, CM, lds, 0, 0, 0, 0.f, 0.f);
    store_gated(tid, p, o, t0, 4928 + hd * 128, 1024 + hd * 128, lds);
  }
  for (; item < 1536; item += gridDim.x) {
    const int tid = opaque(threadIdx.x), lane = tid & 63, wid = tid >> 6, r32 = lane & 31, hh = lane >> 5;
    const int it = item - 1280;
    f32x16 o[4];
    int b = it >> 3, hd = it & 7;
    int t0 = b * 256;
    int trow = t0 + wid * 32 + r32;
    const bfu* Pb = P + (size_t)(b * 256) * EVEN_IN;
    Seg s0 = {Pb + 1024 + hd * 128, Pb + 2048 + hd * 128, EVEN_IN, EVEN_IN, 256};
    Seg s1 = {s0.K, s0.V, EVEN_IN, EVEN_IN, 0};
    attn_core<128, false, false>(tid, o, P + (size_t)trow * EVEN_IN + hd * 128 + hh * 8, s0, s1, CN, lds, 0, 0, 0, 0.f, 0.f);
    store_gated(tid, p, o, t0, 3072 + hd * 128, hd * 128, lds);
  }
}

DI void phase_attn_odd(const Params& p, int l, char* lds) {
  const int li = l >> 1;
  const bfu* P = (const bfu*)(p.ws + WS_PBUF);
  bfu* O = (bfu*)(p.ws + WS_HBUF);
  const bfu* cdk = (const bfu*)(p.ws + WS_C_DK);
  const bfu* cdv = (const bfu*)(p.ws + WS_C_DV);
  float* scr = (float*)(p.ws + WS_SCR) + (size_t)blockIdx.x * 65536;
  const float CD = 0.08838834764831845f * LOG2E;
  const float lam_init = 0.8f - 0.6f * expf(-0.3f * (float)l);
  float lam;
  {
    const float* lp = p.in[23] + li * 512;
    float s1 = 0.f, s2 = 0.f;
    for (int k = 0; k < 128; ++k) { s1 += lp[k] * lp[128 + k]; s2 += lp[256 + k] * lp[384 + k]; }
    lam = expf(s1) - expf(s2) + lam_init;
  }
  const float* gsub = p.in[24] + li * 256;
  for (int item = blockIdx.x; item < 768; item += gridDim.x) {
    const int tid = opaque(threadIdx.x), lane = tid & 63, wid = tid >> 6, r32 = lane & 31, hh = lane >> 5;
    int b, hd, t0; Seg s0, s1;
    if (item < 512) {
      const int xi = xcd_item(item);
      b = xi >> 6; hd = (xi >> 3) & 7; int qb = xi & 7;
      t0 = TP + b * 2048 + qb * 256;
      const bfu* Pl = P + (size_t)(TP + b * 2048) * ODD_IN;
      s0 = Seg{cdk + (size_t)((b * 2 + li) * 512) * 2048 + hd * 256, cdv + (size_t)((b * 2 + li) * 512) * 2048 + hd * 256, 2048, 2048, 512};
      s1 = Seg{Pl + 2048 + hd * 256, Pl + 4096 + hd * 256, ODD_IN, ODD_IN, 2048};
    } else {
      int it = item - 512;
      b = it >> 3; hd = it & 7;
      t0 = b * 256;
      const bfu* Pb = P + (size_t)(b * 256) * ODD_IN;
      s0 = Seg{Pb + 2048 + hd * 256, Pb + 4096 + hd * 256, ODD_IN, ODD_IN, 256};
      s1 = Seg{s0.K, s0.V, ODD_IN, ODD_IN, 0};
    }
    const int trow = t0 + wid * 32 + r32;
    float ssq = 0.f;
    for (int pass = 0; pass < 4; ++pass) {
      const int vh = pass >> 1, c = pass & 1;
      f32x16 o[4];
      Seg a0 = s0, a1 = s1;
      a0.K += c * 128; a1.K += c * 128; a0.V += vh * 128; a1.V += vh * 128;
      for (int rep = 0; rep < p.nrep; ++rep)
        attn_core<128, false, false>(tid, o, P + (size_t)trow * ODD_IN + hd * 256 + c * 128 + hh * 8, a0, a1, CD, lds, 0, 0, 0, 0.f, 0.f);
      float* sc = scr + vh * 32768 + tid;
      if (c == 1) {
        float ss = 0.f;
#pragma unroll
        for (int d = 0; d < 4; ++d)
#pragma unroll
          for (int r = 0; r < 16; ++r) {
            float dd = sc[(d * 16 + r) * 512] - lam * o[d][r];
            o[d][r] = dd; ss += dd * dd;
          }
        ssq += ss;
      }
#pragma unroll
      for (int d = 0; d < 4; ++d)
#pragma unroll
        for (int r = 0; r < 16; ++r) sc[(d * 16 + r) * 512] = o[d][r];
    }
    ssq += __shfl_xor(ssq, 32);
    const float rstd = rsqrtf(ssq * (1.f / 256.f) + EPS) * (1.f - lam_init);
    for (int half = 0; half < 2; ++half) {
      f32x16 o[4];
      const float* sc = scr + half * 32768 + tid;
#pragma unroll
      for (int d = 0; d < 4; ++d)
#pragma unroll
        for (int r = 0; r < 16; ++r) o[d][r] = sc[(d * 16 + r) * 512] * rstd;
      const float* tr = tr_stage(tid, o, lds);
      const int colb = hd * 256 + half * 128 + lane * 2;
      const float g0 = gsub[half * 128 + lane * 2], g1 = gsub[half * 128 + lane * 2 + 1];
#pragma unroll 1
      for (int r0 = 0; r0 < 32; r0 += 8) {
        unsigned g[8];
#pragma unroll
        for (int u = 0; u < 8; ++u) g[u] = *(const unsigned*)(P + (size_t)(t0 + wid * 32 + r0 + u) * ODD_IN + 6144 + colb);
#pragma unroll
        for (int u = 0; u < 8; ++u) {
          f2_t v = *(const f2_t*)(tr + (r0 + u) * ATT_TR_ROW + lane * 2);
          *(unsigned*)(O + (size_t)(t0 + wid * 32 + r0 + u) * D + colb) = cvtpk(v[0] * g0 * silu(bflo(g[u])), v[1] * g1 * silu(bfhi(g[u])));
        }
      }
    }
  }
}

#ifndef PM
#define PM 0xffff
#endif
template <int EPI>
DI void gemm_phase(const Params& p, const bfu* A, const bfu* Bt, int K, int nM, int nN, int li, char* lds) {
  const int ntiles = nM * nN;
  for (int it = 0; it * (int)gridDim.x < ntiles; ++it) {
    int id = tile_id(it);
    if (id >= ntiles) continue;
    int m, n; tile_mn(id, nN, m, n);
    gemm256<EPI>(p, A, Bt, K, m * 256, n * 256, li, lds);
  }
}

DI void run_phase(const Params& p, int ph, char* lds) {
  if (ph == 0) { if (PM & 1) phase_prep(p, lds); return; }
  if (ph == 1) { if (PM & 2) phase_rows(p, 0, 0, lds); return; }
  const int q = ph - 2, pair = q / 10, r = q % 10;
  const bfu* hbuf = (const bfu*)(p.ws + WS_HBUF);
  if (r < 6) {
    const int l = 2 * pair, li = pair;
    if (r == 0 && (PM & 4)) {
      gemm_phase<EPI_E1>(p, hbuf, (const bfu*)(p.ws + WS_WT_IN_E) + (size_t)li * EVEN_PAD * D, D, 96, 24, li, lds);
    } else if (r == 1 && (PM & 8)) {
      phase_mid(p, li);
    } else if (r == 2 && (PM & 16)) {
      gemm_phase<EPI_QM>(p, (const bfu*)(p.ws + WS_CQN), (const bfu*)(p.ws + WS_WT_UQ) + (size_t)li * 1536 * 512, 512, 96, 6, li, lds);
      gemm_phase<EPI_KV>(p, (const bfu*)(p.ws + WS_CKVN), (const bfu*)(p.ws + WS_WT_UKV) + (size_t)li * 2048 * 256, 256, 112, 8, li, lds);
    } else if (r == 3 && (PM & 32)) {
      phase_attn_even(p, li, lds);
    } else if (r == 4 && (PM & 64)) {
      gemm_phase<EPI_Y>(p, hbuf, (const bfu*)(p.ws + WS_WT_OUT_E) + (size_t)li * D * D, D, 96, 8, li, lds);
    } else if (r == 5 && (PM & 128)) {
      phase_rows(p, 1, l, lds);
    }
  } else {
    const int l = 2 * pair + 1, li = pair, k = r - 6;
    if (k == 0 && (PM & 256)) {
      gemm_phase<EPI_O1>(p, hbuf, (const bfu*)(p.ws + WS_WT_IN_O) + (size_t)li * ODD_IN * D, D, 96, 32, li, lds);
    } else if (k == 1 && (PM & 512)) {
      phase_attn_odd(p, l, lds);
    } else if (k == 2 && (PM & 1024)) {
      gemm_phase<EPI_Y>(p, hbuf, (const bfu*)(p.ws + WS_WT_OUT_O) + (size_t)li * D * D, D, 96, 8, li, lds);
    } else if (k == 3 && (PM & 2048)) {
      phase_rows(p, 1, l, lds);
    }
  }
}


#define XB_TMO      128
#define XB_XCNT(j)  (256  + 64 * (j))
#define XB_XSUB(j)  (1280 + 64 * (j))
#define XB_XGEN(j)  (2304 + 64 * (j))
#define XB_TOP      3328
#define XB_TOPGEN   3392
#define XCD_BAR_WORDS 3456
#define XB_SPIN_CAP (1u << 22)
#define LAS __attribute__((address_space(3)))
DI unsigned xb_ld(unsigned* p)              { return __hip_atomic_load(p, __ATOMIC_RELAXED, __HIP_MEMORY_SCOPE_AGENT); }
DI unsigned xb_add(unsigned* p, unsigned v) { return __hip_atomic_fetch_add(p, v, __ATOMIC_RELAXED, __HIP_MEMORY_SCOPE_AGENT); }
DI unsigned xb_xcc_id() { return (unsigned)__builtin_amdgcn_s_getreg((3 << 11) | 20) & 0xFu; }
#define XB_SPIN(cond, bar) do { unsigned _sp = 0; while (cond) { __builtin_amdgcn_s_sleep(1); \
    if ((++_sp & 255u) == 0u) { if (xb_ld(&(bar)[XB_TMO])) break; if (_sp > XB_SPIN_CAP) { atomicAdd(&(bar)[XB_TMO], 1u); break; } } } } while (0)
struct XcdBarrier { unsigned* bar; unsigned x; volatile LAS unsigned* st; };
DI XcdBarrier xcd_barrier_post(unsigned* bar, volatile LAS unsigned* st) {
  XcdBarrier b; b.bar = bar; b.x = xb_xcc_id(); b.st = st;
  if (threadIdx.x == 0) (void)xb_add(&bar[XB_XCNT(b.x)], 1u);
  return b;
}
DI void xcd_barrier_complete(unsigned* bar, unsigned x, unsigned& nloc, unsigned& nx) {
  const unsigned G = gridDim.x * gridDim.y * gridDim.z;
  unsigned sum, cnt, mine, sp = 0u;
  for (;;) {
    sum = 0u; cnt = 0u; mine = 0u;
#pragma unroll
    for (unsigned j = 0; j < 16; ++j) { const unsigned c = xb_ld(&bar[XB_XCNT(j)]); sum += c; cnt += (c > 0u) ? 1u : 0u; mine = (j == x) ? c : mine; }
    if (sum == G) break;
    __builtin_amdgcn_s_sleep(1);
    if ((++sp & 255u) == 0u) { if (xb_ld(&bar[XB_TMO])) break; if (sp > XB_SPIN_CAP) { atomicAdd(&bar[XB_TMO], 1u); break; } }
  }
  nloc = mine > 0u ? mine : 1u; nx = cnt > 0u ? cnt : 1u;
}
DI void xcd_barrier(const XcdBarrier& b) {
  asm volatile("s_waitcnt vmcnt(0)" ::: "memory");
  __syncthreads();
  if (threadIdx.x == 0) {
    unsigned* bar = b.bar;
    __builtin_amdgcn_s_waitcnt(0);
    unsigned nloc = b.st[0], nx = b.st[1];
    if (nloc == 0u) { xcd_barrier_complete(bar, b.x, nloc, nx); b.st[0] = nloc; b.st[1] = nx; }
    const unsigned old = xb_add(&bar[XB_XSUB(b.x)], 1u);
    const unsigned gen = old / nloc;
    if (old + 1u == (gen + 1u) * nloc) {
      __builtin_amdgcn_fence(__ATOMIC_RELEASE, "agent");
      asm volatile("s_waitcnt vmcnt(0)" ::: "memory");
      const unsigned og = xb_add(&bar[XB_TOP], 1u);
      const unsigned tg = og / nx;
      if (og + 1u == (tg + 1u) * nx) xb_add(&bar[XB_TOPGEN], 1u);
      else XB_SPIN(xb_ld(&bar[XB_TOPGEN]) == tg, bar);
      __builtin_amdgcn_fence(__ATOMIC_ACQUIRE, "agent");
      xb_add(&bar[XB_XGEN(b.x)], 1u);
      asm volatile("s_waitcnt vmcnt(0)" ::: "memory");
    } else {
      XB_SPIN(xb_ld(&bar[XB_XGEN(b.x)]) == gen, bar);
      __builtin_amdgcn_fence(__ATOMIC_ACQUIRE, "agent");
      asm volatile("s_waitcnt vmcnt(0)" ::: "memory");
    }
  }
  __syncthreads();
}

constexpr int N_PHASES = 22;
constexpr int LDS_BYTES = 8 * 32 * ATT_TR_ROW * 4;

__global__ void __launch_bounds__(512, 2) fwd_megakernel(Params p) {
  __shared__ __attribute__((aligned(16))) char lds[LDS_BYTES];
  __shared__ uint4 xb_words;
  cg::grid_group grid = cg::this_grid();
  if (threadIdx.x == 0) xb_words = make_uint4(0u, 0u, 0u, 0u);
  __syncthreads();
  XcdBarrier xb = xcd_barrier_post((unsigned*)(p.ws + WS_BAR), (volatile LAS unsigned*)&xb_words);
  for (int ph = p.lo; ph < p.hi; ++ph) {
    run_phase(p, ph, lds);
    if (ph + 1 < p.hi) { if (ph == 0) grid.sync(); else xcd_barrier(xb); }
  }
}

extern "C" void kernel_launch(void* const* d_in, const int* in_sizes, int n_in, void* d_out, int out_size, void* d_ws, size_t ws_size,
                              hipStream_t stream) {
  static int grid_blocks = 0;
  if (!grid_blocks) {
    int dev = 0, cus = 0, per_cu = 0;
    (void)hipGetDevice(&dev);
    (void)hipDeviceGetAttribute(&cus, hipDeviceAttributeMultiprocessorCount, dev);
    (void)hipOccupancyMaxActiveBlocksPerMultiprocessor(&per_cu, fwd_megakernel, 512, 0);
    if (per_cu < 1) per_cu = 1;
    per_cu = 1;
    grid_blocks = cus * per_cu;
    if (grid_blocks > 512) grid_blocks = 512;
  }
  if (n_in != 25 || ws_size < WS_NEED) {
    fprintf(stderr, "kernel_launch: bad n_in %d or ws_size %zu < %zu\n", n_in, ws_size, (size_t)WS_NEED);
    return;
  }
  Params p{};
  for (int i = 0; i < 25; ++i) p.in[i] = (const float*)d_in[i];
  p.out = (float*)d_out;
  p.ws = (char*)d_ws;
#ifndef NREP
#define NREP 1
#endif
  p.nrep = NREP; p.pad = 0;
#ifndef PROBE_PHASE
  p.lo = 0; p.hi = N_PHASES;
  void* args[] = {&p};
  (void)hipMemsetAsync((char*)d_ws + WS_BAR, 0, 16384, stream);
  hipError_t e = hipLaunchCooperativeKernel((void*)fwd_megakernel, dim3(grid_blocks), dim3(512), args, 0, stream);
  if (e != hipSuccess) fprintf(stderr, "cooperative launch failed: %s (grid %d)\n", hipGetErrorString(e), grid_blocks);
#else
  void* args[] = {&p};
  p.lo = 0; p.hi = PROBE_PHASE + 1;
  (void)hipMemsetAsync((char*)d_ws + WS_BAR, 0, 16384, stream);
  (void)hipLaunchCooperativeKernel((void*)fwd_megakernel, dim3(grid_blocks), dim3(512), args, 0, stream);
  p.lo = PROBE_PHASE; p.hi = N_PHASES;
  (void)hipMemsetAsync((char*)d_ws + WS_BAR, 0, 16384, stream);
  (void)hipLaunchCooperativeKernel((void*)fwd_megakernel, dim3(grid_blocks), dim3(512), args, 0, stream);
#endif
}
```

```cpp
#include <hip/hip_runtime.h>
#include <hip/hip_cooperative_groups.h>
#include <cstdio>
#include <cstdint>
namespace cg = cooperative_groups;

#define DI __device__ __forceinline__
typedef unsigned short bfu;
using bf16x8 = __attribute__((ext_vector_type(8))) short;
using s16x4  = __attribute__((ext_vector_type(4))) short;
using f32x16 = __attribute__((ext_vector_type(16))) float;
using f32x4  = __attribute__((ext_vector_type(4))) float;
using u32x4  = __attribute__((ext_vector_type(4))) unsigned;
using u32x2  = __attribute__((ext_vector_type(2))) unsigned;
typedef __bf16 bf2_t __attribute__((ext_vector_type(2)));
typedef float f2_t __attribute__((ext_vector_type(2)));

constexpr int D = 2048, TP = 8192, TS = 16384, T = 24576, TALL = 28672;
constexpr int EVEN_IN = 5952, ODD_IN = 8192;
constexpr float EPS = 1e-6f;
constexpr float LOG2E = 1.4426950408889634f;
constexpr float LOG2_ROPE = 13.287712379549449f;

constexpr size_t OUT_YP = 0, OUT_YS = 16777216, OUT_NAK = 50331648, OUT_NAV = 67108864, OUT_CKV = 83886080,
                 OUT_KPE = 88080384, OUT_DK = 89128960, OUT_DV = 122683392;

constexpr size_t al256(size_t x) { return (x + 255) / 256 * 256; }
constexpr size_t WS_WT_IN_E = 0;
constexpr int EVEN_PAD = 6144;
constexpr size_t WS_WT_IN_O = WS_WT_IN_E + al256((size_t)2 * EVEN_PAD * D * 2);
constexpr size_t WS_WT_OUT_E = WS_WT_IN_O + al256((size_t)2 * ODD_IN * D * 2);
constexpr size_t WS_WT_OUT_O = WS_WT_OUT_E + al256((size_t)2 * D * D * 2);
constexpr size_t WS_WT_UQ = WS_WT_OUT_O + al256((size_t)2 * D * D * 2);
constexpr size_t WS_WT_UKV = WS_WT_UQ + al256((size_t)2 * 1536 * 512 * 2);
constexpr size_t WS_C_NAK = WS_WT_UKV + al256((size_t)2 * 2048 * 256 * 2);
constexpr size_t WS_C_NAV = WS_C_NAK + al256((size_t)8 * 2 * 512 * 1024 * 2);
constexpr size_t WS_C_DK = WS_C_NAV + al256((size_t)8 * 2 * 512 * 1024 * 2);
constexpr size_t WS_C_DV = WS_C_DK + al256((size_t)8 * 2 * 512 * 2048 * 2);
constexpr size_t WS_MODP = WS_C_DV + al256((size_t)8 * 2 * 512 * 2048 * 2);
constexpr size_t WS_BAR = WS_MODP + al256((size_t)4 * 4 * 9 * 6144 * 4);
constexpr size_t WS_HBUF = WS_BAR + 16384;
constexpr size_t WS_CQN = WS_HBUF;
constexpr size_t WS_CKVN = WS_HBUF + al256((size_t)T * 512 * 2);
constexpr size_t WS_PBUF = WS_HBUF + al256((size_t)T * D * 2);
constexpr size_t WS_YBUF = WS_PBUF;
constexpr size_t WS_QM = WS_PBUF + al256((size_t)T * EVEN_IN * 2);
constexpr size_t WS_KMLA = WS_QM + al256((size_t)T * 1536 * 2);
constexpr size_t WS_VMLA = WS_KMLA + al256((size_t)TALL * 1536 * 2);
constexpr size_t WS_END_EVEN = WS_VMLA + al256((size_t)TALL * 1024 * 2);
constexpr size_t WS_SCR = WS_PBUF + al256((size_t)T * ODD_IN * 2);
constexpr size_t WS_END_ODD = WS_SCR + (size_t)1024 * 131072;
constexpr size_t WS_NEED = WS_END_EVEN > WS_END_ODD ? WS_END_EVEN : WS_END_ODD;

struct Params {
  const float* in[25];
  float* out;
  char* ws;
  int lo, hi;
  int nrep, pad;
};

DI unsigned cvtpk(float lo, float hi) {
  f2_t v = {lo, hi};
  bf2_t b = __builtin_convertvector(v, bf2_t);
  return __builtin_bit_cast(unsigned, b);
}
DI bfu f2bf(float x) { return (bfu)(cvtpk(x, 0.f) & 0xffffu); }
DI float bf2f(bfu b) { return __uint_as_float(((unsigned)b) << 16); }
DI float bflo(unsigned u) { return __uint_as_float(u << 16); }
DI float bfhi(unsigned u) { return __uint_as_float(u & 0xffff0000u); }
DI int opaque(int x) { asm volatile("" : "+v"(x)); return x; }
DI int crow(int r, int hi) { return (r & 3) + 8 * (r >> 2) + 4 * hi; }
DI float silu(float x) { return x * __builtin_amdgcn_rcpf(1.f + __expf(-x)); }
DI f32x16 mfma(bf16x8 a, bf16x8 b, f32x16 c) { return __builtin_amdgcn_mfma_f32_32x32x16_bf16(a, b, c, 0, 0, 0); }
DI float xor32(float v) {
  auto rr = __builtin_amdgcn_permlane32_swap(__float_as_uint(v), __float_as_uint(v), false, false);
  return __uint_as_float((threadIdx.x & 32) ? rr[0] : rr[1]);
}
DI float wave_sum(float v) {
#pragma unroll
  for (int o = 32; o >= 1; o >>= 1) v += __shfl_xor(v, o);
  return v;
}
DI float block_sum(float v, float* red, int tid) {
  v = wave_sum(v);
  __syncthreads();
  if ((tid & 63) == 0) red[tid >> 6] = v;
  __syncthreads();
  const int hb = (tid >> 8) * 4;
  return red[hb] + red[hb + 1] + red[hb + 2] + red[hb + 3];
}
DI float modval(const Params& p, int l, int r, int n) {
  const float* mp = (const float*)(p.ws + WS_MODP);
  float s = p.in[11][l * 6144 + n];
#pragma unroll
  for (int ks = 0; ks < 4; ++ks) s += mp[((size_t)(ks * 4 + l) * 9 + r) * 6144 + n];
  return s;
}

DI void prep_mod_item(const Params& p, int item, char* lds) {
  const int tid = opaque(threadIdx.x), lane = tid & 63, wid = tid >> 6;
  const int ks = item & 3, cgp = (item >> 2) % 24, l = item / 96;
  float* scond = (float*)lds;
  float* red = (float*)(lds + 18432);
  for (int idx = tid; idx < 9 * 512; idx += 512) {
    int r = idx >> 9, kk = idx & 511;
    float cv = r < 8 ? p.in[8][r * 2048 + ks * 512 + kk] : p.in[9][ks * 512 + kk];
    scond[idx] = silu(cv);
  }
  __syncthreads();
  const float* W = p.in[10] + ((size_t)l * 2048 + ks * 512 + wid * 64) * 6144 + cgp * 256 + lane * 4;
  float acc[9][4];
#pragma unroll
  for (int r = 0; r < 9; ++r) { acc[r][0] = 0; acc[r][1] = 0; acc[r][2] = 0; acc[r][3] = 0; }
  for (int kk = 0; kk < 64; kk += 4) {
    f32x4 w[4];
#pragma unroll
    for (int u = 0; u < 4; ++u) w[u] = *(const f32x4*)(W + (size_t)(kk + u) * 6144);
#pragma unroll
    for (int u = 0; u < 4; ++u) {
#pragma unroll
      for (int r = 0; r < 9; ++r) {
        float s = scond[r * 512 + wid * 64 + kk + u];
        acc[r][0] += s * w[u][0]; acc[r][1] += s * w[u][1]; acc[r][2] += s * w[u][2]; acc[r][3] += s * w[u][3];
      }
    }
  }
#pragma unroll
  for (int r = 0; r < 9; ++r) {
    f32x4 v = {acc[r][0], acc[r][1], acc[r][2], acc[r][3]};
    *(f32x4*)(red + (wid * 9 + r) * 256 + lane * 4) = v;
  }
  __syncthreads();
  float* mp = (float*)(p.ws + WS_MODP);
  for (int idx = tid; idx < 9 * 256; idx += 512) {
    int r = idx >> 8, cc = idx & 255;
    float s = 0.f;
#pragma unroll
    for (int w = 0; w < 8; ++w) s += red[(w * 9 + r) * 256 + cc];
    mp[((size_t)(ks * 4 + l) * 9 + r) * 6144 + cgp * 256 + cc] = s;
  }
  __syncthreads();
}

DI int swap45(int n) { return (n & ~0x30) | ((n & 0x10) << 1) | ((n & 0x20) >> 1); }

DI void prep_transpose_tile(const float* __restrict__ src, bfu* __restrict__ dst, int K, int N, int k0, int n0, char* lds, int tid) {
  float* tl = (float*)lds + (tid >> 8) * (64 * 65);
  const int t4 = tid & 255;
#pragma unroll
  for (int i = 0; i < 4; ++i) {
    int kr = (t4 >> 4) + 16 * i, nc = (t4 & 15) * 4;
    f32x4 v = *(const f32x4*)(src + (size_t)(k0 + kr) * N + n0 + nc);
    tl[kr * 65 + nc + 0] = v[0]; tl[kr * 65 + nc + 1] = v[1]; tl[kr * 65 + nc + 2] = v[2]; tl[kr * 65 + nc + 3] = v[3];
  }
  __syncthreads();
  {
    int n = t4 >> 2, kseg = (t4 & 3) * 16;
    unsigned w[8];
#pragma unroll
    for (int e = 0; e < 8; ++e) w[e] = cvtpk(tl[(kseg + 2 * e) * 65 + n], tl[(kseg + 2 * e + 1) * 65 + n]);
    u32x4 a = {w[0], w[1], w[2], w[3]}, b = {w[4], w[5], w[6], w[7]};
    bfu* d = dst + (size_t)swap45(n0 + n) * K + k0 + kseg;
    *(u32x4*)d = a; *(u32x4*)(d + 8) = b;
  }
  __syncthreads();
}

DI void phase_prep(const Params& p, char* lds) {
  constexpr int N_MOD = 384, N_TR_L = 9440, N_TRP = N_TR_L, N_CV = 1536;
  for (int item = blockIdx.x; item < N_MOD + N_TRP + N_CV; item += gridDim.x) {
    if (item < N_MOD) { prep_mod_item(p, item, lds); continue; }
    const int tid = opaque(threadIdx.x);
    int it = item - N_MOD;
    if (it < N_TRP) {
      int tl = it * 2 + (tid >> 8);
      int i = tl / N_TR_L, r = tl % N_TR_L;
      const float* src; bfu* dst; int K, N;
      if (r < 2976) { src = p.in[14] + (size_t)i * 2048 * EVEN_IN; dst = (bfu*)(p.ws + WS_WT_IN_E) + (size_t)i * EVEN_PAD * 2048; K = 2048; N = EVEN_IN; }
      else if ((r -= 2976) < 1024) { src = p.in[15] + (size_t)i * 2048 * 2048; dst = (bfu*)(p.ws + WS_WT_OUT_E) + (size_t)i * 2048 * 2048; K = 2048; N = 2048; }
      else if ((r -= 1024) < 192) { src = p.in[18] + (size_t)i * 512 * 1536; dst = (bfu*)(p.ws + WS_WT_UQ) + (size_t)i * 1536 * 512; K = 512; N = 1536; }
      else if ((r -= 192) < 128) { src = p.in[20] + (size_t)i * 256 * 2048; dst = (bfu*)(p.ws + WS_WT_UKV) + (size_t)i * 2048 * 256; K = 256; N = 2048; }
      else if ((r -= 128) < 4096) { src = p.in[21] + (size_t)i * 2048 * ODD_IN; dst = (bfu*)(p.ws + WS_WT_IN_O) + (size_t)i * ODD_IN * 2048; K = 2048; N = ODD_IN; }
      else { r -= 4096; src = p.in[22] + (size_t)i * 2048 * 2048; dst = (bfu*)(p.ws + WS_WT_OUT_O) + (size_t)i * 2048 * 2048; K = 2048; N = 2048; }
      int nN = N / 64;
      int kt = r / nN, nt = r % nN;
      prep_transpose_tile(src, dst, K, N, kt * 64, nt * 64, lds, tid);
      continue;
    }
    it -= N_TRP;
    {
      size_t ch = (size_t)it * 4096;
      const float* src; bfu* dst;
      if (ch < 1048576) { src = p.in[2]; dst = (bfu*)(p.ws + WS_C_NAK); }
      else if ((ch -= 1048576) < 1048576) { src = p.in[3]; dst = (bfu*)(p.ws + WS_C_NAV); }
      else if ((ch -= 1048576) < 2097152) { src = p.in[6]; dst = (bfu*)(p.ws + WS_C_DK); }
      else { ch -= 2097152; src = p.in[7]; dst = (bfu*)(p.ws + WS_C_DV); }
#pragma unroll
      for (int u = 0; u < 8; ++u) {
        size_t c = ch + u * 512 + tid;
        f32x4 a = *(const f32x4*)(src + c * 8), b = *(const f32x4*)(src + c * 8 + 4);
        u32x4 w = {cvtpk(a[0], a[1]), cvtpk(a[2], a[3]), cvtpk(b[0], b[1]), cvtpk(b[2], b[3])};
        *(u32x4*)(dst + c * 8) = w;
      }
    }
  }
}

DI void phase_rows(const Params& p, int kind, int l, char* lds) {
  float* vA = (float*)lds; float* vSH = vA + 2048; float* vG = vSH + 2048;
  const int tid = opaque(threadIdx.x), lane = tid & 63, wid = tid >> 6;
  const int rows_per = ((T / 8 + gridDim.x - 1) / gridDim.x) * 8;
  const int t_begin = blockIdx.x * rows_per;
  const int t_end = min(T, t_begin + rows_per);
  const int ln = kind == 0 ? 0 : l + 1;
  const bool do_h = ln < 4;
  int cur_r = -1;
  bfu* hbuf = (bfu*)(p.ws + WS_HBUF);
  const bfu* ybuf = (const bfu*)(p.ws + WS_YBUF);
  for (int base = t_begin; base < t_end; base += 8) {
    const int r = base < TP ? 8 : (base - TP) >> 11;
    if (r != cur_r) {
      cur_r = r;
      __syncthreads();
#pragma unroll
      for (int e = 0; e < 4; ++e) {
        const int col = tid * 4 + e;
        if (do_h) {
          vSH[col] = modval(p, ln, r, col);
          vA[col] = (1.f + modval(p, ln, r, 2048 + col)) * p.in[12][ln * 2048 + col];
        }
        if (kind == 1) vG[col] = modval(p, l, r, 4096 + col) * p.in[13][l * 2048 + col];
      }
      __syncthreads();
    }
    const int t = base + wid;
    if (t < t_end) {
      const float* xin = (kind == 0 || l == 0) ? (t < TP ? p.in[0] + (size_t)t * D : p.in[1] + (size_t)(t - TP) * D) : p.out + (size_t)t * D;
      f32x4 x[8];
#pragma unroll
      for (int i = 0; i < 8; ++i) x[i] = *(const f32x4*)(xin + i * 256 + lane * 4);
      if (kind == 1) {
        f32x4 y[8];
#pragma unroll
        for (int i = 0; i < 8; ++i) {
          u32x2 w = *(const u32x2*)(ybuf + (size_t)t * D + i * 256 + lane * 4);
          y[i][0] = bflo(w[0]); y[i][1] = bfhi(w[0]); y[i][2] = bflo(w[1]); y[i][3] = bfhi(w[1]);
        }
        float ss = 0.f;
#pragma unroll
        for (int i = 0; i < 8; ++i) ss += y[i][0] * y[i][0] + y[i][1] * y[i][1] + y[i][2] * y[i][2] + y[i][3] * y[i][3];
        ss = wave_sum(ss);
        const float rstd = rsqrtf(ss * (1.f / 2048.f) + EPS);
#pragma unroll
        for (int i = 0; i < 8; ++i) {
          f32x4 g = *(const f32x4*)(vG + i * 256 + lane * 4);
          x[i][0] += g[0] * (y[i][0] * rstd); x[i][1] += g[1] * (y[i][1] * rstd);
          x[i][2] += g[2] * (y[i][2] * rstd); x[i][3] += g[3] * (y[i][3] * rstd);
          *(f32x4*)(p.out + (size_t)t * D + i * 256 + lane * 4) = x[i];
        }
      }
      if (do_h) {
        float ss = 0.f;
#pragma unroll
        for (int i = 0; i < 8; ++i) ss += x[i][0] * x[i][0] + x[i][1] * x[i][1] + x[i][2] * x[i][2] + x[i][3] * x[i][3];
        ss = wave_sum(ss);
        const float rstd = rsqrtf(ss * (1.f / 2048.f) + EPS);
#pragma unroll
        for (int i = 0; i < 8; ++i) {
          f32x4 a = *(const f32x4*)(vA + i * 256 + lane * 4), s = *(const f32x4*)(vSH + i * 256 + lane * 4);
          u32x2 w = {cvtpk(x[i][0] * rstd * a[0] + s[0], x[i][1] * rstd * a[1] + s[1]), cvtpk(x[i][2] * rstd * a[2] + s[2], x[i][3] * rstd * a[3] + s[3])};
          *(u32x2*)(hbuf + (size_t)t * D + i * 256 + lane * 4) = w;
        }
      }
    }
  }
}

constexpr int GBM = 256, GBK = 64, GHALF = 128, GHT = GHALF * GBK;
enum { EPI_E1 = 0, EPI_O1 = 1, EPI_QM = 2, EPI_KV = 3, EPI_Y = 4 };

DI int lds_byte(int r, int c) {
  int st = (r >> 4) * 2 + (c >> 5), rr = r & 15, cc = c & 31, ob = rr * 64 + cc * 2;
  return st * 1024 + (ob ^ (((ob >> 9) & 1) << 5));
}
DI void stage_rc(int b, int& R, int& C) {
  int st = b / 1024, sb = b % 1024, swz = sb ^ (((sb >> 9) & 1) << 5);
  R = (st >> 1) * 16 + swz / 64; C = (st & 1) * 32 + (swz % 64) / 2;
}

template <int EPI>
DI void gemm256(const Params& p, const bfu* __restrict__ A, const bfu* __restrict__ Bt, const int K, const int brow, const int bcol,
                const int li, char* lds) {
  const int tid = opaque(threadIdx.x);
  bfu* shm = (bfu*)lds;
#define SA(b, h) (shm + ((b) * 2 + (h)) * GHT)
#define SB(b, h) (shm + (4 + (b) * 2 + (h)) * GHT)
#define STAGE(P_, BASE, br, kt) do { long _g = (long)(br) * K + (long)(kt) * GBK;                          \
    for (int _i = 0; _i < 2; ++_i) { int _b = tid * 16 + _i * 8192; int _r, _c; stage_rc(_b, _r, _c);      \
      __builtin_amdgcn_global_load_lds((const unsigned*)(BASE + _g + (long)_r * K + _c),                    \
        (__attribute__((address_space(3))) unsigned*)((char*)(P_) + _b), 16, 0, 0); } } while (0)
#define LDA(dst, b, h) for (int m = 0; m < 4; ++m) for (int k = 0; k < 2; ++k)                              \
    dst[m][k] = *reinterpret_cast<const bf16x8*>((char*)SA(b, h) + lds_byte(wr * 64 + m * 16 + fr, k * 32 + fq * 8))
#define LDB(dst, b, h) for (int n = 0; n < 2; ++n) for (int k = 0; k < 2; ++k)                              \
    dst[n][k] = *reinterpret_cast<const bf16x8*>((char*)SB(b, h) + lds_byte(wc * 32 + n * 16 + fr, k * 32 + fq * 8))
#define MMA(ai, bj, At_, Bt_) do { __builtin_amdgcn_s_setprio(1);                                            \
    for (int m = 0; m < 4; ++m) for (int n = 0; n < 2; ++n) for (int k = 0; k < 2; ++k)                      \
      acc[ai][bj][m][n] = __builtin_amdgcn_mfma_f32_16x16x32_bf16(At_[m][k], Bt_[n][k], acc[ai][bj][m][n], 0, 0, 0); \
    __builtin_amdgcn_s_setprio(0); } while (0)
#define WAIT_V(n) asm volatile("s_waitcnt vmcnt(" #n ")" ::: "memory")
#define WAIT_L(n) asm volatile("s_waitcnt lgkmcnt(" #n ")" ::: "memory")
#define BAR __builtin_amdgcn_s_barrier()
#define SCHED __builtin_amdgcn_sched_barrier(0)
  const int wid = tid >> 6, lane = tid & 63, wr = wid >> 2, wc = wid & 3, fr = lane & 15, fq = lane >> 4;
  f32x4 acc[2][2][4][2];
#pragma unroll
  for (int a_ = 0; a_ < 2; ++a_)
#pragma unroll
    for (int b_ = 0; b_ < 2; ++b_)
#pragma unroll
      for (int m = 0; m < 4; ++m)
#pragma unroll
        for (int n = 0; n < 2; ++n) { acc[a_][b_][m][n][0] = 0.f; acc[a_][b_][m][n][1] = 0.f; acc[a_][b_][m][n][2] = 0.f; acc[a_][b_][m][n][3] = 0.f; }
  bf16x8 At[4][2], B0[2][2], B1[2][2];
  const int nt = K / GBK;
  WAIT_V(0); BAR;
  STAGE(SB(0, 0), Bt, bcol, 0); STAGE(SA(0, 0), A, brow, 0);
  STAGE(SB(0, 1), Bt, bcol + GHALF, 0); STAGE(SA(0, 1), A, brow + GHALF, 0);
  if (wr == 1) BAR;
  WAIT_V(4); BAR;
  STAGE(SB(1, 0), Bt, bcol, 1); STAGE(SA(1, 0), A, brow, 1); STAGE(SB(1, 1), Bt, bcol + GHALF, 1);
  WAIT_V(6); BAR;
  for (int t = 0; t < nt - 2; t += 2) {
    LDB(B0, 0, 0); SCHED; LDA(At, 0, 0); STAGE(SA(1, 1), A, brow + GHALF, t + 1);
    WAIT_L(8); BAR; WAIT_L(0); MMA(0, 0, At, B0); BAR; SCHED;
    LDB(B1, 0, 1); STAGE(SB(0, 0), Bt, bcol, t + 2);
    BAR; WAIT_L(0); MMA(0, 1, At, B1); BAR;
    LDA(At, 0, 1); STAGE(SA(0, 0), A, brow, t + 2);
    BAR; WAIT_L(0); MMA(1, 0, At, B0); BAR; SCHED;
    STAGE(SB(0, 1), Bt, bcol + GHALF, t + 2);
    WAIT_V(6); BAR; MMA(1, 1, At, B1); BAR;
    LDB(B0, 1, 0); SCHED; LDA(At, 1, 0); STAGE(SA(0, 1), A, brow + GHALF, t + 2);
    WAIT_L(8); BAR; WAIT_L(0); MMA(0, 0, At, B0); BAR; SCHED;
    LDB(B1, 1, 1); STAGE(SB(1, 0), Bt, bcol, t + 3);
    BAR; WAIT_L(0); MMA(0, 1, At, B1); BAR;
    LDA(At, 1, 1); STAGE(SA(1, 0), A, brow, t + 3);
    BAR; WAIT_L(0); MMA(1, 0, At, B0); BAR; SCHED;
    STAGE(SB(1, 1), Bt, bcol + GHALF, t + 3);
    WAIT_V(6); BAR; MMA(1, 1, At, B1); BAR;
  }
  { LDB(B0, 0, 0); LDA(At, 0, 0); STAGE(SA(1, 1), A, brow + GHALF, nt - 1);
    BAR; WAIT_L(0); MMA(0, 0, At, B0); BAR;
    LDB(B1, 0, 1); BAR; WAIT_L(0); MMA(0, 1, At, B1); BAR;
    LDA(At, 0, 1); WAIT_V(4); BAR; WAIT_L(0); MMA(1, 0, At, B0); MMA(1, 1, At, B1); BAR; }
  { LDB(B0, 1, 0); LDA(At, 1, 0); WAIT_V(2); BAR; WAIT_L(0); MMA(0, 0, At, B0); BAR;
    LDB(B1, 1, 1); WAIT_V(0); BAR; WAIT_L(0); MMA(0, 1, At, B1); BAR;
    LDA(At, 1, 1); BAR; WAIT_L(0); MMA(1, 0, At, B0); MMA(1, 1, At, B1); BAR; }
  if (wr == 0) BAR;
#undef SA
#undef SB
#undef STAGE
#undef LDA
#undef LDB
#undef MMA
#undef WAIT_V
#undef WAIT_L
#undef BAR
#undef SCHED

  const int jr = (wc & 1) * 16 + fr;
  if constexpr (EPI == EPI_O1) {
    if (brow >= TP && bcol < 4096) {
      const float inv = exp2f(-(float)jr * (LOG2_ROPE / 32.f));
      const bool colrope = (wc >> 1) & 1;
#pragma unroll
      for (int ai = 0; ai < 2; ++ai)
#pragma unroll
        for (int m = 0; m < 4; ++m)
#pragma unroll
          for (int j = 0; j < 4; ++j) {
            int row = brow + ai * 128 + wr * 64 + m * 16 + fq * 4 + j;
            int s = (row - TP) & 2047;
            float ang = (float)(colrope ? (s & 63) : (s >> 6)) * inv;
            float cs = __cosf(ang), sn = __sinf(ang);
#pragma unroll
            for (int bj = 0; bj < 2; ++bj) {
              float x1 = acc[ai][bj][m][0][j], x2 = acc[ai][bj][m][1][j];
              acc[ai][bj][m][0][j] = x1 * cs - x2 * sn;
              acc[ai][bj][m][1][j] = x2 * cs + x1 * sn;
            }
          }
    }
  }
  if constexpr (EPI == EPI_E1 || EPI == EPI_O1) {
    if (brow < TP) {
#pragma unroll
      for (int ai = 0; ai < 2; ++ai)
#pragma unroll
        for (int bj = 0; bj < 2; ++bj)
#pragma unroll
          for (int n = 0; n < 2; ++n) {
            const int colg = bcol + bj * 128 + (wc >> 1) * 64 + n * 32 + (wc & 1) * 16;
            const int col = colg + fr;
            float* dst = nullptr; int ldo = 0, c0 = 0;
            if constexpr (EPI == EPI_E1) {
              if (colg >= 1024 && colg < 2048) { dst = p.out + OUT_NAK; ldo = 1024; c0 = 1024; }
              else if (colg >= 2048 && colg < 3072) { dst = p.out + OUT_NAV; ldo = 1024; c0 = 2048; }
              else if (colg >= 4864 && colg < 4928) { dst = p.out + OUT_KPE; ldo = 64; c0 = 4864; }
            } else {
              if (colg >= 2048 && colg < 4096) { dst = p.out + OUT_DK; ldo = 2048; c0 = 2048; }
              else if (colg >= 4096 && colg < 6144) { dst = p.out + OUT_DV; ldo = 2048; c0 = 4096; }
            }
            if (dst) {
#pragma unroll
              for (int m = 0; m < 4; ++m)
#pragma unroll
                for (int j = 0; j < 4; ++j) {
                  const int row = brow + ai * 128 + wr * 64 + m * 16 + fq * 4 + j;
                  size_t orow = (size_t)((row >> 8) * 2 + li) * 256 + (row & 255);
                  dst[orow * ldo + (col - c0)] = acc[ai][bj][m][n][j];
                }
            }
          }
    }
  }
  constexpr int CT_ROW = 528;
#pragma unroll
  for (int ai = 0; ai < 2; ++ai)
#pragma unroll
    for (int bj = 0; bj < 2; ++bj)
#pragma unroll
      for (int n = 0; n < 2; ++n) {
        const int cl = bj * 128 + (wc >> 1) * 64 + n * 32 + (wc & 1) * 16 + fr;
#pragma unroll
        for (int m = 0; m < 4; ++m)
#pragma unroll
          for (int j = 0; j < 4; ++j) {
            const int rl = ai * 128 + wr * 64 + m * 16 + fq * 4 + j;
            *(bfu*)(lds + rl * CT_ROW + cl * 2) = f2bf(acc[ai][bj][m][n][j]);
          }
      }
  __syncthreads();
#pragma unroll 4
  for (int i = 0; i < 16; ++i) {
    const int c = tid + 512 * i, rl = c >> 5, cc = c & 31;
    const u32x4 w = *(const u32x4*)(lds + rl * CT_ROW + cc * 16);
    const size_t row = (size_t)(brow + rl);
    const int col = bcol + cc * 8;
    if constexpr (EPI == EPI_E1) {
      if (col < EVEN_IN) *(u32x4*)((bfu*)(p.ws + WS_PBUF) + row * EVEN_IN + col) = w;
    } else if constexpr (EPI == EPI_O1) {
      *(u32x4*)((bfu*)(p.ws + WS_PBUF) + row * ODD_IN + col) = w;
    } else if constexpr (EPI == EPI_QM) {
      *(u32x4*)((bfu*)(p.ws + WS_QM) + row * 1536 + col) = w;
    } else if constexpr (EPI == EPI_KV) {
      const int hd = col >> 8, jj = col & 255;
      if (jj < 128) *(u32x4*)((bfu*)(p.ws + WS_KMLA) + row * 1536 + hd * 192 + jj) = w;
      else *(u32x4*)((bfu*)(p.ws + WS_VMLA) + row * 1024 + hd * 128 + (jj - 128)) = w;
    } else {
      *(u32x4*)((bfu*)(p.ws + WS_YBUF) + row * D + col) = w;
    }
  }
}

DI int tile_id(int it) {
  const int G = gridDim.x;
  const int pb = (G & 7) == 0 ? (blockIdx.x & 7) * (G >> 3) + (blockIdx.x >> 3) : blockIdx.x;
  return it * G + pb;
}
DI void tile_mn(int id, int nN, int& m, int& n) {
  int grp = id / (8 * nN), rem = id % (8 * nN);
  m = grp * 8 + (rem & 7); n = rem >> 3;
}

DI void phase_mid(const Params& p, int li) {
  const int tid = opaque(threadIdx.x), lane = tid & 63, wid = tid >> 6;
  const bfu* P = (const bfu*)(p.ws + WS_PBUF);
  bfu* cqn = (bfu*)(p.ws + WS_CQN);
  bfu* ckvn = (bfu*)(p.ws + WS_CKVN);
  bfu* kmla = (bfu*)(p.ws + WS_KMLA);
  const float* gq = p.in[17] + li * 512;
  const float* gkv = p.in[19] + li * 256;
  for (int t = blockIdx.x * 8 + wid; t < TALL; t += gridDim.x * 8) {
    float kp;
    if (t < T) {
      const bfu* Pr = P + (size_t)t * EVEN_IN;
      {
        u32x4 w = *(const u32x4*)(Pr + 4096 + lane * 8);
        float v[8] = {bflo(w[0]), bfhi(w[0]), bflo(w[1]), bfhi(w[1]), bflo(w[2]), bfhi(w[2]), bflo(w[3]), bfhi(w[3])};
        float ss = 0;
#pragma unroll
        for (int e = 0; e < 8; ++e) ss += v[e] * v[e];
        ss = wave_sum(ss);
        float rstd = rsqrtf(ss * (1.f / 512.f) + EPS);
#pragma unroll
        for (int e = 0; e < 8; ++e) v[e] = v[e] * rstd * gq[lane * 8 + e];
        u32x4 o = {cvtpk(v[0], v[1]), cvtpk(v[2], v[3]), cvtpk(v[4], v[5]), cvtpk(v[6], v[7])};
        *(u32x4*)(cqn + (size_t)t * 512 + lane * 8) = o;
      }
      {
        u32x2 w = *(const u32x2*)(Pr + 4608 + lane * 4);
        float v[4] = {bflo(w[0]), bfhi(w[0]), bflo(w[1]), bfhi(w[1])};
        float ss = v[0] * v[0] + v[1] * v[1] + v[2] * v[2] + v[3] * v[3];
        ss = wave_sum(ss);
        float rstd = rsqrtf(ss * (1.f / 256.f) + EPS);
#pragma unroll
        for (int e = 0; e < 4; ++e) v[e] = v[e] * rstd * gkv[lane * 4 + e];
        u32x2 o = {cvtpk(v[0], v[1]), cvtpk(v[2], v[3])};
        *(u32x2*)(ckvn + (size_t)t * 256 + lane * 4) = o;
        if (t < TP) {
          size_t orow = (size_t)((t >> 8) * 2 + li) * 256 + (t & 255);
          f32x4 f = {v[0], v[1], v[2], v[3]};
          *(f32x4*)(p.out + OUT_CKV + orow * 256 + lane * 4) = f;
        }
      }
      kp = bf2f(Pr[4864 + lane]);
      if (t >= TP) {
        int s = (t - TP) & 2047;
        float pos = (float)(lane < 32 ? (s >> 6) : (s & 63));
        int jj = lane & 15;
        float inv = exp2f(-(float)jj * (LOG2_ROPE / 16.f));
        float ang = pos * inv;
        float cs = __cosf(ang), sn = __sinf(ang);
        float pv = __shfl_xor(kp, 16);
        kp = (lane & 16) ? (kp * cs + pv * sn) : (kp * cs - pv * sn);
      }
    } else {
      int ci = t - T;
      int b = ci >> 9, j = ci & 511;
      size_t crow_ = (size_t)(b * 2 + li) * 512 + j;
      f32x4 f = *(const f32x4*)(p.in[4] + crow_ * 256 + lane * 4);
      u32x2 o = {cvtpk(f[0], f[1]), cvtpk(f[2], f[3])};
      *(u32x2*)(ckvn + (size_t)t * 256 + lane * 4) = o;
      kp = p.in[5][crow_ * 64 + lane];
    }
    bfu kb = f2bf(kp);
#pragma unroll
    for (int hd = 0; hd < 8; ++hd) kmla[(size_t)t * 1536 + hd * 192 + 128 + lane] = kb;
  }
}

struct Seg { const bfu* K; const bfu* V; int ldk, ldv, n; };
constexpr int ATT_KB = 24576, ATT_VB = 16384, ATT_BUF = ATT_KB + ATT_VB;
constexpr int ATT_BIAS_OFF = 3 * ATT_BUF;
constexpr int ATT_TR_ROW = 132;

template <int DQK>
DI void attn_issue(const int tid, const bfu* __restrict__ Kp, const bfu* __restrict__ Vp, int ldk, int ldv, char* buf) {
  constexpr int KROWB = DQK * 2;
#pragma unroll
  for (int i = 0; i < DQK / 64; ++i) {
    int bb = i * 8192 + tid * 16, row = bb / KROWB, cpos = (bb % KROWB) >> 4, c = cpos ^ (row & 7);
    __builtin_amdgcn_global_load_lds((const unsigned*)(Kp + (size_t)row * ldk + c * 8),
                                     (__attribute__((address_space(3))) unsigned*)(buf + bb), 16, 0, 0);
  }
#pragma unroll
  for (int i = 0; i < 2; ++i) {
    int bb = i * 8192 + tid * 16, row = bb >> 8, cpos = (bb & 255) >> 4, c = cpos ^ ((row & 3) << 2);
    __builtin_amdgcn_global_load_lds((const unsigned*)(Vp + (size_t)row * ldv + c * 8),
                                     (__attribute__((address_space(3))) unsigned*)(buf + ATT_KB + bb), 16, 0, 0);
  }
}

template <int DQK, bool NA, bool ROPEQ>
DI void attn_core(const int tid, f32x16* o, const bfu* __restrict__ Qrow, const Seg& s0, const Seg& s1, float C, char* lds,
                  int gr, int gc, int kr0, float prow, float pcol) {
  constexpr int KROWB = DQK * 2;
  constexpr int ND = DQK / 16;
  const int lane = tid & 63, r32 = lane & 31, hh = lane >> 5;
  const bool lag = __builtin_amdgcn_readfirstlane(tid >> 8) != 0;
  const float* sbias = (const float*)(lds + ATT_BIAS_OFF);
  const int nt0 = s0.n >> 6, ntile = nt0 + (s1.n >> 6);
  auto issue_tile = [&](int jt, int slot) {
    const bool in0 = jt < nt0;
    const bfu* Kp = in0 ? s0.K + (size_t)(jt * 64) * s0.ldk : s1.K + (size_t)((jt - nt0) * 64) * s1.ldk;
    const bfu* Vp = in0 ? s0.V + (size_t)(jt * 64) * s0.ldv : s1.V + (size_t)((jt - nt0) * 64) * s1.ldv;
    attn_issue<DQK>(tid, Kp, Vp, in0 ? s0.ldk : s1.ldk, in0 ? s0.ldv : s1.ldv, lds + slot * ATT_BUF);
  };
  __syncthreads();
  issue_tile(0, 0);
  bf16x8 qr[ND];
#pragma unroll
  for (int d0 = 0; d0 < ND; ++d0) qr[d0] = *(const bf16x8*)(Qrow + d0 * 16);
  if constexpr (ROPEQ) {
#pragma unroll
    for (int pr = 0; pr < 2; ++pr) {
      float pos = pr == 0 ? prow : pcol;
      bf16x8 a = qr[8 + 2 * pr], b = qr[9 + 2 * pr];
      float xa[8], xb[8];
#pragma unroll
      for (int e = 0; e < 8; ++e) {
        float inv = exp2f(-(float)(8 * hh + e) * (LOG2_ROPE / 16.f));
        float ang = pos * inv;
        float cs = __cosf(ang), sn = __sinf(ang);
        float x1 = bf2f((bfu)a[e]), x2 = bf2f((bfu)b[e]);
        xa[e] = x1 * cs - x2 * sn; xb[e] = x2 * cs + x1 * sn;
      }
      u32x4 wa = {cvtpk(xa[0], xa[1]), cvtpk(xa[2], xa[3]), cvtpk(xa[4], xa[5]), cvtpk(xa[6], xa[7])};
      u32x4 wb = {cvtpk(xb[0], xb[1]), cvtpk(xb[2], xb[3]), cvtpk(xb[4], xb[5]), cvtpk(xb[6], xb[7])};
      qr[8 + 2 * pr] = __builtin_bit_cast(bf16x8, wa); qr[9 + 2 * pr] = __builtin_bit_cast(bf16x8, wb);
    }
  }
#pragma unroll
  for (int d = 0; d < 4; ++d)
#pragma unroll
    for (int r = 0; r < 16; ++r) o[d][r] = 0.f;
  float m = -1e30f, l = 0.f;
  const int rs = min(max(gr - 4, 0), 24), cs_ = min(max(gc - 8, 0), 48);
  int kad[4];
#pragma unroll
  for (int q = 0; q < 4; ++q) kad[q] = r32 * KROWB + (((q * 2 + hh) ^ (r32 & 7)) << 4);
  const int q_ = (lane & 15) >> 2;
  int vad[4];
#pragma unroll
  for (int d = 0; d < 4; ++d) vad[d] = ATT_KB + (hh * 4 + q_) * 256 + ((d ^ q_) << 6) + (16 * ((lane >> 4) & 1) + 4 * (lane & 3)) * 2;

  auto qk_sm = [&](bf16x8* pa, const char* buf, const int j) {
    f32x16 p0, p1;
#pragma unroll
    for (int r = 0; r < 16; ++r) { p0[r] = 0.f; p1[r] = 0.f; }
#pragma unroll
    for (int hb = 0; hb < ND; hb += 4) {
      bf16x8 k0[4], k1[4];
#pragma unroll
      for (int d = 0; d < 4; ++d) {
        k0[d] = *(const bf16x8*)(buf + kad[d] + (hb >> 2) * 128);
        k1[d] = *(const bf16x8*)(buf + kad[d] + (hb >> 2) * 128 + 32 * KROWB);
      }
      __builtin_amdgcn_sched_barrier(0);
#pragma unroll
      for (int d = 0; d < 4; ++d) {
        p0 = mfma(k0[d], qr[hb + d], p0);
        p1 = mfma(k1[d], qr[hb + d], p1);
      }
      __builtin_amdgcn_sched_barrier(0);
    }
    float mx;
    if (NA && j >= nt0) {
      const int kr = kr0 + (j - nt0);
      const bool rowok = (kr >= rs) && (kr < rs + 8);
      const int brow = (kr - gr + 7) * 31 - gc + 15;
#pragma unroll
      for (int r = 0; r < 16; ++r) {
        int kc0 = crow(r, hh), kc1 = 32 + kc0;
        bool ok0 = rowok && (kc0 >= cs_) && (kc0 < cs_ + 16);
        bool ok1 = rowok && (kc1 >= cs_) && (kc1 < cs_ + 16);
        float b0 = sbias[ok0 ? brow + kc0 : 0], b1 = sbias[ok1 ? brow + kc1 : 0];
        p0[r] = ok0 ? p0[r] * C + b0 : -1e30f;
        p1[r] = ok1 ? p1[r] * C + b1 : -1e30f;
      }
      mx = p0[0];
#pragma unroll
      for (int r = 1; r < 16; ++r) mx = fmaxf(mx, p0[r]);
#pragma unroll
      for (int r = 0; r < 16; ++r) mx = fmaxf(mx, p1[r]);
      mx = fmaxf(mx, xor32(mx));
    } else {
      mx = p0[0];
#pragma unroll
      for (int r = 1; r < 16; ++r) mx = fmaxf(mx, p0[r]);
#pragma unroll
      for (int r = 0; r < 16; ++r) mx = fmaxf(mx, p1[r]);
      mx = fmaxf(mx, xor32(mx)) * C;
    }
    const float mn = fmaxf(m, mx);
    const float alpha = __builtin_amdgcn_exp2f(m - mn);
    m = mn;
    f2_t ps2 = {0.f, 0.f};
    if (NA && j >= nt0) {
#pragma unroll
      for (int r = 0; r < 16; r += 2) {
        p0[r] = __builtin_amdgcn_exp2f(p0[r] - mn); p0[r + 1] = __builtin_amdgcn_exp2f(p0[r + 1] - mn);
        p1[r] = __builtin_amdgcn_exp2f(p1[r] - mn); p1[r + 1] = __builtin_amdgcn_exp2f(p1[r + 1] - mn);
        f2_t a = {p0[r], p0[r + 1]}, b = {p1[r], p1[r + 1]};
        ps2 += a; ps2 += b;
      }
    } else {
      const f2_t c2 = {C, C}, nm2 = {-mn, -mn};
#pragma unroll
      for (int r = 0; r < 16; r += 2) {
        f2_t a = {p0[r], p0[r + 1]}, b = {p1[r], p1[r + 1]};
        a = a * c2 + nm2; b = b * c2 + nm2;
        p0[r] = __builtin_amdgcn_exp2f(a[0]); p0[r + 1] = __builtin_amdgcn_exp2f(a[1]);
        p1[r] = __builtin_amdgcn_exp2f(b[0]); p1[r + 1] = __builtin_amdgcn_exp2f(b[1]);
        f2_t ea = {p0[r], p0[r + 1]}, eb = {p1[r], p1[r + 1]};
        ps2 += ea; ps2 += eb;
      }
    }
    float ps = ps2[0] + ps2[1];
    ps += xor32(ps);
    l = l * alpha + ps;
    if (__any(alpha != 1.f)) {
#pragma unroll
      for (int d = 0; d < 4; ++d)
#pragma unroll
        for (int r = 0; r < 16; ++r) o[d][r] *= alpha;
    }
    u32x4 w0 = {cvtpk(p0[0], p0[1]), cvtpk(p0[2], p0[3]), cvtpk(p0[4], p0[5]), cvtpk(p0[6], p0[7])};
    u32x4 w1 = {cvtpk(p0[8], p0[9]), cvtpk(p0[10], p0[11]), cvtpk(p0[12], p0[13]), cvtpk(p0[14], p0[15])};
    u32x4 w2 = {cvtpk(p1[0], p1[1]), cvtpk(p1[2], p1[3]), cvtpk(p1[4], p1[5]), cvtpk(p1[6], p1[7])};
    u32x4 w3 = {cvtpk(p1[8], p1[9]), cvtpk(p1[10], p1[11]), cvtpk(p1[12], p1[13]), cvtpk(p1[14], p1[15])};
    pa[0] = __builtin_bit_cast(bf16x8, w0); pa[1] = __builtin_bit_cast(bf16x8, w1);
    pa[2] = __builtin_bit_cast(bf16x8, w2); pa[3] = __builtin_bit_cast(bf16x8, w3);
  };
  auto pv = [&](const bf16x8* pa, const char* buf) {
#pragma unroll
    for (int d = 0; d < 4; ++d) {
      s16x4 lo[4], hi[4];
#pragma unroll
      for (int s = 0; s < 4; ++s) {
        lo[s] = __builtin_amdgcn_ds_read_tr16_b64_v4i16((s16x4 __attribute__((address_space(3)))*)(buf + vad[d] + (16 * s) * 256));
        hi[s] = __builtin_amdgcn_ds_read_tr16_b64_v4i16((s16x4 __attribute__((address_space(3)))*)(buf + vad[d] + (16 * s + 8) * 256));
      }
#pragma unroll
      for (int s = 0; s < 4; ++s) {
        bf16x8 vb = {lo[s][0], lo[s][1], lo[s][2], lo[s][3], hi[s][0], hi[s][1], hi[s][2], hi[s][3]};
        o[d] = mfma(vb, pa[s], o[d]);
      }
    }
  };

  if (!lag) {
    int sl = 0;
    for (int j = 0; j <= ntile; ++j) {
      asm volatile("s_waitcnt vmcnt(0)" ::: "memory");
      __builtin_amdgcn_s_barrier();
      const int sn = sl == 2 ? 0 : sl + 1;
      if (j + 1 < ntile) issue_tile(j + 1, sn);
      if (j < ntile) { bf16x8 pa[4]; qk_sm(pa, lds + sl * ATT_BUF, j); pv(pa, lds + sl * ATT_BUF); }
      sl = sn;
    }
  } else {
    bf16x8 pa[4];
    int sl = 0;
    for (int j = 0; j <= ntile; ++j) {
      asm volatile("s_waitcnt vmcnt(0)" ::: "memory");
      __builtin_amdgcn_s_barrier();
      const int sn = sl == 2 ? 0 : sl + 1, sp = sl == 0 ? 2 : sl - 1;
      if (j + 1 < ntile) issue_tile(j + 1, sn);
      if (j > 0) pv(pa, lds + sp * ATT_BUF);
      if (j < ntile) qk_sm(pa, lds + sl * ATT_BUF, j);
      sl = sn;
    }
  }
  const float linv = 1.f / l;
#pragma unroll
  for (int d = 0; d < 4; ++d)
#pragma unroll
    for (int r = 0; r < 16; ++r) o[d][r] *= linv;
}

DI float* tr_stage(const int tid, const f32x16* o, char* lds) {
  const int lane = tid & 63, wid = tid >> 6, r32 = lane & 31, hh = lane >> 5;
  float* tr = (float*)lds + wid * (32 * ATT_TR_ROW);
  __syncthreads();
#pragma unroll
  for (int d = 0; d < 4; ++d)
#pragma unroll
    for (int g = 0; g < 4; ++g) {
      f32x4 v = {o[d][4 * g], o[d][4 * g + 1], o[d][4 * g + 2], o[d][4 * g + 3]};
      *(f32x4*)(tr + r32 * ATT_TR_ROW + d * 32 + 8 * g + 4 * hh) = v;
    }
  return tr;
}

DI void store_gated(const int tid, const Params& p, const f32x16* o, int t0, int gcol, int ocol, char* lds) {
  const int lane = tid & 63, wid = tid >> 6;
  const bfu* P = (const bfu*)(p.ws + WS_PBUF);
  bfu* O = (bfu*)(p.ws + WS_HBUF);
  const float* tr = tr_stage(tid, o, lds);
#pragma unroll 1
  for (int r0 = 0; r0 < 32; r0 += 8) {
    unsigned g[8];
#pragma unroll
    for (int u = 0; u < 8; ++u) g[u] = *(const unsigned*)(P + (size_t)(t0 + wid * 32 + r0 + u) * EVEN_IN + gcol + lane * 2);
#pragma unroll
    for (int u = 0; u < 8; ++u) {
      f2_t v = *(const f2_t*)(tr + (r0 + u) * ATT_TR_ROW + lane * 2);
      *(unsigned*)(O + (size_t)(t0 + wid * 32 + r0 + u) * D + ocol + lane * 2) = cvtpk(v[0] * silu(bflo(g[u])), v[1] * silu(bfhi(g[u])));
    }
  }
}

DI int xcd_item(int item) {
  if (gridDim.x != 256) return item;
  const int blk = item & 255, sweep = item >> 8;
  const int xcd = blk & 7, slot = blk >> 3, gl = slot >> 3, qb = slot & 7;
  return sweep * 256 + ((gl * 8 + xcd) << 3) + qb;
}

DI void phase_attn_even(const Params& p, int li, char* lds) {
  const bfu* P = (const bfu*)(p.ws + WS_PBUF);
  const bfu* Qm = (const bfu*)(p.ws + WS_QM);
  const bfu* Km = (const bfu*)(p.ws + WS_KMLA);
  const bfu* Vm = (const bfu*)(p.ws + WS_VMLA);
  const bfu* cnk = (const bfu*)(p.ws + WS_C_NAK);
  const bfu* cnv = (const bfu*)(p.ws + WS_C_NAV);
  const float CM = 0.07216878364870322f * LOG2E;
  const float CN = 0.08838834764831845f * LOG2E;
  int item = blockIdx.x;
  for (; item < 512; item += gridDim.x) {
    const int tid = opaque(threadIdx.x), lane = tid & 63, wid = tid >> 6, r32 = lane & 31, hh = lane >> 5;
    f32x16 o[4];
    const int xi = xcd_item(item);
    int b = xi >> 6, hd = (xi >> 3) & 7, qb = xi & 7;
    int t0 = TP + b * 2048 + qb * 256;
    int trow = t0 + wid * 32 + r32;
    int s = qb * 256 + wid * 32 + r32;
    Seg s0 = {Km + (size_t)(T + b * 512) * 1536 + hd * 192, Vm + (size_t)(T + b * 512) * 1024 + hd * 128, 1536, 1024, 512};
    Seg s1 = {Km + (size_t)(TP + b * 2048) * 1536 + hd * 192, Vm + (size_t)(TP + b * 2048) * 1024 + hd * 128, 1536, 1024, 2048};
    attn_core<192, false, true>(tid, o, Qm + (size_t)trow * 1536 + hd * 192 + hh * 8, s0, s1, CM, lds, 0, 0, 0, (float)(s >> 6), (float)(s & 63));
    store_gated(tid, p, o, t0, 4928 + hd * 128, 1024 + hd * 128, lds);
  }
  for (; item < 1024; item += gridDim.x) {
    const int tid = opaque(threadIdx.x), lane = tid & 63, wid = tid >> 6, r32 = lane & 31, hh = lane >> 5;
    const int it = xcd_item(item - 512);
    f32x16 o[4];
    int b = it >> 6, hd = (it >> 3) & 7, qb = it & 7;
    int t0 = TP + b * 2048 + qb * 256;
    int trow = t0 + wid * 32 + r32;
    int qi = wid * 32 + r32;
    int gr = qb * 4 + (qi >> 6), gc = qi & 63;
    int kr0 = min(max(qb * 4 - 4, 0), 24);
    int kr1 = min(max(qb * 4 + 3 - 4, 0), 24) + 8;
    __syncthreads();
    float* sb = (float*)(lds + ATT_BIAS_OFF);
    for (int idx = tid; idx < 465; idx += 512) sb[idx] = p.in[16][(size_t)(li * 8 + hd) * 465 + idx] * LOG2E;
    Seg s0 = {cnk + (size_t)((b * 2 + li) * 512) * 1024 + hd * 128, cnv + (size_t)((b * 2 + li) * 512) * 1024 + hd * 128, 1024, 1024, 512};
    const bfu* Pl = P + (size_t)(TP + b * 2048 + kr0 * 64) * EVEN_IN;
    Seg s1 = {Pl + 1024 + hd * 128, Pl + 2048 + hd * 128, EVEN_IN, EVEN_IN, (kr1 - kr0) * 64};
    attn_core<128, true, false>(tid, o, P + (size_t)trow * EVEN_IN + hd * 128 + hh * 8, s0, s1, CN, lds, gr, gc, kr0, 0.f, 0.f);
    store_gated(tid, p, o, t0, 3072 + hd * 128, hd * 128, lds);
  }
  for (; item < 1280; item += gridDim.x) {
    const int tid = opaque(threadIdx.x), lane = tid & 63, wid = tid >> 6, r32 = lane & 31, hh = lane >> 5;
    const int it = item - 1024;
    f32x16 o[4];
    int b = it >> 3, hd = it & 7;
    int t0 = b * 256;
    int trow = t0 + wid * 32 + r32;
    Seg s0 = {Km + (size_t)(b * 256) * 1536 + hd * 192, Vm + (size_t)(b * 256) * 1024 + hd * 128, 1536, 1024, 256};
    Seg s1 = {s0.K, s0.V, 1536, 1024, 0};
    attn_core<192, false, false>(tid, o, Qm + (size_t)trow * 1536 + hd * 192 + hh * 8, s0, s1, CM, lds, 0, 0, 0, 0.f, 0.f);
    store_gated(tid, p, o, t0, 4928 + hd * 128, 1024 + hd * 128, lds);
  }
  for (; item < 1536; item += gridDim.x) {
    const int tid = opaque(threadIdx.x), lane = tid & 63, wid = tid >> 6, r32 = lane & 31, hh = lane >> 5;
    const int it = item - 1280;
    f32x16 o[4];
    int b = it >> 3, hd = it & 7;
    int t0 = b * 256;
    int trow = t0 + wid * 32 + r32;
    const bfu* Pb = P + (size_t)(b * 256) * EVEN_IN;
    Seg s0 = {Pb + 1024 + hd * 128, Pb + 2048 + hd * 128, EVEN_IN, EVEN_IN, 256};
    Seg s1 = {s0.K, s0.V, EVEN_IN, EVEN_IN, 0};
    attn_core<128, false, false>(tid, o, P + (size_t)trow * EVEN_IN + hd * 128 + hh * 8, s0, s1, CN, lds, 0, 0, 0, 0.f, 0.f);
    store_gated(tid, p, o, t0, 3072 + hd * 128, hd * 128, lds);
  }
}

DI void phase_attn_odd(const Params& p, int l, char* lds) {
  const int li = l >> 1;
  const bfu* P = (const bfu*)(p.ws + WS_PBUF);
  bfu* O = (bfu*)(p.ws + WS_HBUF);
  const bfu* cdk = (const bfu*)(p.ws + WS_C_DK);
  const bfu* cdv = (const bfu*)(p.ws + WS_C_DV);
  float* scr = (float*)(p.ws + WS_SCR) + (size_t)blockIdx.x * 65536;
  const float CD = 0.08838834764831845f * LOG2E;
  const float lam_init = 0.8f - 0.6f * expf(-0.3f * (float)l);
  float lam;
  {
    const float* lp = p.in[23] + li * 512;
    float s1 = 0.f, s2 = 0.f;
    for (int k = 0; k < 128; ++k) { s1 += lp[k] * lp[128 + k]; s2 += lp[256 + k] * lp[384 + k]; }
    lam = expf(s1) - expf(s2) + lam_init;
  }
  const float* gsub = p.in[24] + li * 256;
  for (int item = blockIdx.x; item < 768; item += gridDim.x) {
    const int tid = opaque(threadIdx.x), lane = tid & 63, wid = tid >> 6, r32 = lane & 31, hh = lane >> 5;
    int b, hd, t0; Seg s0, s1;
    if (item < 512) {
      const int xi = xcd_item(item);
      b = xi >> 6; hd = (xi >> 3) & 7; int qb = xi & 7;
      t0 = TP + b * 2048 + qb * 256;
      const bfu* Pl = P + (size_t)(TP + b * 2048) * ODD_IN;
      s0 = Seg{cdk + (size_t)((b * 2 + li) * 512) * 2048 + hd * 256, cdv + (size_t)((b * 2 + li) * 512) * 2048 + hd * 256, 2048, 2048, 512};
      s1 = Seg{Pl + 2048 + hd * 256, Pl + 4096 + hd * 256, ODD_IN, ODD_IN, 2048};
    } else {
      int it = item - 512;
      b = it >> 3; hd = it & 7;
      t0 = b * 256;
      const bfu* Pb = P + (size_t)(b * 256) * ODD_IN;
      s0 = Seg{Pb + 2048 + hd * 256, Pb + 4096 + hd * 256, ODD_IN, ODD_IN, 256};
      s1 = Seg{s0.K, s0.V, ODD_IN, ODD_IN, 0};
    }
    const int trow = t0 + wid * 32 + r32;
    float ssq = 0.f;
    for (int pass = 0; pass < 4; ++pass) {
      const int vh = pass >> 1, c = pass & 1;
      f32x16 o[4];
      Seg a0 = s0, a1 = s1;
      a0.K += c * 128; a1.K += c * 128; a0.V += vh * 128; a1.V += vh * 128;
      for (int rep = 0; rep < p.nrep; ++rep)
        attn_core<128, false, false>(tid, o, P + (size_t)trow * ODD_IN + hd * 256 + c * 128 + hh * 8, a0, a1, CD, lds, 0, 0, 0, 0.f, 0.f);
      float* sc = scr + vh * 32768 + tid;
      if (c == 1) {
        float ss = 0.f;
#pragma unroll
        for (int d = 0; d < 4; ++d)
#pragma unroll
          for (int r = 0; r < 16; ++r) {
            float dd = sc[(d * 16 + r) * 512] - lam * o[d][r];
            o[d][r] = dd; ss += dd * dd;
          }
        ssq += ss;
      }
#pragma unroll
      for (int d = 0; d < 4; ++d)
#pragma unroll
        for (int r = 0; r < 16; ++r) sc[(d * 16 + r) * 512] = o[d][r];
    }
    ssq += __shfl_xor(ssq, 32);
    const float rstd = rsqrtf(ssq * (1.f / 256.f) + EPS) * (1.f - lam_init);
    for (int half = 0; half < 2; ++half) {
      f32x16 o[4];
      const float* sc = scr + half * 32768 + tid;
#pragma unroll
      for (int d = 0; d < 4; ++d)
#pragma unroll
        for (int r = 0; r < 16; ++r) o[d][r] = sc[(d * 16 + r) * 512] * rstd;
      const float* tr = tr_stage(tid, o, lds);
      const int colb = hd * 256 + half * 128 + lane * 2;
      const float g0 = gsub[half * 128 + lane * 2], g1 = gsub[half * 128 + lane * 2 + 1];
#pragma unroll 1
      for (int r0 = 0; r0 < 32; r0 += 8) {
        unsigned g[8];
#pragma unroll
        for (int u = 0; u < 8; ++u) g[u] = *(const unsigned*)(P + (size_t)(t0 + wid * 32 + r0 + u) * ODD_IN + 6144 + colb);
#pragma unroll
        for (int u = 0; u < 8; ++u) {
          f2_t v = *(const f2_t*)(tr + (r0 + u) * ATT_TR_ROW + lane * 2);
          *(unsigned*)(O + (size_t)(t0 + wid * 32 + r0 + u) * D + colb) = cvtpk(v[0] * g0 * silu(bflo(g[u])), v[1] * g1 * silu(bfhi(g[u])));
        }
      }
    }
  }
}

#ifndef PM
#define PM 0xffff
#endif
template <int EPI>
DI void gemm_phase(const Params& p, const bfu* A, const bfu* Bt, int K, int nM, int nN, int li, char* lds) {
  const int ntiles = nM * nN;
  for (int it = 0; it * (int)gridDim.x < ntiles; ++it) {
    int id = tile_id(it);
    if (id >= ntiles) continue;
    int m, n; tile_mn(id, nN, m, n);
    gemm256<EPI>(p, A, Bt, K, m * 256, n * 256, li, lds);
  }
}

DI void run_phase(const Params& p, int ph, char* lds) {
  if (ph == 0) { if (PM & 1) phase_prep(p, lds); return; }
  if (ph == 1) { if (PM & 2) phase_rows(p, 0, 0, lds); return; }
  const int q = ph - 2, pair = q / 10, r = q % 10;
  const bfu* hbuf = (const bfu*)(p.ws + WS_HBUF);
  if (r < 6) {
    const int l = 2 * pair, li = pair;
    if (r == 0 && (PM & 4)) {
      gemm_phase<EPI_E1>(p, hbuf, (const bfu*)(p.ws + WS_WT_IN_E) + (size_t)li * EVEN_PAD * D, D, 96, 24, li, lds);
    } else if (r == 1 && (PM & 8)) {
      phase_mid(p, li);
    } else if (r == 2 && (PM & 16)) {
      gemm_phase<EPI_QM>(p, (const bfu*)(p.ws + WS_CQN), (const bfu*)(p.ws + WS_WT_UQ) + (size_t)li * 1536 * 512, 512, 96, 6, li, lds);
      gemm_phase<EPI_KV>(p, (const bfu*)(p.ws + WS_CKVN), (const bfu*)(p.ws + WS_WT_UKV) + (size_t)li * 2048 * 256, 256, 112, 8, li, lds);
    } else if (r == 3 && (PM & 32)) {
      phase_attn_even(p, li, lds);
    } else if (r == 4 && (PM & 64)) {
      gemm_phase<EPI_Y>(p, hbuf, (const bfu*)(p.ws + WS_WT_OUT_E) + (size_t)li * D * D, D, 96, 8, li, lds);
    } else if (r == 5 && (PM & 128)) {
      phase_rows(p, 1, l, lds);
    }
  } else {
    const int l = 2 * pair + 1, li = pair, k = r - 6;
    if (k == 0 && (PM & 256)) {
      gemm_phase<EPI_O1>(p, hbuf, (const bfu*)(p.ws + WS_WT_IN_O) + (size_t)li * ODD_IN * D, D, 96, 32, li, lds);
    } else if (k == 1 && (PM & 512)) {
      phase_attn_odd(p, l, lds);
    } else if (k == 2 && (PM & 1024)) {
      gemm_phase<EPI_Y>(p, hbuf, (const bfu*)(p.ws + WS_WT_OUT_O) + (size_t)li * D * D, D, 96, 8, li, lds);
    } else if (k == 3 && (PM & 2048)) {
      phase_rows(p, 1, l, lds);
    }
  }
}


#define XB_TMO      128
#define XB_XCNT(j)  (256  + 64 * (j))
#define XB_XSUB(j)  (1280 + 64 * (j))
#define XB_XGEN(j)  (2304 + 64 * (j))
#define XB_TOP      3328
#define XB_TOPGEN   3392
#define XCD_BAR_WORDS 3456
#define XB_SPIN_CAP (1u << 22)
#define LAS __attribute__((address_space(3)))
DI unsigned xb_ld(unsigned* p)              { return __hip_atomic_load(p, __ATOMIC_RELAXED, __HIP_MEMORY_SCOPE_AGENT); }
DI unsigned xb_add(unsigned* p, unsigned v) { return __hip_atomic_fetch_add(p, v, __ATOMIC_RELAXED, __HIP_MEMORY_SCOPE_AGENT); }
DI unsigned xb_xcc_id() { return (unsigned)__builtin_amdgcn_s_getreg((3 << 11) | 20) & 0xFu; }
#define XB_SPIN(cond, bar) do { unsigned _sp = 0; while (cond) { __builtin_amdgcn_s_sleep(1); \
    if ((++_sp & 255u) == 0u) { if (xb_ld(&(bar)[XB_TMO])) break; if (_sp > XB_SPIN_CAP) { atomicAdd(&(bar)[XB_TMO], 1u); break; } } } } while (0)
struct XcdBarrier { unsigned* bar; unsigned x; volatile LAS unsigned* st; };
DI XcdBarrier xcd_barrier_post(unsigned* bar, volatile LAS unsigned* st) {
  XcdBarrier b; b.bar = bar; b.x = xb_xcc_id(); b.st = st;
  if (threadIdx.x == 0) (void)xb_add(&bar[XB_XCNT(b.x)], 1u);
  return b;
}
DI void xcd_barrier_complete(unsigned* bar, unsigned x, unsigned& nloc, unsigned& nx) {
  const unsigned G = gridDim.x * gridDim.y * gridDim.z;
  unsigned sum, cnt, mine, sp = 0u;
  for (;;) {
    sum = 0u; cnt = 0u; mine = 0u;
#pragma unroll
    for (unsigned j = 0; j < 16; ++j) { const unsigned c = xb_ld(&bar[XB_XCNT(j)]); sum += c; cnt += (c > 0u) ? 1u : 0u; mine = (j == x) ? c : mine; }
    if (sum == G) break;
    __builtin_amdgcn_s_sleep(1);
    if ((++sp & 255u) == 0u) { if (xb_ld(&bar[XB_TMO])) break; if (sp > XB_SPIN_CAP) { atomicAdd(&bar[XB_TMO], 1u); break; } }
  }
  nloc = mine > 0u ? mine : 1u; nx = cnt > 0u ? cnt : 1u;
}
DI void xcd_barrier(const XcdBarrier& b) {
  asm volatile("s_waitcnt vmcnt(0)" ::: "memory");
  __syncthreads();
  if (threadIdx.x == 0) {
    unsigned* bar = b.bar;
    __builtin_amdgcn_s_waitcnt(0);
    unsigned nloc = b.st[0], nx = b.st[1];
    if (nloc == 0u) { xcd_barrier_complete(bar, b.x, nloc, nx); b.st[0] = nloc; b.st[1] = nx; }
    const unsigned old = xb_add(&bar[XB_XSUB(b.x)], 1u);
    const unsigned gen = old / nloc;
    if (old + 1u == (gen + 1u) * nloc) {
      __builtin_amdgcn_fence(__ATOMIC_RELEASE, "agent");
      asm volatile("s_waitcnt vmcnt(0)" ::: "memory");
      const unsigned og = xb_add(&bar[XB_TOP], 1u);
      const unsigned tg = og / nx;
      if (og + 1u == (tg + 1u) * nx) xb_add(&bar[XB_TOPGEN], 1u);
      else XB_SPIN(xb_ld(&bar[XB_TOPGEN]) == tg, bar);
      __builtin_amdgcn_fence(__ATOMIC_ACQUIRE, "agent");
      xb_add(&bar[XB_XGEN(b.x)], 1u);
      asm volatile("s_waitcnt vmcnt(0)" ::: "memory");
    } else {
      XB_SPIN(xb_ld(&bar[XB_XGEN(b.x)]) == gen, bar);
      __builtin_amdgcn_fence(__ATOMIC_ACQUIRE, "agent");
      asm volatile("s_waitcnt vmcnt(0)" ::: "memory");
    }
  }
  __syncthreads();
}

constexpr int N_PHASES = 22;
constexpr int LDS_BYTES = 8 * 32 * ATT_TR_ROW * 4;

__global__ void __launch_bounds__(512, 2) fwd_megakernel(Params p) {
  __shared__ __attribute__((aligned(16))) char lds[LDS_BYTES];
  __shared__ uint4 xb_words;
  cg::grid_group grid = cg::this_grid();
  if (threadIdx.x == 0) xb_words = make_uint4(0u, 0u, 0u, 0u);
  __syncthreads();
  XcdBarrier xb = xcd_barrier_post((unsigned*)(p.ws + WS_BAR), (volatile LAS unsigned*)&xb_words);
  for (int ph = p.lo; ph < p.hi; ++ph) {
    run_phase(p, ph, lds);
    if (ph + 1 < p.hi) { if (ph == 0) grid.sync(); else xcd_barrier(xb); }
  }
}

extern "C" void kernel_launch(void* const* d_in, const int* in_sizes, int n_in, void* d_out, int out_size, void* d_ws, size_t ws_size,
                              hipStream_t stream) {
  static int grid_blocks = 0;
  if (!grid_blocks) {
    int dev = 0, cus = 0, per_cu = 0;
    (void)hipGetDevice(&dev);
    (void)hipDeviceGetAttribute(&cus, hipDeviceAttributeMultiprocessorCount, dev);
    (void)hipOccupancyMaxActiveBlocksPerMultiprocessor(&per_cu, fwd_megakernel, 512, 0);
    if (per_cu < 1) per_cu = 1;
    per_cu = 1;
    grid_blocks = cus * per_cu;
    if (grid_blocks > 512) grid_blocks = 512;
  }
  if (n_in != 25 || ws_size < WS_NEED) {
    fprintf(stderr, "kernel_launch: bad n_in %d or ws_size %zu < %zu\n", n_in, ws_size, (size_t)WS_NEED);
    return;
  }
  Params p{};
  for (int i = 0; i < 25; ++i) p.in[i] = (const float*)d_in[i];
  p.out = (float*)d_out;
  p.ws = (char*)d_ws;
#ifndef NREP
#define NREP 1
#endif
  p.nrep = NREP; p.pad = 0;
#ifndef PROBE_PHASE
  p.lo = 0; p.hi = N_PHASES;
  void* args[] = {&p};
  (void)hipMemsetAsync((char*)d_ws + WS_BAR, 0, 16384, stream);
  hipError_t e = hipLaunchCooperativeKernel((void*)fwd_megakernel, dim3(grid_blocks), dim3(512), args, 0, stream);
  if (e != hipSuccess) fprintf(stderr, "cooperative launch failed: %s (grid %d)\n", hipGetErrorString(e), grid_blocks);
#else
  void* args[] = {&p};
  p.lo = 0; p.hi = PROBE_PHASE + 1;
  (void)hipMemsetAsync((char*)d_ws + WS_BAR, 0, 16384, stream);
  (void)hipLaunchCooperativeKernel((void*)fwd_megakernel, dim3(grid_blocks), dim3(512), args, 0, stream);
  p.lo = PROBE_PHASE; p.hi = N_PHASES;
  (void)hipMemsetAsync((char*)d_ws + WS_BAR, 0, 16384, stream);
  (void)hipLaunchCooperativeKernel((void*)fwd_megakernel, dim3(grid_blocks), dim3(512), args, 0, stream);
#endif
}
```

```cpp
#include <hip/hip_runtime.h>
#include <hip/hip_cooperative_groups.h>
#include <cstdio>
#include <cstdint>
namespace cg = cooperative_groups;

#define DI __device__ __forceinline__
typedef unsigned short bfu;
using bf16x8 = __attribute__((ext_vector_type(8))) short;
using s16x4  = __attribute__((ext_vector_type(4))) short;
using f32x16 = __attribute__((ext_vector_type(16))) float;
using f32x4  = __attribute__((ext_vector_type(4))) float;
using u32x4  = __attribute__((ext_vector_type(4))) unsigned;
using u32x2  = __attribute__((ext_vector_type(2))) unsigned;
typedef __bf16 bf2_t __attribute__((ext_vector_type(2)));
typedef float f2_t __attribute__((ext_vector_type(2)));

constexpr int D = 2048, TP = 8192, TS = 16384, T = 24576, TALL = 28672;
constexpr int EVEN_IN = 5952, ODD_IN = 8192;
constexpr float EPS = 1e-6f;
constexpr float LOG2E = 1.4426950408889634f;
constexpr float LOG2_ROPE = 13.287712379549449f;

constexpr size_t OUT_YP = 0, OUT_YS = 16777216, OUT_NAK = 50331648, OUT_NAV = 67108864, OUT_CKV = 83886080,
                 OUT_KPE = 88080384, OUT_DK = 89128960, OUT_DV = 122683392;

constexpr size_t al256(size_t x) { return (x + 255) / 256 * 256; }
constexpr size_t WS_WT_IN_E = 0;
constexpr int EVEN_PAD = 6144;
constexpr size_t WS_WT_IN_O = WS_WT_IN_E + al256((size_t)2 * EVEN_PAD * D * 2);
constexpr size_t WS_WT_OUT_E = WS_WT_IN_O + al256((size_t)2 * ODD_IN * D * 2);
constexpr size_t WS_WT_OUT_O = WS_WT_OUT_E + al256((size_t)2 * D * D * 2);
constexpr size_t WS_WT_UQ = WS_WT_OUT_O + al256((size_t)2 * D * D * 2);
constexpr size_t WS_WT_UKV = WS_WT_UQ + al256((size_t)2 * 1536 * 512 * 2);
constexpr size_t WS_C_NAK = WS_WT_UKV + al256((size_t)2 * 2048 * 256 * 2);
constexpr size_t WS_C_NAV = WS_C_NAK + al256((size_t)8 * 2 * 512 * 1024 * 2);
constexpr size_t WS_C_DK = WS_C_NAV + al256((size_t)8 * 2 * 512 * 1024 * 2);
constexpr size_t WS_C_DV = WS_C_DK + al256((size_t)8 * 2 * 512 * 2048 * 2);
constexpr size_t WS_MODP = WS_C_DV + al256((size_t)8 * 2 * 512 * 2048 * 2);
constexpr size_t WS_BAR = WS_MODP + al256((size_t)4 * 4 * 9 * 6144 * 4);
constexpr size_t WS_HBUF = WS_BAR + 16384;
constexpr size_t WS_CQN = WS_HBUF;
constexpr size_t WS_CKVN = WS_HBUF + al256((size_t)T * 512 * 2);
constexpr size_t WS_PBUF = WS_HBUF + al256((size_t)T * D * 2);
constexpr size_t WS_YBUF = WS_PBUF;
constexpr size_t WS_QM = WS_PBUF + al256((size_t)T * EVEN_IN * 2);
constexpr size_t WS_KMLA = WS_QM + al256((size_t)T * 1536 * 2);
constexpr size_t WS_VMLA = WS_KMLA + al256((size_t)TALL * 1536 * 2);
constexpr size_t WS_END_EVEN = WS_VMLA + al256((size_t)TALL * 1024 * 2);
constexpr size_t WS_SCR = WS_PBUF + al256((size_t)T * ODD_IN * 2);
constexpr size_t WS_END_ODD = WS_SCR + (size_t)1024 * 131072;
constexpr size_t WS_NEED = WS_END_EVEN > WS_END_ODD ? WS_END_EVEN : WS_END_ODD;

struct Params {
  const float* in[25];
  float* out;
  char* ws;
  int lo, hi;
  int nrep, pad;
};

DI unsigned cvtpk(float lo, float hi) {
  f2_t v = {lo, hi};
  bf2_t b = __builtin_convertvector(v, bf2_t);
  return __builtin_bit_cast(unsigned, b);
}
DI bfu f2bf(float x) { return (bfu)(cvtpk(x, 0.f) & 0xffffu); }
DI float bf2f(bfu b) { return __uint_as_float(((unsigned)b) << 16); }
DI float bflo(unsigned u) { return __uint_as_float(u << 16); }
DI float bfhi(unsigned u) { return __uint_as_float(u & 0xffff0000u); }
DI int opaque(int x) { asm volatile("" : "+v"(x)); return x; }
DI int crow(int r, int hi) { return (r & 3) + 8 * (r >> 2) + 4 * hi; }
DI float silu(float x) { return x * __builtin_amdgcn_rcpf(1.f + __expf(-x)); }
DI f32x16 mfma(bf16x8 a, bf16x8 b, f32x16 c) { return __builtin_amdgcn_mfma_f32_32x32x16_bf16(a, b, c, 0, 0, 0); }
DI float xor32(float v) {
  auto rr = __builtin_amdgcn_permlane32_swap(__float_as_uint(v), __float_as_uint(v), false, false);
  return __uint_as_float((threadIdx.x & 32) ? rr[0] : rr[1]);
}
DI float wave_sum(float v) {
#pragma unroll
  for (int o = 32; o >= 1; o >>= 1) v += __shfl_xor(v, o);
  return v;
}
DI float block_sum(float v, float* red, int tid) {
  v = wave_sum(v);
  __syncthreads();
  if ((tid & 63) == 0) red[tid >> 6] = v;
  __syncthreads();
  const int hb = (tid >> 8) * 4;
  return red[hb] + red[hb + 1] + red[hb + 2] + red[hb + 3];
}
DI float modval(const Params& p, int l, int r, int n) {
  const float* mp = (const float*)(p.ws + WS_MODP);
  float s = p.in[11][l * 6144 + n];
#pragma unroll
  for (int ks = 0; ks < 4; ++ks) s += mp[((size_t)(ks * 4 + l) * 9 + r) * 6144 + n];
  return s;
}

DI void prep_mod_item(const Params& p, int item, char* lds) {
  const int tid = opaque(threadIdx.x), lane = tid & 63, wid = tid >> 6;
  const int ks = item & 3, cgp = (item >> 2) % 24, l = item / 96;
  float* scond = (float*)lds;
  float* red = (float*)(lds + 18432);
  for (int idx = tid; idx < 9 * 512; idx += 512) {
    int r = idx >> 9, kk = idx & 511;
    float cv = r < 8 ? p.in[8][r * 2048 + ks * 512 + kk] : p.in[9][ks * 512 + kk];
    scond[idx] = silu(cv);
  }
  __syncthreads();
  const float* W = p.in[10] + ((size_t)l * 2048 + ks * 512 + wid * 64) * 6144 + cgp * 256 + lane * 4;
  float acc[9][4];
#pragma unroll
  for (int r = 0; r < 9; ++r) { acc[r][0] = 0; acc[r][1] = 0; acc[r][2] = 0; acc[r][3] = 0; }
  for (int kk = 0; kk < 64; kk += 4) {
    f32x4 w[4];
#pragma unroll
    for (int u = 0; u < 4; ++u) w[u] = *(const f32x4*)(W + (size_t)(kk + u) * 6144);
#pragma unroll
    for (int u = 0; u < 4; ++u) {
#pragma unroll
      for (int r = 0; r < 9; ++r) {
        float s = scond[r * 512 + wid * 64 + kk + u];
        acc[r][0] += s * w[u][0]; acc[r][1] += s * w[u][1]; acc[r][2] += s * w[u][2]; acc[r][3] += s * w[u][3];
      }
    }
  }
#pragma unroll
  for (int r = 0; r < 9; ++r) {
    f32x4 v = {acc[r][0], acc[r][1], acc[r][2], acc[r][3]};
    *(f32x4*)(red + (wid * 9 + r) * 256 + lane * 4) = v;
  }
  __syncthreads();
  float* mp = (float*)(p.ws + WS_MODP);
  for (int idx = tid; idx < 9 * 256; idx += 512) {
    int r = idx >> 8, cc = idx & 255;
    float s = 0.f;
#pragma unroll
    for (int w = 0; w < 8; ++w) s += red[(w * 9 + r) * 256 + cc];
    mp[((size_t)(ks * 4 + l) * 9 + r) * 6144 + cgp * 256 + cc] = s;
  }
  __syncthreads();
}

DI int swap45(int n) { return (n & ~0x30) | ((n & 0x10) << 1) | ((n & 0x20) >> 1); }

DI void prep_transpose_tile(const float* __restrict__ src, bfu* __restrict__ dst, int K, int N, int k0, int n0, char* lds, int tid) {
  float* tl = (float*)lds + (tid >> 8) * (64 * 65);
  const int t4 = tid & 255;
#pragma unroll
  for (int i = 0; i < 4; ++i) {
    int kr = (t4 >> 4) + 16 * i, nc = (t4 & 15) * 4;
    f32x4 v = *(const f32x4*)(src + (size_t)(k0 + kr) * N + n0 + nc);
    tl[kr * 65 + nc + 0] = v[0]; tl[kr * 65 + nc + 1] = v[1]; tl[kr * 65 + nc + 2] = v[2]; tl[kr * 65 + nc + 3] = v[3];
  }
  __syncthreads();
  {
    int n = t4 >> 2, kseg = (t4 & 3) * 16;
    unsigned w[8];
#pragma unroll
    for (int e = 0; e < 8; ++e) w[e] = cvtpk(tl[(kseg + 2 * e) * 65 + n], tl[(kseg + 2 * e + 1) * 65 + n]);
    u32x4 a = {w[0], w[1], w[2], w[3]}, b = {w[4], w[5], w[6], w[7]};
    bfu* d = dst + (size_t)swap45(n0 + n) * K + k0 + kseg;
    *(u32x4*)d = a; *(u32x4*)(d + 8) = b;
  }
  __syncthreads();
}

DI void phase_prep(const Params& p, char* lds) {
  constexpr int N_MOD = 384, N_TR_L = 9440, N_TRP = N_TR_L, N_CV = 1536;
  for (int item = blockIdx.x; item < N_MOD + N_TRP + N_CV; item += gridDim.x) {
    if (item < N_MOD) { prep_mod_item(p, item, lds); continue; }
    const int tid = opaque(threadIdx.x);
    int it = item - N_MOD;
    if (it < N_TRP) {
      int tl = it * 2 + (tid >> 8);
      int i = tl / N_TR_L, r = tl % N_TR_L;
      const float* src; bfu* dst; int K, N;
      if (r < 2976) { src = p.in[14] + (size_t)i * 2048 * EVEN_IN; dst = (bfu*)(p.ws + WS_WT_IN_E) + (size_t)i * EVEN_PAD * 2048; K = 2048; N = EVEN_IN; }
      else if ((r -= 2976) < 1024) { src = p.in[15] + (size_t)i * 2048 * 2048; dst = (bfu*)(p.ws + WS_WT_OUT_E) + (size_t)i * 2048 * 2048; K = 2048; N = 2048; }
      else if ((r -= 1024) < 192) { src = p.in[18] + (size_t)i * 512 * 1536; dst = (bfu*)(p.ws + WS_WT_UQ) + (size_t)i * 1536 * 512; K = 512; N = 1536; }
      else if ((r -= 192) < 128) { src = p.in[20] + (size_t)i * 256 * 2048; dst = (bfu*)(p.ws + WS_WT_UKV) + (size_t)i * 2048 * 256; K = 256; N = 2048; }
      else if ((r -= 128) < 4096) { src = p.in[21] + (size_t)i * 2048 * ODD_IN; dst = (bfu*)(p.ws + WS_WT_IN_O) + (size_t)i * ODD_IN * 2048; K = 2048; N = ODD_IN; }
      else { r -= 4096; src = p.in[22] + (size_t)i * 2048 * 2048; dst = (bfu*)(p.ws + WS_WT_OUT_O) + (size_t)i * 2048 * 2048; K = 2048; N = 2048; }
      int nN = N / 64;
      int kt = r / nN, nt = r % nN;
      prep_transpose_tile(src, dst, K, N, kt * 64, nt * 64, lds, tid);
      continue;
    }
    it -= N_TRP;
    {
      size_t ch = (size_t)it * 4096;
      const float* src; bfu* dst;
      if (ch < 1048576) { src = p.in[2]; dst = (bfu*)(p.ws + WS_C_NAK); }
      else if ((ch -= 1048576) < 1048576) { src = p.in[3]; dst = (bfu*)(p.ws + WS_C_NAV); }
      else if ((ch -= 1048576) < 2097152) { src = p.in[6]; dst = (bfu*)(p.ws + WS_C_DK); }
      else { ch -= 2097152; src = p.in[7]; dst = (bfu*)(p.ws + WS_C_DV); }
#pragma unroll
      for (int u = 0; u < 8; ++u) {
        size_t c = ch + u * 512 + tid;
        f32x4 a = *(const f32x4*)(src + c * 8), b = *(const f32x4*)(src + c * 8 + 4);
        u32x4 w = {cvtpk(a[0], a[1]), cvtpk(a[2], a[3]), cvtpk(b[0], b[1]), cvtpk(b[2], b[3])};
        *(u32x4*)(dst + c * 8) = w;
      }
    }
  }
}

DI void phase_rows(const Params& p, int kind, int l, char* lds) {
  float* vA = (float*)lds; float* vSH = vA + 2048; float* vG = vSH + 2048;
  const int tid = opaque(threadIdx.x), lane = tid & 63, wid = tid >> 6;
  const int rows_per = ((T / 8 + gridDim.x - 1) / gridDim.x) * 8;
  const int t_begin = blockIdx.x * rows_per;
  const int t_end = min(T, t_begin + rows_per);
  const int ln = kind == 0 ? 0 : l + 1;
  const bool do_h = ln < 4;
  int cur_r = -1;
  bfu* hbuf = (bfu*)(p.ws + WS_HBUF);
  const bfu* ybuf = (const bfu*)(p.ws + WS_YBUF);
  for (int base = t_begin; base < t_end; base += 8) {
    const int r = base < TP ? 8 : (base - TP) >> 11;
    if (r != cur_r) {
      cur_r = r;
      __syncthreads();
#pragma unroll
      for (int e = 0; e < 4; ++e) {
        const int col = tid * 4 + e;
        if (do_h) {
          vSH[col] = modval(p, ln, r, col);
          vA[col] = (1.f + modval(p, ln, r, 2048 + col)) * p.in[12][ln * 2048 + col];
        }
        if (kind == 1) vG[col] = modval(p, l, r, 4096 + col) * p.in[13][l * 2048 + col];
      }
      __syncthreads();
    }
    const int t = base + wid;
    if (t < t_end) {
      const float* xin = (kind == 0 || l == 0) ? (t < TP ? p.in[0] + (size_t)t * D : p.in[1] + (size_t)(t - TP) * D) : p.out + (size_t)t * D;
      f32x4 x[8];
#pragma unroll
      for (int i = 0; i < 8; ++i) x[i] = *(const f32x4*)(xin + i * 256 + lane * 4);
      if (kind == 1) {
        f32x4 y[8];
#pragma unroll
        for (int i = 0; i < 8; ++i) {
          u32x2 w = *(const u32x2*)(ybuf + (size_t)t * D + i * 256 + lane * 4);
          y[i][0] = bflo(w[0]); y[i][1] = bfhi(w[0]); y[i][2] = bflo(w[1]); y[i][3] = bfhi(w[1]);
        }
        float ss = 0.f;
#pragma unroll
        for (int i = 0; i < 8; ++i) ss += y[i][0] * y[i][0] + y[i][1] * y[i][1] + y[i][2] * y[i][2] + y[i][3] * y[i][3];
        ss = wave_sum(ss);
        const float rstd = rsqrtf(ss * (1.f / 2048.f) + EPS);
#pragma unroll
        for (int i = 0; i < 8; ++i) {
          f32x4 g = *(const f32x4*)(vG + i * 256 + lane * 4);
          x[i][0] += g[0] * (y[i][0] * rstd); x[i][1] += g[1] * (y[i][1] * rstd);
          x[i][2] += g[2] * (y[i][2] * rstd); x[i][3] += g[3] * (y[i][3] * rstd);
          *(f32x4*)(p.out + (size_t)t * D + i * 256 + lane * 4) = x[i];
        }
      }
      if (do_h) {
        float ss = 0.f;
#pragma unroll
        for (int i = 0; i < 8; ++i) ss += x[i][0] * x[i][0] + x[i][1] * x[i][1] + x[i][2] * x[i][2] + x[i][3] * x[i][3];
        ss = wave_sum(ss);
        const float rstd = rsqrtf(ss * (1.f / 2048.f) + EPS);
#pragma unroll
        for (int i = 0; i < 8; ++i) {
          f32x4 a = *(const f32x4*)(vA + i * 256 + lane * 4), s = *(const f32x4*)(vSH + i * 256 + lane * 4);
          u32x2 w = {cvtpk(x[i][0] * rstd * a[0] + s[0], x[i][1] * rstd * a[1] + s[1]), cvtpk(x[i][2] * rstd * a[2] + s[2], x[i][3] * rstd * a[3] + s[3])};
          *(u32x2*)(hbuf + (size_t)t * D + i * 256 + lane * 4) = w;
        }
      }
    }
  }
}

constexpr int GBM = 256, GBK = 64, GHALF = 128, GHT = GHALF * GBK;
enum { EPI_E1 = 0, EPI_O1 = 1, EPI_QM = 2, EPI_KV = 3, EPI_Y = 4 };

DI int lds_byte(int r, int c) {
  int st = (r >> 4) * 2 + (c >> 5), rr = r & 15, cc = c & 31, ob = rr * 64 + cc * 2;
  return st * 1024 + (ob ^ (((ob >> 9) & 1) << 5));
}
DI void stage_rc(int b, int& R, int& C) {
  int st = b / 1024, sb = b % 1024, swz = sb ^ (((sb >> 9) & 1) << 5);
  R = (st >> 1) * 16 + swz / 64; C = (st & 1) * 32 + (swz % 64) / 2;
}

template <int EPI>
DI void gemm256(const Params& p, const bfu* __restrict__ A, const bfu* __restrict__ Bt, const int K, const int brow, const int bcol,
                const int li, char* lds) {
  const int tid = opaque(threadIdx.x);
  bfu* shm = (bfu*)lds;
#define SA(b, h) (shm + ((b) * 2 + (h)) * GHT)
#define SB(b, h) (shm + (4 + (b) * 2 + (h)) * GHT)
#define STAGE(P_, BASE, br, kt) do { long _g = (long)(br) * K + (long)(kt) * GBK;                          \
    for (int _i = 0; _i < 2; ++_i) { int _b = tid * 16 + _i * 8192; int _r, _c; stage_rc(_b, _r, _c);      \
      __builtin_amdgcn_global_load_lds((const unsigned*)(BASE + _g + (long)_r * K + _c),                    \
        (__attribute__((address_space(3))) unsigned*)((char*)(P_) + _b), 16, 0, 0); } } while (0)
#define LDA(dst, b, h) for (int m = 0; m < 4; ++m) for (int k = 0; k < 2; ++k)                              \
    dst[m][k] = *reinterpret_cast<const bf16x8*>((char*)SA(b, h) + lds_byte(wr * 64 + m * 16 + fr, k * 32 + fq * 8))
#define LDB(dst, b, h) for (int n = 0; n < 2; ++n) for (int k = 0; k < 2; ++k)                              \
    dst[n][k] = *reinterpret_cast<const bf16x8*>((char*)SB(b, h) + lds_byte(wc * 32 + n * 16 + fr, k * 32 + fq * 8))
#define MMA(ai, bj, At_, Bt_) do { __builtin_amdgcn_s_setprio(1);                                            \
    for (int m = 0; m < 4; ++m) for (int n = 0; n < 2; ++n) for (int k = 0; k < 2; ++k)                      \
      acc[ai][bj][m][n] = __builtin_amdgcn_mfma_f32_16x16x32_bf16(At_[m][k], Bt_[n][k], acc[ai][bj][m][n], 0, 0, 0); \
    __builtin_amdgcn_s_setprio(0); } while (0)
#define WAIT_V(n) asm volatile("s_waitcnt vmcnt(" #n ")" ::: "memory")
#define WAIT_L(n) asm volatile("s_waitcnt lgkmcnt(" #n ")" ::: "memory")
#define BAR __builtin_amdgcn_s_barrier()
#define SCHED __builtin_amdgcn_sched_barrier(0)
  const int wid = tid >> 6, lane = tid & 63, wr = wid >> 2, wc = wid & 3, fr = lane & 15, fq = lane >> 4;
  f32x4 acc[2][2][4][2];
#pragma unroll
  for (int a_ = 0; a_ < 2; ++a_)
#pragma unroll
    for (int b_ = 0; b_ < 2; ++b_)
#pragma unroll
      for (int m = 0; m < 4; ++m)
#pragma unroll
        for (int n = 0; n < 2; ++n) { acc[a_][b_][m][n][0] = 0.f; acc[a_][b_][m][n][1] = 0.f; acc[a_][b_][m][n][2] = 0.f; acc[a_][b_][m][n][3] = 0.f; }
  bf16x8 At[4][2], B0[2][2], B1[2][2];
  const int nt = K / GBK;
  WAIT_V(0); BAR;
  STAGE(SB(0, 0), Bt, bcol, 0); STAGE(SA(0, 0), A, brow, 0);
  STAGE(SB(0, 1), Bt, bcol + GHALF, 0); STAGE(SA(0, 1), A, brow + GHALF, 0);
  if (wr == 1) BAR;
  WAIT_V(4); BAR;
  STAGE(SB(1, 0), Bt, bcol, 1); STAGE(SA(1, 0), A, brow, 1); STAGE(SB(1, 1), Bt, bcol + GHALF, 1);
  WAIT_V(6); BAR;
  for (int t = 0; t < nt - 2; t += 2) {
    LDB(B0, 0, 0); SCHED; LDA(At, 0, 0); STAGE(SA(1, 1), A, brow + GHALF, t + 1);
    WAIT_L(8); BAR; WAIT_L(0); MMA(0, 0, At, B0); BAR; SCHED;
    LDB(B1, 0, 1); STAGE(SB(0, 0), Bt, bcol, t + 2);
    BAR; WAIT_L(0); MMA(0, 1, At, B1); BAR;
    LDA(At, 0, 1); STAGE(SA(0, 0), A, brow, t + 2);
    BAR; WAIT_L(0); MMA(1, 0, At, B0); BAR; SCHED;
    STAGE(SB(0, 1), Bt, bcol + GHALF, t + 2);
    WAIT_V(6); BAR; MMA(1, 1, At, B1); BAR;
    LDB(B0, 1, 0); SCHED; LDA(At, 1, 0); STAGE(SA(0, 1), A, brow + GHALF, t + 2);
    WAIT_L(8); BAR; WAIT_L(0); MMA(0, 0, At, B0); BAR; SCHED;
    LDB(B1, 1, 1); STAGE(SB(1, 0), Bt, bcol, t + 3);
    BAR; WAIT_L(0); MMA(0, 1, At, B1); BAR;
    LDA(At, 1, 1); STAGE(SA(1, 0), A, brow, t + 3);
    BAR; WAIT_L(0); MMA(1, 0, At, B0); BAR; SCHED;
    STAGE(SB(1, 1), Bt, bcol + GHALF, t + 3);
    WAIT_V(6); BAR; MMA(1, 1, At, B1); BAR;
  }
  { LDB(B0, 0, 0); LDA(At, 0, 0); STAGE(SA(1, 1), A, brow + GHALF, nt - 1);
    BAR; WAIT_L(0); MMA(0, 0, At, B0); BAR;
    LDB(B1, 0, 1); BAR; WAIT_L(0); MMA(0, 1, At, B1); BAR;
    LDA(At, 0, 1); WAIT_V(4); BAR; WAIT_L(0); MMA(1, 0, At, B0); MMA(1, 1, At, B1); BAR; }
  { LDB(B0, 1, 0); LDA(At, 1, 0); WAIT_V(2); BAR; WAIT_L(0); MMA(0, 0, At, B0); BAR;
    LDB(B1, 1, 1); WAIT_V(0); BAR; WAIT_L(0); MMA(0, 1, At, B1); BAR;
    LDA(At, 1, 1); BAR; WAIT_L(0); MMA(1, 0, At, B0); MMA(1, 1, At, B1); BAR; }
  if (wr == 0) BAR;
#undef SA
#undef SB
#undef STAGE
#undef LDA
#undef LDB
#undef MMA
#undef WAIT_V
#undef WAIT_L
#undef BAR
#undef SCHED

  const int jr = (wc & 1) * 16 + fr;
  if constexpr (EPI == EPI_O1) {
    if (brow >= TP && bcol < 4096) {
      const float inv = exp2f(-(float)jr * (LOG2_ROPE / 32.f));
      const bool colrope = (wc >> 1) & 1;
#pragma unroll
      for (int ai = 0; ai < 2; ++ai)
#pragma unroll
        for (int m = 0; m < 4; ++m)
#pragma unroll
          for (int j = 0; j < 4; ++j) {
            int row = brow + ai * 128 + wr * 64 + m * 16 + fq * 4 + j;
            int s = (row - TP) & 2047;
            float ang = (float)(colrope ? (s & 63) : (s >> 6)) * inv;
            float cs = __cosf(ang), sn = __sinf(ang);
#pragma unroll
            for (int bj = 0; bj < 2; ++bj) {
              float x1 = acc[ai][bj][m][0][j], x2 = acc[ai][bj][m][1][j];
              acc[ai][bj][m][0][j] = x1 * cs - x2 * sn;
              acc[ai][bj][m][1][j] = x2 * cs + x1 * sn;
            }
          }
    }
  }
  if constexpr (EPI == EPI_E1 || EPI == EPI_O1) {
    if (brow < TP) {
#pragma unroll
      for (int ai = 0; ai < 2; ++ai)
#pragma unroll
        for (int bj = 0; bj < 2; ++bj)
#pragma unroll
          for (int n = 0; n < 2; ++n) {
            const int colg = bcol + bj * 128 + (wc >> 1) * 64 + n * 32 + (wc & 1) * 16;
            const int col = colg + fr;
            float* dst = nullptr; int ldo = 0, c0 = 0;
            if constexpr (EPI == EPI_E1) {
              if (colg >= 1024 && colg < 2048) { dst = p.out + OUT_NAK; ldo = 1024; c0 = 1024; }
              else if (colg >= 2048 && colg < 3072) { dst = p.out + OUT_NAV; ldo = 1024; c0 = 2048; }
              else if (colg >= 4864 && colg < 4928) { dst = p.out + OUT_KPE; ldo = 64; c0 = 4864; }
            } else {
              if (colg >= 2048 && colg < 4096) { dst = p.out + OUT_DK; ldo = 2048; c0 = 2048; }
              else if (colg >= 4096 && colg < 6144) { dst = p.out + OUT_DV; ldo = 2048; c0 = 4096; }
            }
            if (dst) {
#pragma unroll
              for (int m = 0; m < 4; ++m)
#pragma unroll
                for (int j = 0; j < 4; ++j) {
                  const int row = brow + ai * 128 + wr * 64 + m * 16 + fq * 4 + j;
                  size_t orow = (size_t)((row >> 8) * 2 + li) * 256 + (row & 255);
                  dst[orow * ldo + (col - c0)] = acc[ai][bj][m][n][j];
                }
            }
          }
    }
  }
  constexpr int CT_ROW = 528;
#pragma unroll
  for (int ai = 0; ai < 2; ++ai)
#pragma unroll
    for (int bj = 0; bj < 2; ++bj)
#pragma unroll
      for (int n = 0; n < 2; ++n) {
        const int cl = bj * 128 + (wc >> 1) * 64 + n * 32 + (wc & 1) * 16 + fr;
#pragma unroll
        for (int m = 0; m < 4; ++m)
#pragma unroll
          for (int j = 0; j < 4; ++j) {
            const int rl = ai * 128 + wr * 64 + m * 16 + fq * 4 + j;
            *(bfu*)(lds + rl * CT_ROW + cl * 2) = f2bf(acc[ai][bj][m][n][j]);
          }
      }
  __syncthreads();
#pragma unroll 4
  for (int i = 0; i < 16; ++i) {
    const int c = tid + 512 * i, rl = c >> 5, cc = c & 31;
    const u32x4 w = *(const u32x4*)(lds + rl * CT_ROW + cc * 16);
    const size_t row = (size_t)(brow + rl);
    const int col = bcol + cc * 8;
    if constexpr (EPI == EPI_E1) {
      if (col < EVEN_IN) *(u32x4*)((bfu*)(p.ws + WS_PBUF) + row * EVEN_IN + col) = w;
    } else if constexpr (EPI == EPI_O1) {
      *(u32x4*)((bfu*)(p.ws + WS_PBUF) + row * ODD_IN + col) = w;
    } else if constexpr (EPI == EPI_QM) {
      *(u32x4*)((bfu*)(p.ws + WS_QM) + row * 1536 + col) = w;
    } else if constexpr (EPI == EPI_KV) {
      const int hd = col >> 8, jj = col & 255;
      if (jj < 128) *(u32x4*)((bfu*)(p.ws + WS_KMLA) + row * 1536 + hd * 192 + jj) = w;
      else *(u32x4*)((bfu*)(p.ws + WS_VMLA) + row * 1024 + hd * 128 + (jj - 128)) = w;
    } else {
      *(u32x4*)((bfu*)(p.ws + WS_YBUF) + row * D + col) = w;
    }
  }
}

DI int tile_id(int it) {
  const int G = gridDim.x;
  const int pb = (G & 7) == 0 ? (blockIdx.x & 7) * (G >> 3) + (blockIdx.x >> 3) : blockIdx.x;
  return it * G + pb;
}
DI void tile_mn(int id, int nN, int& m, int& n) {
  int grp = id / (8 * nN), rem = id % (8 * nN);
  m = grp * 8 + (rem & 7); n = rem >> 3;
}

DI void phase_mid(const Params& p, int li) {
  const int tid = opaque(threadIdx.x), lane = tid & 63, wid = tid >> 6;
  const bfu* P = (const bfu*)(p.ws + WS_PBUF);
  bfu* cqn = (bfu*)(p.ws + WS_CQN);
  bfu* ckvn = (bfu*)(p.ws + WS_CKVN);
  bfu* kmla = (bfu*)(p.ws + WS_KMLA);
  const float* gq = p.in[17] + li * 512;
  const float* gkv = p.in[19] + li * 256;
  for (int t = blockIdx.x * 8 + wid; t < TALL; t += gridDim.x * 8) {
    float kp;
    if (t < T) {
      const bfu* Pr = P + (size_t)t * EVEN_IN;
      {
        u32x4 w = *(const u32x4*)(Pr + 4096 + lane * 8);
        float v[8] = {bflo(w[0]), bfhi(w[0]), bflo(w[1]), bfhi(w[1]), bflo(w[2]), bfhi(w[2]), bflo(w[3]), bfhi(w[3])};
        float ss = 0;
#pragma unroll
        for (int e = 0; e < 8; ++e) ss += v[e] * v[e];
        ss = wave_sum(ss);
        float rstd = rsqrtf(ss * (1.f / 512.f) + EPS);
#pragma unroll
        for (int e = 0; e < 8; ++e) v[e] = v[e] * rstd * gq[lane * 8 + e];
        u32x4 o = {cvtpk(v[0], v[1]), cvtpk(v[2], v[3]), cvtpk(v[4], v[5]), cvtpk(v[6], v[7])};
        *(u32x4*)(cqn + (size_t)t * 512 + lane * 8) = o;
      }
      {
        u32x2 w = *(const u32x2*)(Pr + 4608 + lane * 4);
        float v[4] = {bflo(w[0]), bfhi(w[0]), bflo(w[1]), bfhi(w[1])};
        float ss = v[0] * v[0] + v[1] * v[1] + v[2] * v[2] + v[3] * v[3];
        ss = wave_sum(ss);
        float rstd = rsqrtf(ss * (1.f / 256.f) + EPS);
#pragma unroll
        for (int e = 0; e < 4; ++e) v[e] = v[e] * rstd * gkv[lane * 4 + e];
        u32x2 o = {cvtpk(v[0], v[1]), cvtpk(v[2], v[3])};
        *(u32x2*)(ckvn + (size_t)t * 256 + lane * 4) = o;
        if (t < TP) {
          size_t orow = (size_t)((t >> 8) * 2 + li) * 256 + (t & 255);
          f32x4 f = {v[0], v[1], v[2], v[3]};
          *(f32x4*)(p.out + OUT_CKV + orow * 256 + lane * 4) = f;
        }
      }
      kp = bf2f(Pr[4864 + lane]);
      if (t >= TP) {
        int s = (t - TP) & 2047;
        float pos = (float)(lane < 32 ? (s >> 6) : (s & 63));
        int jj = lane & 15;
        float inv = exp2f(-(float)jj * (LOG2_ROPE / 16.f));
        float ang = pos * inv;
        float cs = __cosf(ang), sn = __sinf(ang);
        float pv = __shfl_xor(kp, 16);
        kp = (lane & 16) ? (kp * cs + pv * sn) : (kp * cs - pv * sn);
      }
    } else {
      int ci = t - T;
      int b = ci >> 9, j = ci & 511;
      size_t crow_ = (size_t)(b * 2 + li) * 512 + j;
      f32x4 f = *(const f32x4*)(p.in[4] + crow_ * 256 + lane * 4);
      u32x2 o = {cvtpk(f[0], f[1]), cvtpk(f[2], f[3])};
      *(u32x2*)(ckvn + (size_t)t * 256 + lane * 4) = o;
      kp = p.in[5][crow_ * 64 + lane];
    }
    bfu kb = f2bf(kp);
#pragma unroll
    for (int hd = 0; hd < 8; ++hd) kmla[(size_t)t * 1536 + hd * 192 + 128 + lane] = kb;
  }
}

struct Seg { const bfu* K; const bfu* V; int ldk, ldv, n; };
constexpr int ATT_KB = 24576, ATT_VB = 16384, ATT_BUF = ATT_KB + ATT_VB;
constexpr int ATT_BIAS_OFF = 3 * ATT_BUF;
constexpr int ATT_TR_ROW = 132;

template <int DQK>
DI void attn_issue(const int tid, const bfu* __restrict__ Kp, const bfu* __restrict__ Vp, int ldk, int ldv, char* buf) {
  constexpr int KROWB = DQK * 2;
#pragma unroll
  for (int i = 0; i < DQK / 64; ++i) {
    int bb = i * 8192 + tid * 16, row = bb / KROWB, cpos = (bb % KROWB) >> 4, c = cpos ^ (row & 7);
    __builtin_amdgcn_global_load_lds((const unsigned*)(Kp + (size_t)row * ldk + c * 8),
                                     (__attribute__((address_space(3))) unsigned*)(buf + bb), 16, 0, 0);
  }
#pragma unroll
  for (int i = 0; i < 2; ++i) {
    int bb = i * 8192 + tid * 16, row = bb >> 8, cpos = (bb & 255) >> 4, c = cpos ^ ((row & 3) << 2);
    __builtin_amdgcn_global_load_lds((const unsigned*)(Vp + (size_t)row * ldv + c * 8),
                                     (__attribute__((address_space(3))) unsigned*)(buf + ATT_KB + bb), 16, 0, 0);
  }
}

template <int DQK, bool NA, bool ROPEQ>
DI void attn_core(const int tid, f32x16* o, const bfu* __restrict__ Qrow, const Seg& s0, const Seg& s1, float C, char* lds,
                  int gr, int gc, int kr0, float prow, float pcol) {
  constexpr int KROWB = DQK * 2;
  constexpr int ND = DQK / 16;
  const int lane = tid & 63, r32 = lane & 31, hh = lane >> 5;
  const bool lag = __builtin_amdgcn_readfirstlane(tid >> 8) != 0;
  const float* sbias = (const float*)(lds + ATT_BIAS_OFF);
  const int nt0 = s0.n >> 6, ntile = nt0 + (s1.n >> 6);
  auto issue_tile = [&](int jt, int slot) {
    const bool in0 = jt < nt0;
    const bfu* Kp = in0 ? s0.K + (size_t)(jt * 64) * s0.ldk : s1.K + (size_t)((jt - nt0) * 64) * s1.ldk;
    const bfu* Vp = in0 ? s0.V + (size_t)(jt * 64) * s0.ldv : s1.V + (size_t)((jt - nt0) * 64) * s1.ldv;
    attn_issue<DQK>(tid, Kp, Vp, in0 ? s0.ldk : s1.ldk, in0 ? s0.ldv : s1.ldv, lds + slot * ATT_BUF);
  };
  __syncthreads();
  issue_tile(0, 0);
  bf16x8 qr[ND];
#pragma unroll
  for (int d0 = 0; d0 < ND; ++d0) qr[d0] = *(const bf16x8*)(Qrow + d0 * 16);
  if constexpr (ROPEQ) {
#pragma unroll
    for (int pr = 0; pr < 2; ++pr) {
      float pos = pr == 0 ? prow : pcol;
      bf16x8 a = qr[8 + 2 * pr], b = qr[9 + 2 * pr];
      float xa[8], xb[8];
#pragma unroll
      for (int e = 0; e < 8; ++e) {
        float inv = exp2f(-(float)(8 * hh + e) * (LOG2_ROPE / 16.f));
        float ang = pos * inv;
        float cs = __cosf(ang), sn = __sinf(ang);
        float x1 = bf2f((bfu)a[e]), x2 = bf2f((bfu)b[e]);
        xa[e] = x1 * cs - x2 * sn; xb[e] = x2 * cs + x1 * sn;
      }
      u32x4 wa = {cvtpk(xa[0], xa[1]), cvtpk(xa[2], xa[3]), cvtpk(xa[4], xa[5]), cvtpk(xa[6], xa[7])};
      u32x4 wb = {cvtpk(xb[0], xb[1]), cvtpk(xb[2], xb[3]), cvtpk(xb[4], xb[5]), cvtpk(xb[6], xb[7])};
      qr[8 + 2 * pr] = __builtin_bit_cast(bf16x8, wa); qr[9 + 2 * pr] = __builtin_bit_cast(bf16x8, wb);
    }
  }
#pragma unroll
  for (int d = 0; d < 4; ++d)
#pragma unroll
    for (int r = 0; r < 16; ++r) o[d][r] = 0.f;
  float m = -1e30f, l = 0.f;
  const int rs = min(max(gr - 4, 0), 24), cs_ = min(max(gc - 8, 0), 48);
  int kad[4];
#pragma unroll
  for (int q = 0; q < 4; ++q) kad[q] = r32 * KROWB + (((q * 2 + hh) ^ (r32 & 7)) << 4);
  const int q_ = (lane & 15) >> 2;
  int vad[4];
#pragma unroll
  for (int d = 0; d < 4; ++d) vad[d] = ATT_KB + (hh * 4 + q_) * 256 + ((d ^ q_) << 6) + (16 * ((lane >> 4) & 1) + 4 * (lane & 3)) * 2;

  auto qk_sm = [&](bf16x8* pa, const char* buf, const int j) {
    f32x16 p0, p1;
#pragma unroll
    for (int r = 0; r < 16; ++r) { p0[r] = 0.f; p1[r] = 0.f; }
#pragma unroll
    for (int hb = 0; hb < ND; hb += 4) {
      bf16x8 k0[4], k1[4];
#pragma unroll
      for (int d = 0; d < 4; ++d) {
        k0[d] = *(const bf16x8*)(buf + kad[d] + (hb >> 2) * 128);
        k1[d] = *(const bf16x8*)(buf + kad[d] + (hb >> 2) * 128 + 32 * KROWB);
      }
      __builtin_amdgcn_sched_barrier(0);
#pragma unroll
      for (int d = 0; d < 4; ++d) {
        p0 = mfma(k0[d], qr[hb + d], p0);
        p1 = mfma(k1[d], qr[hb + d], p1);
      }
      __builtin_amdgcn_sched_barrier(0);
    }
    float mx;
    if (NA && j >= nt0) {
      const int kr = kr0 + (j - nt0);
      const bool rowok = (kr >= rs) && (kr < rs + 8);
      const int brow = (kr - gr + 7) * 31 - gc + 15;
#pragma unroll
      for (int r = 0; r < 16; ++r) {
        int kc0 = crow(r, hh), kc1 = 32 + kc0;
        bool ok0 = rowok && (kc0 >= cs_) && (kc0 < cs_ + 16);
        bool ok1 = rowok && (kc1 >= cs_) && (kc1 < cs_ + 16);
        float b0 = sbias[ok0 ? brow + kc0 : 0], b1 = sbias[ok1 ? brow + kc1 : 0];
        p0[r] = ok0 ? p0[r] * C + b0 : -1e30f;
        p1[r] = ok1 ? p1[r] * C + b1 : -1e30f;
      }
      mx = p0[0];
#pragma unroll
      for (int r = 1; r < 16; ++r) mx = fmaxf(mx, p0[r]);
#pragma unroll
      for (int r = 0; r < 16; ++r) mx = fmaxf(mx, p1[r]);
      mx = fmaxf(mx, xor32(mx));
    } else {
      mx = p0[0];
#pragma unroll
      for (int r = 1; r < 16; ++r) mx = fmaxf(mx, p0[r]);
#pragma unroll
      for (int r = 0; r < 16; ++r) mx = fmaxf(mx, p1[r]);
      mx = fmaxf(mx, xor32(mx)) * C;
    }
    const float mn = fmaxf(m, mx);
    const float alpha = __builtin_amdgcn_exp2f(m - mn);
    m = mn;
    f2_t ps2 = {0.f, 0.f};
    if (NA && j >= nt0) {
#pragma unroll
      for (int r = 0; r < 16; r += 2) {
        p0[r] = __builtin_amdgcn_exp2f(p0[r] - mn); p0[r + 1] = __builtin_amdgcn_exp2f(p0[r + 1] - mn);
        p1[r] = __builtin_amdgcn_exp2f(p1[r] - mn); p1[r + 1] = __builtin_amdgcn_exp2f(p1[r + 1] - mn);
        f2_t a = {p0[r], p0[r + 1]}, b = {p1[r], p1[r + 1]};
        ps2 += a; ps2 += b;
      }
    } else {
      const f2_t c2 = {C, C}, nm2 = {-mn, -mn};
#pragma unroll
      for (int r = 0; r < 16; r += 2) {
        f2_t a = {p0[r], p0[r + 1]}, b = {p1[r], p1[r + 1]};
        a = a * c2 + nm2; b = b * c2 + nm2;
        p0[r] = __builtin_amdgcn_exp2f(a[0]); p0[r + 1] = __builtin_amdgcn_exp2f(a[1]);
        p1[r] = __builtin_amdgcn_exp2f(b[0]); p1[r + 1] = __builtin_amdgcn_exp2f(b[1]);
        f2_t ea = {p0[r], p0[r + 1]}, eb = {p1[r], p1[r + 1]};
        ps2 += ea; ps2 += eb;
      }
    }
    float ps = ps2[0] + ps2[1];
    ps += xor32(ps);
    l = l * alpha + ps;
    if (__any(alpha != 1.f)) {
#pragma unroll
      for (int d = 0; d < 4; ++d)
#pragma unroll
        for (int r = 0; r < 16; ++r) o[d][r] *= alpha;
    }
    u32x4 w0 = {cvtpk(p0[0], p0[1]), cvtpk(p0[2], p0[3]), cvtpk(p0[4], p0[5]), cvtpk(p0[6], p0[7])};
    u32x4 w1 = {cvtpk(p0[8], p0[9]), cvtpk(p0[10], p0[11]), cvtpk(p0[12], p0[13]), cvtpk(p0[14], p0[15])};
    u32x4 w2 = {cvtpk(p1[0], p1[1]), cvtpk(p1[2], p1[3]), cvtpk(p1[4], p1[5]), cvtpk(p1[6], p1[7])};
    u32x4 w3 = {cvtpk(p1[8], p1[9]), cvtpk(p1[10], p1[11]), cvtpk(p1[12], p1[13]), cvtpk(p1[14], p1[15])};
    pa[0] = __builtin_bit_cast(bf16x8, w0); pa[1] = __builtin_bit_cast(bf16x8, w1);
    pa[2] = __builtin_bit_cast(bf16x8, w2); pa[3] = __builtin_bit_cast(bf16x8, w3);
  };
  auto pv = [&](const bf16x8* pa, const char* buf) {
#pragma unroll
    for (int d = 0; d < 4; ++d) {
      s16x4 lo[4], hi[4];
#pragma unroll
      for (int s = 0; s < 4; ++s) {
        lo[s] = __builtin_amdgcn_ds_read_tr16_b64_v4i16((s16x4 __attribute__((address_space(3)))*)(buf + vad[d] + (16 * s) * 256));
        hi[s] = __builtin_amdgcn_ds_read_tr16_b64_v4i16((s16x4 __attribute__((address_space(3)))*)(buf + vad[d] + (16 * s + 8) * 256));
      }
#pragma unroll
      for (int s = 0; s < 4; ++s) {
        bf16x8 vb = {lo[s][0], lo[s][1], lo[s][2], lo[s][3], hi[s][0], hi[s][1], hi[s][2], hi[s][3]};
        o[d] = mfma(vb, pa[s], o[d]);
      }
    }
  };

  if (!lag) {
    int sl = 0;
    for (int j = 0; j <= ntile; ++j) {
      asm volatile("s_waitcnt vmcnt(0)" ::: "memory");
      __builtin_amdgcn_s_barrier();
      const int sn = sl == 2 ? 0 : sl + 1;
      if (j + 1 < ntile) issue_tile(j + 1, sn);
      if (j < ntile) { bf16x8 pa[4]; qk_sm(pa, lds + sl * ATT_BUF, j); pv(pa, lds + sl * ATT_BUF); }
      sl = sn;
    }
  } else {
    bf16x8 pa[4];
    int sl = 0;
    for (int j = 0; j <= ntile; ++j) {
      asm volatile("s_waitcnt vmcnt(0)" ::: "memory");
      __builtin_amdgcn_s_barrier();
      const int sn = sl == 2 ? 0 : sl + 1, sp = sl == 0 ? 2 : sl - 1;
      if (j + 1 < ntile) issue_tile(j + 1, sn);
      if (j > 0) pv(pa, lds + sp * ATT_BUF);
      if (j < ntile) qk_sm(pa, lds + sl * ATT_BUF, j);
      sl = sn;
    }
  }
  const float linv = 1.f / l;
#pragma unroll
  for (int d = 0; d < 4; ++d)
#pragma unroll
    for (int r = 0; r < 16; ++r) o[d][r] *= linv;
}

DI float* tr_stage(const int tid, const f32x16* o, char* lds) {
  const int lane = tid & 63, wid = tid >> 6, r32 = lane & 31, hh = lane >> 5;
  float* tr = (float*)lds + wid * (32 * ATT_TR_ROW);
  __syncthreads();
#pragma unroll
  for (int d = 0; d < 4; ++d)
#pragma unroll
    for (int g = 0; g < 4; ++g) {
      f32x4 v = {o[d][4 * g], o[d][4 * g + 1], o[d][4 * g + 2], o[d][4 * g + 3]};
      *(f32x4*)(tr + r32 * ATT_TR_ROW + d * 32 + 8 * g + 4 * hh) = v;
    }
  return tr;
}

DI void store_gated(const int tid, const Params& p, const f32x16* o, int t0, int gcol, int ocol, char* lds) {
  const int lane = tid & 63, wid = tid >> 6;
  const bfu* P = (const bfu*)(p.ws + WS_PBUF);
  bfu* O = (bfu*)(p.ws + WS_HBUF);
  const float* tr = tr_stage(tid, o, lds);
#pragma unroll 1
  for (int r0 = 0; r0 < 32; r0 += 8) {
    unsigned g[8];
#pragma unroll
    for (int u = 0; u < 8; ++u) g[u] = *(const unsigned*)(P + (size_t)(t0 + wid * 32 + r0 + u) * EVEN_IN + gcol + lane * 2);
#pragma unroll
    for (int u = 0; u < 8; ++u) {
      f2_t v = *(const f2_t*)(tr + (r0 + u) * ATT_TR_ROW + lane * 2);
      *(unsigned*)(O + (size_t)(t0 + wid * 32 + r0 + u) * D + ocol + lane * 2) = cvtpk(v[0] * silu(bflo(g[u])), v[1] * silu(bfhi(g[u])));
    }
  }
}

DI int xcd_item(int item) {
  if (gridDim.x != 256) return item;
  const int blk = item & 255, sweep = item >> 8;
  const int xcd = blk & 7, slot = blk >> 3, gl = slot >> 3, qb = slot & 7;
  return sweep * 256 + ((gl * 8 + xcd) << 3) + qb;
}

DI void phase_attn_even(const Params& p, int li, char* lds) {
  const bfu* P = (const bfu*)(p.ws + WS_PBUF);
  const bfu* Qm = (const bfu*)(p.ws + WS_QM);
  const bfu* Km = (const bfu*)(p.ws + WS_KMLA);
  const bfu* Vm = (const bfu*)(p.ws + WS_VMLA);
  const bfu* cnk = (const bfu*)(p.ws + WS_C_NAK);
  const bfu* cnv = (const bfu*)(p.ws + WS_C_NAV);
  const float CM = 0.07216878364870322f * LOG2E;
  const float CN = 0.08838834764831845f * LOG2E;
  int item = blockIdx.x;
  for (; item < 512; item += gridDim.x) {
    const int tid = opaque(threadIdx.x), lane = tid & 63, wid = tid >> 6, r32 = lane & 31, hh = lane >> 5;
    f32x16 o[4];
    const int xi = xcd_item(item);
    int b = xi >> 6, hd = (xi >> 3) & 7, qb = xi & 7;
    int t0 = TP + b * 2048 + qb * 256;
    int trow = t0 + wid * 32 + r32;
    int s = qb * 256 + wid * 32 + r32;
    Seg s0 = {Km + (size_t)(T + b * 512) * 1536 + hd * 192, Vm + (size_t)(T + b * 512) * 1024 + hd * 128, 1536, 1024, 512};
    Seg s1 = {Km + (size_t)(TP + b * 2048) * 1536 + hd * 192, Vm + (size_t)(TP + b * 2048) * 1024 + hd * 128, 1536, 1024, 2048};
    attn_core<192, false, true>(tid, o, Qm + (size_t)trow * 1536 + hd * 192 + hh * 8, s0, s1, CM, lds, 0, 0, 0, (float)(s >> 6), (float)(s & 63));
    store_gated(tid, p, o, t0, 4928 + hd * 128, 1024 + hd * 128, lds);
  }
  for (; item < 1024; item += gridDim.x) {
    const int tid = opaque(threadIdx.x), lane = tid & 63, wid = tid >> 6, r32 = lane & 31, hh = lane >> 5;
    const int it = xcd_item(item - 512);
    f32x16 o[4];
    int b = it >> 6, hd = (it >> 3) & 7, qb = it & 7;
    int t0 = TP + b * 2048 + qb * 256;
    int trow = t0 + wid * 32 + r32;
    int qi = wid * 32 + r32;
    int gr = qb * 4 + (qi >> 6), gc = qi & 63;
    int kr0 = min(max(qb * 4 - 4, 0), 24);
    int kr1 = min(max(qb * 4 + 3 - 4, 0), 24) + 8;
    __syncthreads();
    float* sb = (float*)(lds + ATT_BIAS_OFF);
    for (int idx = tid; idx < 465; idx += 512) sb[idx] = p.in[16][(size_t)(li * 8 + hd) * 465 + idx] * LOG2E;
    Seg s0 = {cnk + (size_t)((b * 2 + li) * 512) * 1024 + hd * 128, cnv + (size_t)((b * 2 + li) * 512) * 1024 + hd * 128, 1024, 1024, 512};
    const bfu* Pl = P + (size_t)(TP + b * 2048 + kr0 * 64) * EVEN_IN;
    Seg s1 = {Pl + 1024 + hd * 128, Pl + 2048 + hd * 128, EVEN_IN, EVEN_IN, (kr1 - kr0) * 64};
    attn_core<128, true, false>(tid, o, P + (size_t)trow * EVEN_IN + hd * 128 + hh * 8, s0, s1, CN, lds, gr, gc, kr0, 0.f, 0.f);
    store_gated(tid, p, o, t0, 3072 + hd * 128, hd * 128, lds);
  }
  for (; item < 1280; item += gridDim.x) {
    const int tid = opaque(threadIdx.x), lane = tid & 63, wid = tid >> 6, r32 = lane & 31, hh = lane >> 5;
    const int it = item - 1024;
    f32x16 o[4];
    int b = it >> 3, hd = it & 7;
    int t0 = b * 256;
    int trow = t0 + wid * 32 + r32;
    Seg s0 = {Km + (size_t)(b * 256) * 1536 + hd * 192, Vm + (size_t)(b * 256) * 1024 + hd * 128, 1536, 1024, 256};
    Seg s1 = {s0.K, s0.V, 1536, 1024, 0};
    attn_core<192, false, false>(tid, o, Qm + (size_t)trow * 1536 + hd * 192 + hh * 8, s0, s1, CM, lds, 0, 0, 0, 0.f, 0.f);
    store_gated(tid, p, o, t0, 4928 + hd * 128, 1024 + hd * 128, lds);
  }
  for (; item < 1536; item += gridDim.x) {
    const int tid = opaque(threadIdx.x), lane = tid & 63, wid = tid >> 6, r32 = lane & 31, hh = lane >> 5;
    const int it = item - 1280;
    f32x16 o[4];
    int b = it >> 3, hd = it & 7;
    int t0 = b * 256;
    int trow = t0 + wid * 32 + r32;
    const bfu* Pb = P + (size_t)(b * 256) * EVEN_IN;
    Seg s0 = {Pb + 1024 + hd * 128, Pb + 2048 + hd * 128, EVEN_IN, EVEN_IN, 256};
    Seg s1 = {s0.K, s0.V, EVEN_IN, EVEN_IN, 0};
    attn_core<128, false, false>(tid, o, P + (size_t)trow * EVEN_IN + hd * 128 + hh * 8, s0, s1, CN, lds, 0, 0, 0, 0.f, 0.f);
    store_gated(tid, p, o, t0, 3072 + hd * 128, hd * 128, lds);
  }
}

DI void phase_attn_odd(const Params& p, int l, char* lds) {
  const int li = l >> 1;
  const bfu* P = (const bfu*)(p.ws + WS_PBUF);
  bfu* O = (bfu*)(p.ws + WS_HBUF);
  const bfu* cdk = (const bfu*)(p.ws + WS_C_DK);
  const bfu* cdv = (const bfu*)(p.ws + WS_C_DV);
  float* scr = (float*)(p.ws + WS_SCR) + (size_t)blockIdx.x * 65536;
  const float CD = 0.08838834764831845f * LOG2E;
  const float lam_init = 0.8f - 0.6f * expf(-0.3f * (float)l);
  float lam;
  {
    const float* lp = p.in[23] + li * 512;
    float s1 = 0.f, s2 = 0.f;
    for (int k = 0; k < 128; ++k) { s1 += lp[k] * lp[128 + k]; s2 += lp[256 + k] * lp[384 + k]; }
    lam = expf(s1) - expf(s2) + lam_init;
  }
  const float* gsub = p.in[24] + li * 256;
  for (int item = blockIdx.x; item < 768; item += gridDim.x) {
    const int tid = opaque(threadIdx.x), lane = tid & 63, wid = tid >> 6, r32 = lane & 31, hh = lane >> 5;
    int b, hd, t0; Seg s0, s1;
    if (item < 512) {
      const int xi = xcd_item(item);
      b = xi >> 6; hd = (xi >> 3) & 7; int qb = xi & 7;
      t0 = TP + b * 2048 + qb * 256;
      const bfu* Pl = P + (size_t)(TP + b * 2048) * ODD_IN;
      s0 = Seg{cdk + (size_t)((b * 2 + li) * 512) * 2048 + hd * 256, cdv + (size_t)((b * 2 + li) * 512) * 2048 + hd * 256, 2048, 2048, 512};
      s1 = Seg{Pl + 2048 + hd * 256, Pl + 4096 + hd * 256, ODD_IN, ODD_IN, 2048};
    } else {
      int it = item - 512;
      b = it >> 3; hd = it & 7;
      t0 = b * 256;
      const bfu* Pb = P + (size_t)(b * 256) * ODD_IN;
      s0 = Seg{Pb + 2048 + hd * 256, Pb + 4096 + hd * 256, ODD_IN, ODD_IN, 256};
      s1 = Seg{s0.K, s0.V, ODD_IN, ODD_IN, 0};
    }
    const int trow = t0 + wid * 32 + r32;
    float ssq = 0.f;
    for (int pass = 0; pass < 4; ++pass) {
      const int vh = pass >> 1, c = pass & 1;
      f32x16 o[4];
      Seg a0 = s0, a1 = s1;
      a0.K += c * 128; a1.K += c * 128; a0.V += vh * 128; a1.V += vh * 128;
      for (int rep = 0; rep < p.nrep; ++rep)
        attn_core<128, false, false>(tid, o, P + (size_t)trow * ODD_IN + hd * 256 + c * 128 + hh * 8, a0, a1, CD, lds, 0, 0, 0, 0.f, 0.f);
      float* sc = scr + vh * 32768 + tid;
      if (c == 1) {
        float ss = 0.f;
#pragma unroll
        for (int d = 0; d < 4; ++d)
#pragma unroll
          for (int r = 0; r < 16; ++r) {
            float dd = sc[(d * 16 + r) * 512] - lam * o[d][r];
            o[d][r] = dd; ss += dd * dd;
          }
        ssq += ss;
      }
#pragma unroll
      for (int d = 0; d < 4; ++d)
#pragma unroll
        for (int r = 0; r < 16; ++r) sc[(d * 16 + r) * 512] = o[d][r];
    }
    ssq += __shfl_xor(ssq, 32);
    const float rstd = rsqrtf(ssq * (1.f / 256.f) + EPS) * (1.f - lam_init);
    for (int half = 0; half < 2; ++half) {
      f32x16 o[4];
      const float* sc = scr + half * 32768 + tid;
#pragma unroll
      for (int d = 0; d < 4; ++d)
#pragma unroll
        for (int r = 0; r < 16; ++r) o[d][r] = sc[(d * 16 + r) * 512] * rstd;
      const float* tr = tr_stage(tid, o, lds);
      const int colb = hd * 256 + half * 128 + lane * 2;
      const float g0 = gsub[half * 128 + lane * 2], g1 = gsub[half * 128 + lane * 2 + 1];
#pragma unroll 1
      for (int r0 = 0; r0 < 32; r0 += 8) {
        unsigned g[8];
#pragma unroll
        for (int u = 0; u < 8; ++u) g[u] = *(const unsigned*)(P + (size_t)(t0 + wid * 32 + r0 + u) * ODD_IN + 6144 + colb);
#pragma unroll
        for (int u = 0; u < 8; ++u) {
          f2_t v = *(const f2_t*)(tr + (r0 + u) * ATT_TR_ROW + lane * 2);
          *(unsigned*)(O + (size_t)(t0 + wid * 32 + r0 + u) * D + colb) = cvtpk(v[0] * g0 * silu(bflo(g[u])), v[1] * g1 * silu(bfhi(g[u])));
        }
      }
    }
  }
}

#ifndef PM
#define PM 0xffff
#endif
template <int EPI>
DI void gemm_phase(const Params& p, const bfu* A, const bfu* Bt, int K, int nM, int nN, int li, char* lds) {
  const int ntiles = nM * nN;
  for (int it = 0; it * (int)gridDim.x < ntiles; ++it) {
    int id = tile_id(it);
    if (id >= ntiles) continue;
    int m, n; tile_mn(id, nN, m, n);
    gemm256<EPI>(p, A, Bt, K, m * 256, n * 256, li, lds);
  }
}

DI void run_phase(const Params& p, int ph, char* lds) {
  if (ph == 0) { if (PM & 1) phase_prep(p, lds); return; }
  if (ph == 1) { if (PM & 2) phase_rows(p, 0, 0, lds); return; }
  const int q = ph - 2, pair = q / 10, r = q % 10;
  const bfu* hbuf = (const bfu*)(p.ws + WS_HBUF);
  if (r < 6) {
    const int l = 2 * pair, li = pair;
    if (r == 0 && (PM & 4)) {
      gemm_phase<EPI_E1>(p, hbuf, (const bfu*)(p.ws + WS_WT_IN_E) + (size_t)li * EVEN_PAD * D, D, 96, 24, li, lds);
    } else if (r == 1 && (PM & 8)) {
      phase_mid(p, li);
    } else if (r == 2 && (PM & 16)) {
      gemm_phase<EPI_QM>(p, (const bfu*)(p.ws + WS_CQN), (const bfu*)(p.ws + WS_WT_UQ) + (size_t)li * 1536 * 512, 512, 96, 6, li, lds);
      gemm_phase<EPI_KV>(p, (const bfu*)(p.ws + WS_CKVN), (const bfu*)(p.ws + WS_WT_UKV) + (size_t)li * 2048 * 256, 256, 112, 8, li, lds);
    } else if (r == 3 && (PM & 32)) {
      phase_attn_even(p, li, lds);
    } else if (r == 4 && (PM & 64)) {
      gemm_phase<EPI_Y>(p, hbuf, (const bfu*)(p.ws + WS_WT_OUT_E) + (size_t)li * D * D, D, 96, 8, li, lds);
    } else if (r == 5 && (PM & 128)) {
      phase_rows(p, 1, l, lds);
    }
  } else {
    const int l = 2 * pair + 1, li = pair, k = r - 6;
    if (k == 0 && (PM & 256)) {
      gemm_phase<EPI_O1>(p, hbuf, (const bfu*)(p.ws + WS_WT_IN_O) + (size_t)li * ODD_IN * D, D, 96, 32, li, lds);
    } else if (k == 1 && (PM & 512)) {
      phase_attn_odd(p, l, lds);
    } else if (k == 2 && (PM & 1024)) {
      gemm_phase<EPI_Y>(p, hbuf, (const bfu*)(p.ws + WS_WT_OUT_O) + (size_t)li * D * D, D, 96, 8, li, lds);
    } else if (k == 3 && (PM & 2048)) {
      phase_rows(p, 1, l, lds);
    }
  }
}


#define XB_TMO      128
#define XB_XCNT(j)  (256  + 64 * (j))
#define XB_XSUB(j)  (1280 + 64 * (j))
#define XB_XGEN(j)  (2304 + 64 * (j))
#define XB_TOP      3328
#define XB_TOPGEN   3392
#define XCD_BAR_WORDS 3456
#define XB_SPIN_CAP (1u << 22)
#define LAS __attribute__((address_space(3)))
DI unsigned xb_ld(unsigned* p)              { return __hip_atomic_load(p, __ATOMIC_RELAXED, __HIP_MEMORY_SCOPE_AGENT); }
DI unsigned xb_add(unsigned* p, unsigned v) { return __hip_atomic_fetch_add(p, v, __ATOMIC_RELAXED, __HIP_MEMORY_SCOPE_AGENT); }
DI unsigned xb_xcc_id() { return (unsigned)__builtin_amdgcn_s_getreg((3 << 11) | 20) & 0xFu; }
#define XB_SPIN(cond, bar) do { unsigned _sp = 0; while (cond) { __builtin_amdgcn_s_sleep(1); \
    if ((++_sp & 255u) == 0u) { if (xb_ld(&(bar)[XB_TMO])) break; if (_sp > XB_SPIN_CAP) { atomicAdd(&(bar)[XB_TMO], 1u); break; } } } } while (0)
struct XcdBarrier { unsigned* bar; unsigned x; volatile LAS unsigned* st; };
DI XcdBarrier xcd_barrier_post(unsigned* bar, volatile LAS unsigned* st) {
  XcdBarrier b; b.bar = bar; b.x = xb_xcc_id(); b.st = st;
  if (threadIdx.x == 0) (void)xb_add(&bar[XB_XCNT(b.x)], 1u);
  return b;
}
DI void xcd_barrier_complete(unsigned* bar, unsigned x, unsigned& nloc, unsigned& nx) {
  const unsigned G = gridDim.x * gridDim.y * gridDim.z;
  unsigned sum, cnt, mine, sp = 0u;
  for (;;) {
    sum = 0u; cnt = 0u; mine = 0u;
#pragma unroll
    for (unsigned j = 0; j < 16; ++j) { const unsigned c = xb_ld(&bar[XB_XCNT(j)]); sum += c; cnt += (c > 0u) ? 1u : 0u; mine = (j == x) ? c : mine; }
    if (sum == G) break;
    __builtin_amdgcn_s_sleep(1);
    if ((++sp & 255u) == 0u) { if (xb_ld(&bar[XB_TMO])) break; if (sp > XB_SPIN_CAP) { atomicAdd(&bar[XB_TMO], 1u); break; } }
  }
  nloc = mine > 0u ? mine : 1u; nx = cnt > 0u ? cnt : 1u;
}
DI void xcd_barrier(const XcdBarrier& b) {
  asm volatile("s_waitcnt vmcnt(0)" ::: "memory");
  __syncthreads();
  if (threadIdx.x == 0) {
    unsigned* bar = b.bar;
    __builtin_amdgcn_s_waitcnt(0);
    unsigned nloc = b.st[0], nx = b.st[1];
    if (nloc == 0u) { xcd_barrier_complete(bar, b.x, nloc, nx); b.st[0] = nloc; b.st[1] = nx; }
    const unsigned old = xb_add(&bar[XB_XSUB(b.x)], 1u);
    const unsigned gen = old / nloc;
    if (old + 1u == (gen + 1u) * nloc) {
      __builtin_amdgcn_fence(__ATOMIC_RELEASE, "agent");
      asm volatile("s_waitcnt vmcnt(0)" ::: "memory");
      const unsigned og = xb_add(&bar[XB_TOP], 1u);
      const unsigned tg = og / nx;
      if (og + 1u == (tg + 1u) * nx) xb_add(&bar[XB_TOPGEN], 1u);
      else XB_SPIN(xb_ld(&bar[XB_TOPGEN]) == tg, bar);
      __builtin_amdgcn_fence(__ATOMIC_ACQUIRE, "agent");
      xb_add(&bar[XB_XGEN(b.x)], 1u);
      asm volatile("s_waitcnt vmcnt(0)" ::: "memory");
    } else {
      XB_SPIN(xb_ld(&bar[XB_XGEN(b.x)]) == gen, bar);
      __builtin_amdgcn_fence(__ATOMIC_ACQUIRE, "agent");
      asm volatile("s_waitcnt vmcnt(0)" ::: "memory");
    }
  }
  __syncthreads();
}

constexpr int N_PHASES = 22;
constexpr int LDS_BYTES = 8 * 32 * ATT_TR_ROW * 4;

__global__ void __launch_bounds__(512, 2) fwd_megakernel(Params p) {
  __shared__ __attribute__((aligned(16))) char lds[LDS_BYTES];
  __shared__ uint4 xb_words;
  cg::grid_group grid = cg::this_grid();
  if (threadIdx.x == 0) xb_words = make_uint4(0u, 0u, 0u, 0u);
  __syncthreads();
  XcdBarrier xb = xcd_barrier_post((unsigned*)(p.ws + WS_BAR), (volatile LAS unsigned*)&xb_words);
  for (int ph = p.lo; ph < p.hi; ++ph) {
    run_phase(p, ph, lds);
    if (ph + 1 < p.hi) { if (ph < 0) grid.sync(); else xcd_barrier(xb); }
  }
}

extern "C" void kernel_launch(void* const* d_in, const int* in_sizes, int n_in, void* d_out, int out_size, void* d_ws, size_t ws_size,
                              hipStream_t stream) {
  static int grid_blocks = 0;
  if (!grid_blocks) {
    int dev = 0, cus = 0, per_cu = 0;
    (void)hipGetDevice(&dev);
    (void)hipDeviceGetAttribute(&cus, hipDeviceAttributeMultiprocessorCount, dev);
    (void)hipOccupancyMaxActiveBlocksPerMultiprocessor(&per_cu, fwd_megakernel, 512, 0);
    if (per_cu < 1) per_cu = 1;
    per_cu = 1;
    grid_blocks = cus * per_cu;
    if (grid_blocks > 512) grid_blocks = 512;
  }
  if (n_in != 25 || ws_size < WS_NEED) {
    fprintf(stderr, "kernel_launch: bad n_in %d or ws_size %zu < %zu\n", n_in, ws_size, (size_t)WS_NEED);
    return;
  }
  Params p{};
  for (int i = 0; i < 25; ++i) p.in[i] = (const float*)d_in[i];
  p.out = (float*)d_out;
  p.ws = (char*)d_ws;
#ifndef NREP
#define NREP 1
#endif
  p.nrep = NREP; p.pad = 0;
#ifndef PROBE_PHASE
  p.lo = 0; p.hi = N_PHASES;
  void* args[] = {&p};
  (void)hipMemsetAsync((char*)d_ws + WS_BAR, 0, 16384, stream);
  hipError_t e = hipLaunchCooperativeKernel((void*)fwd_megakernel, dim3(grid_blocks), dim3(512), args, 0, stream);
  if (e != hipSuccess) fprintf(stderr, "cooperative launch failed: %s (grid %d)\n", hipGetErrorString(e), grid_blocks);
#else
  void* args[] = {&p};
  p.lo = 0; p.hi = PROBE_PHASE + 1;
  (void)hipMemsetAsync((char*)d_ws + WS_BAR, 0, 16384, stream);
  (void)hipLaunchCooperativeKernel((void*)fwd_megakernel, dim3(grid_blocks), dim3(512), args, 0, stream);
  p.lo = PROBE_PHASE; p.hi = N_PHASES;
  (void)hipMemsetAsync((char*)d_ws + WS_BAR, 0, 16384, stream);
  (void)hipLaunchCooperativeKernel((void*)fwd_megakernel, dim3(grid_blocks), dim3(512), args, 0, stream);
#endif
}
```

```cpp
#include <hip/hip_runtime.h>
#include <hip/hip_cooperative_groups.h>
#include <cstdio>
#include <cstdint>
namespace cg = cooperative_groups;

#define DI __device__ __forceinline__
typedef unsigned short bfu;
using bf16x8 = __attribute__((ext_vector_type(8))) short;
using s16x4  = __attribute__((ext_vector_type(4))) short;
using f32x16 = __attribute__((ext_vector_type(16))) float;
using f32x4  = __attribute__((ext_vector_type(4))) float;
using u32x4  = __attribute__((ext_vector_type(4))) unsigned;
using u32x2  = __attribute__((ext_vector_type(2))) unsigned;
typedef __bf16 bf2_t __attribute__((ext_vector_type(2)));
typedef float f2_t __attribute__((ext_vector_type(2)));

constexpr int D = 2048, TP = 8192, TS = 16384, T = 24576, TALL = 28672;
constexpr int EVEN_IN = 5952, ODD_IN = 8192;
constexpr float EPS = 1e-6f;
constexpr float LOG2E = 1.4426950408889634f;
constexpr float LOG2_ROPE = 13.287712379549449f;

constexpr size_t OUT_YP = 0, OUT_YS = 16777216, OUT_NAK = 50331648, OUT_NAV = 67108864, OUT_CKV = 83886080,
                 OUT_KPE = 88080384, OUT_DK = 89128960, OUT_DV = 122683392;

constexpr size_t al256(size_t x) { return (x + 255) / 256 * 256; }
constexpr size_t WS_WT_IN_E = 0;
constexpr int EVEN_PAD = 6144;
constexpr size_t WS_WT_IN_O = WS_WT_IN_E + al256((size_t)2 * EVEN_PAD * D * 2);
constexpr size_t WS_WT_OUT_E = WS_WT_IN_O + al256((size_t)2 * ODD_IN * D * 2);
constexpr size_t WS_WT_OUT_O = WS_WT_OUT_E + al256((size_t)2 * D * D * 2);
constexpr size_t WS_WT_UQ = WS_WT_OUT_O + al256((size_t)2 * D * D * 2);
constexpr size_t WS_WT_UKV = WS_WT_UQ + al256((size_t)2 * 1536 * 512 * 2);
constexpr size_t WS_C_NAK = WS_WT_UKV + al256((size_t)2 * 2048 * 256 * 2);
constexpr size_t WS_C_NAV = WS_C_NAK + al256((size_t)8 * 2 * 512 * 1024 * 2);
constexpr size_t WS_C_DK = WS_C_NAV + al256((size_t)8 * 2 * 512 * 1024 * 2);
constexpr size_t WS_C_DV = WS_C_DK + al256((size_t)8 * 2 * 512 * 2048 * 2);
constexpr size_t WS_MODP = WS_C_DV + al256((size_t)8 * 2 * 512 * 2048 * 2);
constexpr size_t WS_BAR = WS_MODP + al256((size_t)4 * 4 * 9 * 6144 * 4);
constexpr size_t WS_HBUF = WS_BAR + 16384;
constexpr size_t WS_CQN = WS_HBUF;
constexpr size_t WS_CKVN = WS_HBUF + al256((size_t)T * 512 * 2);
constexpr size_t WS_PBUF = WS_HBUF + al256((size_t)T * D * 2);
constexpr size_t WS_YBUF = WS_PBUF;
constexpr size_t WS_QM = WS_PBUF + al256((size_t)T * EVEN_IN * 2);
constexpr size_t WS_KMLA = WS_QM + al256((size_t)T * 1536 * 2);
constexpr size_t WS_VMLA = WS_KMLA + al256((size_t)TALL * 1536 * 2);
constexpr size_t WS_END_EVEN = WS_VMLA + al256((size_t)TALL * 1024 * 2);
constexpr size_t WS_SCR = WS_PBUF + al256((size_t)T * ODD_IN * 2);
constexpr size_t WS_END_ODD = WS_SCR + (size_t)1024 * 131072;
constexpr size_t WS_NEED = WS_END_EVEN > WS_END_ODD ? WS_END_EVEN : WS_END_ODD;

struct Params {
  const float* in[25];
  float* out;
  char* ws;
  int lo, hi;
  int nrep, pad;
};

DI unsigned cvtpk(float lo, float hi) {
  f2_t v = {lo, hi};
  bf2_t b = __builtin_convertvector(v, bf2_t);
  return __builtin_bit_cast(unsigned, b);
}
DI bfu f2bf(float x) { return (bfu)(cvtpk(x, 0.f) & 0xffffu); }
DI float bf2f(bfu b) { return __uint_as_float(((unsigned)b) << 16); }
DI float bflo(unsigned u) { return __uint_as_float(u << 16); }
DI float bfhi(unsigned u) { return __uint_as_float(u & 0xffff0000u); }
DI int opaque(int x) { asm volatile("" : "+v"(x)); return x; }
DI int crow(int r, int hi) { return (r & 3) + 8 * (r >> 2) + 4 * hi; }
DI float silu(float x) { return x * __builtin_amdgcn_rcpf(1.f + __expf(-x)); }
DI f32x16 mfma(bf16x8 a, bf16x8 b, f32x16 c) { return __builtin_amdgcn_mfma_f32_32x32x16_bf16(a, b, c, 0, 0, 0); }
DI float xor32(float v) {
  auto rr = __builtin_amdgcn_permlane32_swap(__float_as_uint(v), __float_as_uint(v), false, false);
  return __uint_as_float((threadIdx.x & 32) ? rr[0] : rr[1]);
}
DI float wave_sum(float v) {
#pragma unroll
  for (int o = 32; o >= 1; o >>= 1) v += __shfl_xor(v, o);
  return v;
}
DI float block_sum(float v, float* red, int tid) {
  v = wave_sum(v);
  __syncthreads();
  if ((tid & 63) == 0) red[tid >> 6] = v;
  __syncthreads();
  const int hb = (tid >> 8) * 4;
  return red[hb] + red[hb + 1] + red[hb + 2] + red[hb + 3];
}
DI float modval(const Params& p, int l, int r, int n) {
  const float* mp = (const float*)(p.ws + WS_MODP);
  float s = p.in[11][l * 6144 + n];
#pragma unroll
  for (int ks = 0; ks < 4; ++ks) s += mp[((size_t)(ks * 4 + l) * 9 + r) * 6144 + n];
  return s;
}

DI void prep_mod_item(const Params& p, int item, char* lds) {
  const int tid = opaque(threadIdx.x), lane = tid & 63, wid = tid >> 6;
  const int ks = item & 3, cgp = (item >> 2) % 24, l = item / 96;
  float* scond = (float*)lds;
  float* red = (float*)(lds + 18432);
  for (int idx = tid; idx < 9 * 512; idx += 512) {
    int r = idx >> 9, kk = idx & 511;
    float cv = r < 8 ? p.in[8][r * 2048 + ks * 512 + kk] : p.in[9][ks * 512 + kk];
    scond[idx] = silu(cv);
  }
  __syncthreads();
  const float* W = p.in[10] + ((size_t)l * 2048 + ks * 512 + wid * 64) * 6144 + cgp * 256 + lane * 4;
  float acc[9][4];
#pragma unroll
  for (int r = 0; r < 9; ++r) { acc[r][0] = 0; acc[r][1] = 0; acc[r][2] = 0; acc[r][3] = 0; }
  for (int kk = 0; kk < 64; kk += 4) {
    f32x4 w[4];
#pragma unroll
    for (int u = 0; u < 4; ++u) w[u] = *(const f32x4*)(W + (size_t)(kk + u) * 6144);
#pragma unroll
    for (int u = 0; u < 4; ++u) {
#pragma unroll
      for (int r = 0; r < 9; ++r) {
        float s = scond[r * 512 + wid * 64 + kk + u];
        acc[r][0] += s * w[u][0]; acc[r][1] += s * w[u][1]; acc[r][2] += s * w[u][2]; acc[r][3] += s * w[u][3];
      }
    }
  }
#pragma unroll
  for (int r = 0; r < 9; ++r) {
    f32x4 v = {acc[r][0], acc[r][1], acc[r][2], acc[r][3]};
    *(f32x4*)(red + (wid * 9 + r) * 256 + lane * 4) = v;
  }
  __syncthreads();
  float* mp = (float*)(p.ws + WS_MODP);
  for (int idx = tid; idx < 9 * 256; idx += 512) {
    int r = idx >> 8, cc = idx & 255;
    float s = 0.f;
#pragma unroll
    for (int w = 0; w < 8; ++w) s += red[(w * 9 + r) * 256 + cc];
    mp[((size_t)(ks * 4 + l) * 9 + r) * 6144 + cgp * 256 + cc] = s;
  }
  __syncthreads();
}

DI int swap45(int n) { return (n & ~0x30) | ((n & 0x10) << 1) | ((n & 0x20) >> 1); }

DI void prep_transpose_tile(const float* __restrict__ src, bfu* __restrict__ dst, int K, int N, int k0, int n0, char* lds, int tid) {
  float* tl = (float*)lds + (tid >> 8) * (64 * 65);
  const int t4 = tid & 255;
#pragma unroll
  for (int i = 0; i < 4; ++i) {
    int kr = (t4 >> 4) + 16 * i, nc = (t4 & 15) * 4;
    f32x4 v = *(const f32x4*)(src + (size_t)(k0 + kr) * N + n0 + nc);
    tl[kr * 65 + nc + 0] = v[0]; tl[kr * 65 + nc + 1] = v[1]; tl[kr * 65 + nc + 2] = v[2]; tl[kr * 65 + nc + 3] = v[3];
  }
  __syncthreads();
  {
    int n = t4 >> 2, kseg = (t4 & 3) * 16;
    unsigned w[8];
#pragma unroll
    for (int e = 0; e < 8; ++e) w[e] = cvtpk(tl[(kseg + 2 * e) * 65 + n], tl[(kseg + 2 * e + 1) * 65 + n]);
    u32x4 a = {w[0], w[1], w[2], w[3]}, b = {w[4], w[5], w[6], w[7]};
    bfu* d = dst + (size_t)swap45(n0 + n) * K + k0 + kseg;
    *(u32x4*)d = a; *(u32x4*)(d + 8) = b;
  }
  __syncthreads();
}

DI void phase_prep(const Params& p, char* lds) {
  constexpr int N_MOD = 384, N_TR_L = 9440, N_TRP = N_TR_L, N_CV = 1536;
  for (int item = blockIdx.x; item < N_MOD + N_TRP + N_CV; item += gridDim.x) {
    if (item < N_MOD) { prep_mod_item(p, item, lds); continue; }
    const int tid = opaque(threadIdx.x);
    int it = item - N_MOD;
    if (it < N_TRP) {
      int tl = it * 2 + (tid >> 8);
      int i = tl / N_TR_L, r = tl % N_TR_L;
      const float* src; bfu* dst; int K, N;
      if (r < 2976) { src = p.in[14] + (size_t)i * 2048 * EVEN_IN; dst = (bfu*)(p.ws + WS_WT_IN_E) + (size_t)i * EVEN_PAD * 2048; K = 2048; N = EVEN_IN; }
      else if ((r -= 2976) < 1024) { src = p.in[15] + (size_t)i * 2048 * 2048; dst = (bfu*)(p.ws + WS_WT_OUT_E) + (size_t)i * 2048 * 2048; K = 2048; N = 2048; }
      else if ((r -= 1024) < 192) { src = p.in[18] + (size_t)i * 512 * 1536; dst = (bfu*)(p.ws + WS_WT_UQ) + (size_t)i * 1536 * 512; K = 512; N = 1536; }
      else if ((r -= 192) < 128) { src = p.in[20] + (size_t)i * 256 * 2048; dst = (bfu*)(p.ws + WS_WT_UKV) + (size_t)i * 2048 * 256; K = 256; N = 2048; }
      else if ((r -= 128) < 4096) { src = p.in[21] + (size_t)i * 2048 * ODD_IN; dst = (bfu*)(p.ws + WS_WT_IN_O) + (size_t)i * ODD_IN * 2048; K = 2048; N = ODD_IN; }
      else { r -= 4096; src = p.in[22] + (size_t)i * 2048 * 2048; dst = (bfu*)(p.ws + WS_WT_OUT_O) + (size_t)i * 2048 * 2048; K = 2048; N = 2048; }
      int nN = N / 64;
      int kt = r / nN, nt = r % nN;
      prep_transpose_tile(src, dst, K, N, kt * 64, nt * 64, lds, tid);
      continue;
    }
    it -= N_TRP;
    {
      size_t ch = (size_t)it * 4096;
      const float* src; bfu* dst;
      if (ch < 1048576) { src = p.in[2]; dst = (bfu*)(p.ws + WS_C_NAK); }
      else if ((ch -= 1048576) < 1048576) { src = p.in[3]; dst = (bfu*)(p.ws + WS_C_NAV); }
      else if ((ch -= 1048576) < 2097152) { src = p.in[6]; dst = (bfu*)(p.ws + WS_C_DK); }
      else { ch -= 2097152; src = p.in[7]; dst = (bfu*)(p.ws + WS_C_DV); }
#pragma unroll
      for (int u = 0; u < 8; ++u) {
        size_t c = ch + u * 512 + tid;
        f32x4 a = *(const f32x4*)(src + c * 8), b = *(const f32x4*)(src + c * 8 + 4);
        u32x4 w = {cvtpk(a[0], a[1]), cvtpk(a[2], a[3]), cvtpk(b[0], b[1]), cvtpk(b[2], b[3])};
        *(u32x4*)(dst + c * 8) = w;
      }
    }
  }
}

DI void phase_rows(const Params& p, int kind, int l, char* lds) {
  float* vA = (float*)lds; float* vSH = vA + 2048; float* vG = vSH + 2048;
  const int tid = opaque(threadIdx.x), lane = tid & 63, wid = tid >> 6;
  const int rows_per = ((T / 8 + gridDim.x - 1) / gridDim.x) * 8;
  const int t_begin = blockIdx.x * rows_per;
  const int t_end = min(T, t_begin + rows_per);
  const int ln = kind == 0 ? 0 : l + 1;
  const bool do_h = ln < 4;
  int cur_r = -1;
  bfu* hbuf = (bfu*)(p.ws + WS_HBUF);
  const bfu* ybuf = (const bfu*)(p.ws + WS_YBUF);
  for (int base = t_begin; base < t_end; base += 8) {
    const int r = base < TP ? 8 : (base - TP) >> 11;
    if (r != cur_r) {
      cur_r = r;
      __syncthreads();
#pragma unroll
      for (int e = 0; e < 4; ++e) {
        const int col = tid * 4 + e;
        if (do_h) {
          vSH[col] = modval(p, ln, r, col);
          vA[col] = (1.f + modval(p, ln, r, 2048 + col)) * p.in[12][ln * 2048 + col];
        }
        if (kind == 1) vG[col] = modval(p, l, r, 4096 + col) * p.in[13][l * 2048 + col];
      }
      __syncthreads();
    }
    const int t = base + wid;
    if (t < t_end) {
      const float* xin = (kind == 0 || l == 0) ? (t < TP ? p.in[0] + (size_t)t * D : p.in[1] + (size_t)(t - TP) * D) : p.out + (size_t)t * D;
      f32x4 x[8];
#pragma unroll
      for (int i = 0; i < 8; ++i) x[i] = *(const f32x4*)(xin + i * 256 + lane * 4);
      if (kind == 1) {
        f32x4 y[8];
#pragma unroll
        for (int i = 0; i < 8; ++i) {
          u32x2 w = *(const u32x2*)(ybuf + (size_t)t * D + i * 256 + lane * 4);
          y[i][0] = bflo(w[0]); y[i][1] = bfhi(w[0]); y[i][2] = bflo(w[1]); y[i][3] = bfhi(w[1]);
        }
        float ss = 0.f;
#pragma unroll
        for (int i = 0; i < 8; ++i) ss += y[i][0] * y[i][0] + y[i][1] * y[i][1] + y[i][2] * y[i][2] + y[i][3] * y[i][3];
        ss = wave_sum(ss);
        const float rstd = rsqrtf(ss * (1.f / 2048.f) + EPS);
#pragma unroll
        for (int i = 0; i < 8; ++i) {
          f32x4 g = *(const f32x4*)(vG + i * 256 + lane * 4);
          x[i][0] += g[0] * (y[i][0] * rstd); x[i][1] += g[1] * (y[i][1] * rstd);
          x[i][2] += g[2] * (y[i][2] * rstd); x[i][3] += g[3] * (y[i][3] * rstd);
          *(f32x4*)(p.out + (size_t)t * D + i * 256 + lane * 4) = x[i];
        }
      }
      if (do_h) {
        float ss = 0.f;
#pragma unroll
        for (int i = 0; i < 8; ++i) ss += x[i][0] * x[i][0] + x[i][1] * x[i][1] + x[i][2] * x[i][2] + x[i][3] * x[i][3];
        ss = wave_sum(ss);
        const float rstd = rsqrtf(ss * (1.f / 2048.f) + EPS);
#pragma unroll
        for (int i = 0; i < 8; ++i) {
          f32x4 a = *(const f32x4*)(vA + i * 256 + lane * 4), s = *(const f32x4*)(vSH + i * 256 + lane * 4);
          u32x2 w = {cvtpk(x[i][0] * rstd * a[0] + s[0], x[i][1] * rstd * a[1] + s[1]), cvtpk(x[i][2] * rstd * a[2] + s[2], x[i][3] * rstd * a[3] + s[3])};
          *(u32x2*)(hbuf + (size_t)t * D + i * 256 + lane * 4) = w;
        }
      }
    }
  }
}

constexpr int GBM = 256, GBK = 64, GHALF = 128, GHT = GHALF * GBK;
enum { EPI_E1 = 0, EPI_O1 = 1, EPI_QM = 2, EPI_KV = 3, EPI_Y = 4 };

DI int lds_byte(int r, int c) {
  int st = (r >> 4) * 2 + (c >> 5), rr = r & 15, cc = c & 31, ob = rr * 64 + cc * 2;
  return st * 1024 + (ob ^ (((ob >> 9) & 1) << 5));
}
DI void stage_rc(int b, int& R, int& C) {
  int st = b / 1024, sb = b % 1024, swz = sb ^ (((sb >> 9) & 1) << 5);
  R = (st >> 1) * 16 + swz / 64; C = (st & 1) * 32 + (swz % 64) / 2;
}

template <int EPI>
DI void gemm256(const Params& p, const bfu* __restrict__ A, const bfu* __restrict__ Bt, const int K, const int brow, const int bcol,
                const int li, char* lds) {
  const int tid = opaque(threadIdx.x);
  bfu* shm = (bfu*)lds;
#define SA(b, h) (shm + ((b) * 2 + (h)) * GHT)
#define SB(b, h) (shm + (4 + (b) * 2 + (h)) * GHT)
#define STAGE(P_, BASE, br, kt) do { long _g = (long)(br) * K + (long)(kt) * GBK;                          \
    for (int _i = 0; _i < 2; ++_i) { int _b = tid * 16 + _i * 8192; int _r, _c; stage_rc(_b, _r, _c);      \
      __builtin_amdgcn_global_load_lds((const unsigned*)(BASE + _g + (long)_r * K + _c),                    \
        (__attribute__((address_space(3))) unsigned*)((char*)(P_) + _b), 16, 0, 0); } } while (0)
#define LDA(dst, b, h) for (int m = 0; m < 4; ++m) for (int k = 0; k < 2; ++k)                              \
    dst[m][k] = *reinterpret_cast<const bf16x8*>((char*)SA(b, h) + lds_byte(wr * 64 + m * 16 + fr, k * 32 + fq * 8))
#define LDB(dst, b, h) for (int n = 0; n < 2; ++n) for (int k = 0; k < 2; ++k)                              \
    dst[n][k] = *reinterpret_cast<const bf16x8*>((char*)SB(b, h) + lds_byte(wc * 32 + n * 16 + fr, k * 32 + fq * 8))
#define MMA(ai, bj, At_, Bt_) do { __builtin_amdgcn_s_setprio(1);                                            \
    for (int m = 0; m < 4; ++m) for (int n = 0; n < 2; ++n) for (int k = 0; k < 2; ++k)                      \
      acc[ai][bj][m][n] = __builtin_amdgcn_mfma_f32_16x16x32_bf16(At_[m][k], Bt_[n][k], acc[ai][bj][m][n], 0, 0, 0); \
    __builtin_amdgcn_s_setprio(0); } while (0)
#define WAIT_V(n) asm volatile("s_waitcnt vmcnt(" #n ")" ::: "memory")
#define WAIT_L(n) asm volatile("s_waitcnt lgkmcnt(" #n ")" ::: "memory")
#define BAR __builtin_amdgcn_s_barrier()
#define SCHED __builtin_amdgcn_sched_barrier(0)
  const int wid = tid >> 6, lane = tid & 63, wr = wid >> 2, wc = wid & 3, fr = lane & 15, fq = lane >> 4;
  f32x4 acc[2][2][4][2];
#pragma unroll
  for (int a_ = 0; a_ < 2; ++a_)
#pragma unroll
    for (int b_ = 0; b_ < 2; ++b_)
#pragma unroll
      for (int m = 0; m < 4; ++m)
#pragma unroll
        for (int n = 0; n < 2; ++n) { acc[a_][b_][m][n][0] = 0.f; acc[a_][b_][m][n][1] = 0.f; acc[a_][b_][m][n][2] = 0.f; acc[a_][b_][m][n][3] = 0.f; }
  bf16x8 At[4][2], B0[2][2], B1[2][2];
  const int nt = K / GBK;
  WAIT_V(0); BAR;
  STAGE(SB(0, 0), Bt, bcol, 0); STAGE(SA(0, 0), A, brow, 0);
  STAGE(SB(0, 1), Bt, bcol + GHALF, 0); STAGE(SA(0, 1), A, brow + GHALF, 0);
  if (wr == 1) BAR;
  WAIT_V(4); BAR;
  STAGE(SB(1, 0), Bt, bcol, 1); STAGE(SA(1, 0), A, brow, 1); STAGE(SB(1, 1), Bt, bcol + GHALF, 1);
  WAIT_V(6); BAR;
  for (int t = 0; t < nt - 2; t += 2) {
    LDB(B0, 0, 0); SCHED; LDA(At, 0, 0); STAGE(SA(1, 1), A, brow + GHALF, t + 1);
    WAIT_L(8); BAR; WAIT_L(0); MMA(0, 0, At, B0); BAR; SCHED;
    LDB(B1, 0, 1); STAGE(SB(0, 0), Bt, bcol, t + 2);
    BAR; WAIT_L(0); MMA(0, 1, At, B1); BAR;
    LDA(At, 0, 1); STAGE(SA(0, 0), A, brow, t + 2);
    BAR; WAIT_L(0); MMA(1, 0, At, B0); BAR; SCHED;
    STAGE(SB(0, 1), Bt, bcol + GHALF, t + 2);
    WAIT_V(6); BAR; MMA(1, 1, At, B1); BAR;
    LDB(B0, 1, 0); SCHED; LDA(At, 1, 0); STAGE(SA(0, 1), A, brow + GHALF, t + 2);
    WAIT_L(8); BAR; WAIT_L(0); MMA(0, 0, At, B0); BAR; SCHED;
    LDB(B1, 1, 1); STAGE(SB(1, 0), Bt, bcol, t + 3);
    BAR; WAIT_L(0); MMA(0, 1, At, B1); BAR;
    LDA(At, 1, 1); STAGE(SA(1, 0), A, brow, t + 3);
    BAR; WAIT_L(0); MMA(1, 0, At, B0); BAR; SCHED;
    STAGE(SB(1, 1), Bt, bcol + GHALF, t + 3);
    WAIT_V(6); BAR; MMA(1, 1, At, B1); BAR;
  }
  { LDB(B0, 0, 0); LDA(At, 0, 0); STAGE(SA(1, 1), A, brow + GHALF, nt - 1);
    BAR; WAIT_L(0); MMA(0, 0, At, B0); BAR;
    LDB(B1, 0, 1); BAR; WAIT_L(0); MMA(0, 1, At, B1); BAR;
    LDA(At, 0, 1); WAIT_V(4); BAR; WAIT_L(0); MMA(1, 0, At, B0); MMA(1, 1, At, B1); BAR; }
  { LDB(B0, 1, 0); LDA(At, 1, 0); WAIT_V(2); BAR; WAIT_L(0); MMA(0, 0, At, B0); BAR;
    LDB(B1, 1, 1); WAIT_V(0); BAR; WAIT_L(0); MMA(0, 1, At, B1); BAR;
    LDA(At, 1, 1); BAR; WAIT_L(0); MMA(1, 0, At, B0); MMA(1, 1, At, B1); BAR; }
  if (wr == 0) BAR;
#undef SA
#undef SB
#undef STAGE
#undef LDA
#undef LDB
#undef MMA
#undef WAIT_V
#undef WAIT_L
#undef BAR
#undef SCHED

  const int jr = (wc & 1) * 16 + fr;
  if constexpr (EPI == EPI_O1) {
    if (brow >= TP && bcol < 4096) {
      const float inv = exp2f(-(float)jr * (LOG2_ROPE / 32.f));
      const bool colrope = (wc >> 1) & 1;
#pragma unroll
      for (int ai = 0; ai < 2; ++ai)
#pragma unroll
        for (int m = 0; m < 4; ++m)
#pragma unroll
          for (int j = 0; j < 4; ++j) {
            int row = brow + ai * 128 + wr * 64 + m * 16 + fq * 4 + j;
            int s = (row - TP) & 2047;
            float ang = (float)(colrope ? (s & 63) : (s >> 6)) * inv;
            float cs = __cosf(ang), sn = __sinf(ang);
#pragma unroll
            for (int bj = 0; bj < 2; ++bj) {
              float x1 = acc[ai][bj][m][0][j], x2 = acc[ai][bj][m][1][j];
              acc[ai][bj][m][0][j] = x1 * cs - x2 * sn;
              acc[ai][bj][m][1][j] = x2 * cs + x1 * sn;
            }
          }
    }
  }
  if constexpr (EPI == EPI_E1 || EPI == EPI_O1) {
    if (brow < TP) {
#pragma unroll
      for (int ai = 0; ai < 2; ++ai)
#pragma unroll
        for (int bj = 0; bj < 2; ++bj)
#pragma unroll
          for (int n = 0; n < 2; ++n) {
            const int colg = bcol + bj * 128 + (wc >> 1) * 64 + n * 32 + (wc & 1) * 16;
            const int col = colg + fr;
            float* dst = nullptr; int ldo = 0, c0 = 0;
            if constexpr (EPI == EPI_E1) {
              if (colg >= 1024 && colg < 2048) { dst = p.out + OUT_NAK; ldo = 1024; c0 = 1024; }
              else if (colg >= 2048 && colg < 3072) { dst = p.out + OUT_NAV; ldo = 1024; c0 = 2048; }
              else if (colg >= 4864 && colg < 4928) { dst = p.out + OUT_KPE; ldo = 64; c0 = 4864; }
            } else {
              if (colg >= 2048 && colg < 4096) { dst = p.out + OUT_DK; ldo = 2048; c0 = 2048; }
              else if (colg >= 4096 && colg < 6144) { dst = p.out + OUT_DV; ldo = 2048; c0 = 4096; }
            }
            if (dst) {
#pragma unroll
              for (int m = 0; m < 4; ++m)
#pragma unroll
                for (int j = 0; j < 4; ++j) {
                  const int row = brow + ai * 128 + wr * 64 + m * 16 + fq * 4 + j;
                  size_t orow = (size_t)((row >> 8) * 2 + li) * 256 + (row & 255);
                  dst[orow * ldo + (col - c0)] = acc[ai][bj][m][n][j];
                }
            }
          }
    }
  }
  constexpr int CT_ROW = 528;
#pragma unroll
  for (int ai = 0; ai < 2; ++ai)
#pragma unroll
    for (int bj = 0; bj < 2; ++bj)
#pragma unroll
      for (int n = 0; n < 2; ++n) {
        const int cl = bj * 128 + (wc >> 1) * 64 + n * 32 + (wc & 1) * 16 + fr;
#pragma unroll
        for (int m = 0; m < 4; ++m)
#pragma unroll
          for (int j = 0; j < 4; ++j) {
            const int rl = ai * 128 + wr * 64 + m * 16 + fq * 4 + j;
            *(bfu*)(lds + rl * CT_ROW + cl * 2) = f2bf(acc[ai][bj][m][n][j]);
          }
      }
  __syncthreads();
#pragma unroll 4
  for (int i = 0; i < 16; ++i) {
    const int c = tid + 512 * i, rl = c >> 5, cc = c & 31;
    const u32x4 w = *(const u32x4*)(lds + rl * CT_ROW + cc * 16);
    const size_t row = (size_t)(brow + rl);
    const int col = bcol + cc * 8;
    if constexpr (EPI == EPI_E1) {
      if (col < EVEN_IN) *(u32x4*)((bfu*)(p.ws + WS_PBUF) + row * EVEN_IN + col) = w;
    } else if constexpr (EPI == EPI_O1) {
      *(u32x4*)((bfu*)(p.ws + WS_PBUF) + row * ODD_IN + col) = w;
    } else if constexpr (EPI == EPI_QM) {
      *(u32x4*)((bfu*)(p.ws + WS_QM) + row * 1536 + col) = w;
    } else if constexpr (EPI == EPI_KV) {
      const int hd = col >> 8, jj = col & 255;
      if (jj < 128) *(u32x4*)((bfu*)(p.ws + WS_KMLA) + row * 1536 + hd * 192 + jj) = w;
      else *(u32x4*)((bfu*)(p.ws + WS_VMLA) + row * 1024 + hd * 128 + (jj - 128)) = w;
    } else {
      *(u32x4*)((bfu*)(p.ws + WS_YBUF) + row * D + col) = w;
    }
  }
}

DI int tile_id(int it) {
  const int G = gridDim.x;
  const int pb = (G & 7) == 0 ? (blockIdx.x & 7) * (G >> 3) + (blockIdx.x >> 3) : blockIdx.x;
  return it * G + pb;
}
DI void tile_mn(int id, int nN, int& m, int& n) {
  int grp = id / (8 * nN), rem = id % (8 * nN);
  m = grp * 8 + (rem & 7); n = rem >> 3;
}

DI void phase_mid(const Params& p, int li) {
  const int tid = opaque(threadIdx.x), lane = tid & 63, wid = tid >> 6;
  const bfu* P = (const bfu*)(p.ws + WS_PBUF);
  bfu* cqn = (bfu*)(p.ws + WS_CQN);
  bfu* ckvn = (bfu*)(p.ws + WS_CKVN);
  bfu* kmla = (bfu*)(p.ws + WS_KMLA);
  const float* gq = p.in[17] + li * 512;
  const float* gkv = p.in[19] + li * 256;
  for (int t = blockIdx.x * 8 + wid; t < TALL; t += gridDim.x * 8) {
    float kp;
    if (t < T) {
      const bfu* Pr = P + (size_t)t * EVEN_IN;
      {
        u32x4 w = *(const u32x4*)(Pr + 4096 + lane * 8);
        float v[8] = {bflo(w[0]), bfhi(w[0]), bflo(w[1]), bfhi(w[1]), bflo(w[2]), bfhi(w[2]), bflo(w[3]), bfhi(w[3])};
        float ss = 0;
#pragma unroll
        for (int e = 0; e < 8; ++e) ss += v[e] * v[e];
        ss = wave_sum(ss);
        float rstd = rsqrtf(ss * (1.f / 512.f) + EPS);
#pragma unroll
        for (int e = 0; e < 8; ++e) v[e] = v[e] * rstd * gq[lane * 8 + e];
        u32x4 o = {cvtpk(v[0], v[1]), cvtpk(v[2], v[3]), cvtpk(v[4], v[5]), cvtpk(v[6], v[7])};
        *(u32x4*)(cqn + (size_t)t * 512 + lane * 8) = o;
      }
      {
        u32x2 w = *(const u32x2*)(Pr + 4608 + lane * 4);
        float v[4] = {bflo(w[0]), bfhi(w[0]), bflo(w[1]), bfhi(w[1])};
        float ss = v[0] * v[0] + v[1] * v[1] + v[2] * v[2] + v[3] * v[3];
        ss = wave_sum(ss);
        float rstd = rsqrtf(ss * (1.f / 256.f) + EPS);
#pragma unroll
        for (int e = 0; e < 4; ++e) v[e] = v[e] * rstd * gkv[lane * 4 + e];
        u32x2 o = {cvtpk(v[0], v[1]), cvtpk(v[2], v[3])};
        *(u32x2*)(ckvn + (size_t)t * 256 + lane * 4) = o;
        if (t < TP) {
          size_t orow = (size_t)((t >> 8) * 2 + li) * 256 + (t & 255);
          f32x4 f = {v[0], v[1], v[2], v[3]};
          *(f32x4*)(p.out + OUT_CKV + orow * 256 + lane * 4) = f;
        }
      }
      kp = bf2f(Pr[4864 + lane]);
      if (t >= TP) {
        int s = (t - TP) & 2047;
        float pos = (float)(lane < 32 ? (s >> 6) : (s & 63));
        int jj = lane & 15;
        float inv = exp2f(-(float)jj * (LOG2_ROPE / 16.f));
        float ang = pos * inv;
        float cs = __cosf(ang), sn = __sinf(ang);
        float pv = __shfl_xor(kp, 16);
        kp = (lane & 16) ? (kp * cs + pv * sn) : (kp * cs - pv * sn);
      }
    } else {
      int ci = t - T;
      int b = ci >> 9, j = ci & 511;
      size_t crow_ = (size_t)(b * 2 + li) * 512 + j;
      f32x4 f = *(const f32x4*)(p.in[4] + crow_ * 256 + lane * 4);
      u32x2 o = {cvtpk(f[0], f[1]), cvtpk(f[2], f[3])};
      *(u32x2*)(ckvn + (size_t)t * 256 + lane * 4) = o;
      kp = p.in[5][crow_ * 64 + lane];
    }
    bfu kb = f2bf(kp);
#pragma unroll
    for (int hd = 0; hd < 8; ++hd) kmla[(size_t)t * 1536 + hd * 192 + 128 + lane] = kb;
  }
}

struct Seg { const bfu* K; const bfu* V; int ldk, ldv, n; };
constexpr int ATT_KB = 24576, ATT_VB = 16384, ATT_BUF = ATT_KB + ATT_VB;
constexpr int ATT_BIAS_OFF = 3 * ATT_BUF;
constexpr int ATT_TR_ROW = 132;

template <int DQK>
DI void attn_issue(const int tid, const bfu* __restrict__ Kp, const bfu* __restrict__ Vp, int ldk, int ldv, char* buf) {
  constexpr int KROWB = DQK * 2;
#pragma unroll
  for (int i = 0; i < DQK / 64; ++i) {
    int bb = i * 8192 + tid * 16, row = bb / KROWB, cpos = (bb % KROWB) >> 4, c = cpos ^ (row & 7);
    __builtin_amdgcn_global_load_lds((const unsigned*)(Kp + (size_t)row * ldk + c * 8),
                                     (__attribute__((address_space(3))) unsigned*)(buf + bb), 16, 0, 0);
  }
#pragma unroll
  for (int i = 0; i < 2; ++i) {
    int bb = i * 8192 + tid * 16, row = bb >> 8, cpos = (bb & 255) >> 4, c = cpos ^ ((row & 3) << 2);
    __builtin_amdgcn_global_load_lds((const unsigned*)(Vp + (size_t)row * ldv + c * 8),
                                     (__attribute__((address_space(3))) unsigned*)(buf + ATT_KB + bb), 16, 0, 0);
  }
}

template <int DQK, bool NA, bool ROPEQ>
DI void attn_core(const int tid, f32x16* o, const bfu* __restrict__ Qrow, const Seg& s0, const Seg& s1, float C, char* lds,
                  int gr, int gc, int kr0, float prow, float pcol) {
  constexpr int KROWB = DQK * 2;
  constexpr int ND = DQK / 16;
  const int lane = tid & 63, r32 = lane & 31, hh = lane >> 5;
  const bool lag = __builtin_amdgcn_readfirstlane(tid >> 8) != 0;
  const float* sbias = (const float*)(lds + ATT_BIAS_OFF);
  const int nt0 = s0.n >> 6, ntile = nt0 + (s1.n >> 6);
  auto issue_tile = [&](int jt, int slot) {
    const bool in0 = jt < nt0;
    const bfu* Kp = in0 ? s0.K + (size_t)(jt * 64) * s0.ldk : s1.K + (size_t)((jt - nt0) * 64) * s1.ldk;
    const bfu* Vp = in0 ? s0.V + (size_t)(jt * 64) * s0.ldv : s1.V + (size_t)((jt - nt0) * 64) * s1.ldv;
    attn_issue<DQK>(tid, Kp, Vp, in0 ? s0.ldk : s1.ldk, in0 ? s0.ldv : s1.ldv, lds + slot * ATT_BUF);
  };
  __syncthreads();
  issue_tile(0, 0);
  bf16x8 qr[ND];
#pragma unroll
  for (int d0 = 0; d0 < ND; ++d0) qr[d0] = *(const bf16x8*)(Qrow + d0 * 16);
  if constexpr (ROPEQ) {
#pragma unroll
    for (int pr = 0; pr < 2; ++pr) {
      float pos = pr == 0 ? prow : pcol;
      bf16x8 a = qr[8 + 2 * pr], b = qr[9 + 2 * pr];
      float xa[8], xb[8];
#pragma unroll
      for (int e = 0; e < 8; ++e) {
        float inv = exp2f(-(float)(8 * hh + e) * (LOG2_ROPE / 16.f));
        float ang = pos * inv;
        float cs = __cosf(ang), sn = __sinf(ang);
        float x1 = bf2f((bfu)a[e]), x2 = bf2f((bfu)b[e]);
        xa[e] = x1 * cs - x2 * sn; xb[e] = x2 * cs + x1 * sn;
      }
      u32x4 wa = {cvtpk(xa[0], xa[1]), cvtpk(xa[2], xa[3]), cvtpk(xa[4], xa[5]), cvtpk(xa[6], xa[7])};
      u32x4 wb = {cvtpk(xb[0], xb[1]), cvtpk(xb[2], xb[3]), cvtpk(xb[4], xb[5]), cvtpk(xb[6], xb[7])};
      qr[8 + 2 * pr] = __builtin_bit_cast(bf16x8, wa); qr[9 + 2 * pr] = __builtin_bit_cast(bf16x8, wb);
    }
  }
#pragma unroll
  for (int d = 0; d < 4; ++d)
#pragma unroll
    for (int r = 0; r < 16; ++r) o[d][r] = 0.f;
  float m = -1e30f, l = 0.f;
  const int rs = min(max(gr - 4, 0), 24), cs_ = min(max(gc - 8, 0), 48);
  int kad[4];
#pragma unroll
  for (int q = 0; q < 4; ++q) kad[q] = r32 * KROWB + (((q * 2 + hh) ^ (r32 & 7)) << 4);
  const int q_ = (lane & 15) >> 2;
  int vad[4];
#pragma unroll
  for (int d = 0; d < 4; ++d) vad[d] = ATT_KB + (hh * 4 + q_) * 256 + ((d ^ q_) << 6) + (16 * ((lane >> 4) & 1) + 4 * (lane & 3)) * 2;

  auto qk_sm = [&](bf16x8* pa, const char* buf, const int j) {
    f32x16 p0, p1;
#pragma unroll
    for (int r = 0; r < 16; ++r) { p0[r] = 0.f; p1[r] = 0.f; }
#pragma unroll
    for (int hb = 0; hb < ND; hb += 4) {
      bf16x8 k0[4], k1[4];
#pragma unroll
      for (int d = 0; d < 4; ++d) {
        k0[d] = *(const bf16x8*)(buf + kad[d] + (hb >> 2) * 128);
        k1[d] = *(const bf16x8*)(buf + kad[d] + (hb >> 2) * 128 + 32 * KROWB);
      }
      __builtin_amdgcn_sched_barrier(0);
#pragma unroll
      for (int d = 0; d < 4; ++d) {
        p0 = mfma(k0[d], qr[hb + d], p0);
        p1 = mfma(k1[d], qr[hb + d], p1);
      }
      __builtin_amdgcn_sched_barrier(0);
    }
    float mx;
    if (NA && j >= nt0) {
      const int kr = kr0 + (j - nt0);
      const bool rowok = (kr >= rs) && (kr < rs + 8);
      const int brow = (kr - gr + 7) * 31 - gc + 15;
#pragma unroll
      for (int r = 0; r < 16; ++r) {
        int kc0 = crow(r, hh), kc1 = 32 + kc0;
        bool ok0 = rowok && (kc0 >= cs_) && (kc0 < cs_ + 16);
        bool ok1 = rowok && (kc1 >= cs_) && (kc1 < cs_ + 16);
        float b0 = sbias[ok0 ? brow + kc0 : 0], b1 = sbias[ok1 ? brow + kc1 : 0];
        p0[r] = ok0 ? p0[r] * C + b0 : -1e30f;
        p1[r] = ok1 ? p1[r] * C + b1 : -1e30f;
      }
      mx = p0[0];
#pragma unroll
      for (int r = 1; r < 16; ++r) mx = fmaxf(mx, p0[r]);
#pragma unroll
      for (int r = 0; r < 16; ++r) mx = fmaxf(mx, p1[r]);
      mx = fmaxf(mx, xor32(mx));
    } else {
      mx = p0[0];
#pragma unroll
      for (int r = 1; r < 16; ++r) mx = fmaxf(mx, p0[r]);
#pragma unroll
      for (int r = 0; r < 16; ++r) mx = fmaxf(mx, p1[r]);
      mx = fmaxf(mx, xor32(mx)) * C;
    }
    float mn, alpha;
    if (__all(mx - m <= 11.541560327111707f)) { mn = m; alpha = 1.f; }
    else { mn = fmaxf(m, mx); alpha = __builtin_amdgcn_exp2f(m - mn); m = mn; }
    f2_t ps2 = {0.f, 0.f};
    if (NA && j >= nt0) {
#pragma unroll
      for (int r = 0; r < 16; r += 2) {
        p0[r] = __builtin_amdgcn_exp2f(p0[r] - mn); p0[r + 1] = __builtin_amdgcn_exp2f(p0[r + 1] - mn);
        p1[r] = __builtin_amdgcn_exp2f(p1[r] - mn); p1[r + 1] = __builtin_amdgcn_exp2f(p1[r + 1] - mn);
        f2_t a = {p0[r], p0[r + 1]}, b = {p1[r], p1[r + 1]};
        ps2 += a; ps2 += b;
      }
    } else {
      const f2_t c2 = {C, C}, nm2 = {-mn, -mn};
#pragma unroll
      for (int r = 0; r < 16; r += 2) {
        f2_t a = {p0[r], p0[r + 1]}, b = {p1[r], p1[r + 1]};
        a = a * c2 + nm2; b = b * c2 + nm2;
        p0[r] = __builtin_amdgcn_exp2f(a[0]); p0[r + 1] = __builtin_amdgcn_exp2f(a[1]);
        p1[r] = __builtin_amdgcn_exp2f(b[0]); p1[r + 1] = __builtin_amdgcn_exp2f(b[1]);
        f2_t ea = {p0[r], p0[r + 1]}, eb = {p1[r], p1[r + 1]};
        ps2 += ea; ps2 += eb;
      }
    }
    float ps = ps2[0] + ps2[1];
    ps += xor32(ps);
    l = l * alpha + ps;
    if (__any(alpha != 1.f)) {
#pragma unroll
      for (int d = 0; d < 4; ++d)
#pragma unroll
        for (int r = 0; r < 16; ++r) o[d][r] *= alpha;
    }
    u32x4 w0 = {cvtpk(p0[0], p0[1]), cvtpk(p0[2], p0[3]), cvtpk(p0[4], p0[5]), cvtpk(p0[6], p0[7])};
    u32x4 w1 = {cvtpk(p0[8], p0[9]), cvtpk(p0[10], p0[11]), cvtpk(p0[12], p0[13]), cvtpk(p0[14], p0[15])};
    u32x4 w2 = {cvtpk(p1[0], p1[1]), cvtpk(p1[2], p1[3]), cvtpk(p1[4], p1[5]), cvtpk(p1[6], p1[7])};
    u32x4 w3 = {cvtpk(p1[8], p1[9]), cvtpk(p1[10], p1[11]), cvtpk(p1[12], p1[13]), cvtpk(p1[14], p1[15])};
    pa[0] = __builtin_bit_cast(bf16x8, w0); pa[1] = __builtin_bit_cast(bf16x8, w1);
    pa[2] = __builtin_bit_cast(bf16x8, w2); pa[3] = __builtin_bit_cast(bf16x8, w3);
  };
  auto pv = [&](const bf16x8* pa, const char* buf) {
#pragma unroll
    for (int d = 0; d < 4; ++d) {
      s16x4 lo[4], hi[4];
#pragma unroll
      for (int s = 0; s < 4; ++s) {
        lo[s] = __builtin_amdgcn_ds_read_tr16_b64_v4i16((s16x4 __attribute__((address_space(3)))*)(buf + vad[d] + (16 * s) * 256));
        hi[s] = __builtin_amdgcn_ds_read_tr16_b64_v4i16((s16x4 __attribute__((address_space(3)))*)(buf + vad[d] + (16 * s + 8) * 256));
      }
#pragma unroll
      for (int s = 0; s < 4; ++s) {
        bf16x8 vb = {lo[s][0], lo[s][1], lo[s][2], lo[s][3], hi[s][0], hi[s][1], hi[s][2], hi[s][3]};
        o[d] = mfma(vb, pa[s], o[d]);
      }
    }
  };

  if (!lag) {
    int sl = 0;
    for (int j = 0; j <= ntile; ++j) {
      asm volatile("s_waitcnt vmcnt(0)" ::: "memory");
      __builtin_amdgcn_s_barrier();
      const int sn = sl == 2 ? 0 : sl + 1;
      if (j + 1 < ntile) issue_tile(j + 1, sn);
      if (j < ntile) { bf16x8 pa[4]; qk_sm(pa, lds + sl * ATT_BUF, j); pv(pa, lds + sl * ATT_BUF); }
      sl = sn;
    }
  } else {
    bf16x8 pa[4];
    int sl = 0;
    for (int j = 0; j <= ntile; ++j) {
      asm volatile("s_waitcnt vmcnt(0)" ::: "memory");
      __builtin_amdgcn_s_barrier();
      const int sn = sl == 2 ? 0 : sl + 1, sp = sl == 0 ? 2 : sl - 1;
      if (j + 1 < ntile) issue_tile(j + 1, sn);
      if (j > 0) pv(pa, lds + sp * ATT_BUF);
      if (j < ntile) qk_sm(pa, lds + sl * ATT_BUF, j);
      sl = sn;
    }
  }
  const float linv = 1.f / l;
#pragma unroll
  for (int d = 0; d < 4; ++d)
#pragma unroll
    for (int r = 0; r < 16; ++r) o[d][r] *= linv;
}

DI float* tr_stage(const int tid, const f32x16* o, char* lds) {
  const int lane = tid & 63, wid = tid >> 6, r32 = lane & 31, hh = lane >> 5;
  float* tr = (float*)lds + wid * (32 * ATT_TR_ROW);
  __syncthreads();
#pragma unroll
  for (int d = 0; d < 4; ++d)
#pragma unroll
    for (int g = 0; g < 4; ++g) {
      f32x4 v = {o[d][4 * g], o[d][4 * g + 1], o[d][4 * g + 2], o[d][4 * g + 3]};
      *(f32x4*)(tr + r32 * ATT_TR_ROW + d * 32 + 8 * g + 4 * hh) = v;
    }
  return tr;
}

DI void store_gated(const int tid, const Params& p, const f32x16* o, int t0, int gcol, int ocol, char* lds) {
  const int lane = tid & 63, wid = tid >> 6;
  const bfu* P = (const bfu*)(p.ws + WS_PBUF);
  bfu* O = (bfu*)(p.ws + WS_HBUF);
  const float* tr = tr_stage(tid, o, lds);
#pragma unroll 1
  for (int r0 = 0; r0 < 32; r0 += 8) {
    unsigned g[8];
#pragma unroll
    for (int u = 0; u < 8; ++u) g[u] = *(const unsigned*)(P + (size_t)(t0 + wid * 32 + r0 + u) * EVEN_IN + gcol + lane * 2);
#pragma unroll
    for (int u = 0; u < 8; ++u) {
      f2_t v = *(const f2_t*)(tr + (r0 + u) * ATT_TR_ROW + lane * 2);
      *(unsigned*)(O + (size_t)(t0 + wid * 32 + r0 + u) * D + ocol + lane * 2) = cvtpk(v[0] * silu(bflo(g[u])), v[1] * silu(bfhi(g[u])));
    }
  }
}

DI int xcd_item(int item) {
  if (gridDim.x != 256) return item;
  const int blk = item & 255, sweep = item >> 8;
  const int xcd = blk & 7, slot = blk >> 3, gl = slot >> 3, qb = slot & 7;
  return sweep * 256 + ((gl * 8 + xcd) << 3) + qb;
}

DI void phase_attn_even(const Params& p, int li, char* lds) {
  const bfu* P = (const bfu*)(p.ws + WS_PBUF);
  const bfu* Qm = (const bfu*)(p.ws + WS_QM);
  const bfu* Km = (const bfu*)(p.ws + WS_KMLA);
  const bfu* Vm = (const bfu*)(p.ws + WS_VMLA);
  const bfu* cnk = (const bfu*)(p.ws + WS_C_NAK);
  const bfu* cnv = (const bfu*)(p.ws + WS_C_NAV);
  const float CM = 0.07216878364870322f * LOG2E;
  const float CN = 0.08838834764831845f * LOG2E;
  int item = blockIdx.x;
  for (; item < 512; item += gridDim.x) {
    const int tid = opaque(threadIdx.x), lane = tid & 63, wid = tid >> 6, r32 = lane & 31, hh = lane >> 5;
    f32x16 o[4];
    const int xi = xcd_item(item);
    int b = xi >> 6, hd = (xi >> 3) & 7, qb = xi & 7;
    int t0 = TP + b * 2048 + qb * 256;
    int trow = t0 + wid * 32 + r32;
    int s = qb * 256 + wid * 32 + r32;
    Seg s0 = {Km + (size_t)(T + b * 512) * 1536 + hd * 192, Vm + (size_t)(T + b * 512) * 1024 + hd * 128, 1536, 1024, 512};
    Seg s1 = {Km + (size_t)(TP + b * 2048) * 1536 + hd * 192, Vm + (size_t)(TP + b * 2048) * 1024 + hd * 128, 1536, 1024, 2048};
    attn_core<192, false, true>(tid, o, Qm + (size_t)trow * 1536 + hd * 192 + hh * 8, s0, s1, CM, lds, 0, 0, 0, (float)(s >> 6), (float)(s & 63));
    store_gated(tid, p, o, t0, 4928 + hd * 128, 1024 + hd * 128, lds);
  }
  for (; item < 1024; item += gridDim.x) {
    const int tid = opaque(threadIdx.x), lane = tid & 63, wid = tid >> 6, r32 = lane & 31, hh = lane >> 5;
    const int it = xcd_item(item - 512);
    f32x16 o[4];
    int b = it >> 6, hd = (it >> 3) & 7, qb = it & 7;
    int t0 = TP + b * 2048 + qb * 256;
    int trow = t0 + wid * 32 + r32;
    int qi = wid * 32 + r32;
    int gr = qb * 4 + (qi >> 6), gc = qi & 63;
    int kr0 = min(max(qb * 4 - 4, 0), 24);
    int kr1 = min(max(qb * 4 + 3 - 4, 0), 24) + 8;
    __syncthreads();
    float* sb = (float*)(lds + ATT_BIAS_OFF);
    for (int idx = tid; idx < 465; idx += 512) sb[idx] = p.in[16][(size_t)(li * 8 + hd) * 465 + idx] * LOG2E;
    Seg s0 = {cnk + (size_t)((b * 2 + li) * 512) * 1024 + hd * 128, cnv + (size_t)((b * 2 + li) * 512) * 1024 + hd * 128, 1024, 1024, 512};
    const bfu* Pl = P + (size_t)(TP + b * 2048 + kr0 * 64) * EVEN_IN;
    Seg s1 = {Pl + 1024 + hd * 128, Pl + 2048 + hd * 128, EVEN_IN, EVEN_IN, (kr1 - kr0) * 64};
    attn_core<128, true, false>(tid, o, P + (size_t)trow * EVEN_IN + hd * 128 + hh * 8, s0, s1, CN, lds, gr, gc, kr0, 0.f, 0.f);
    store_gated(tid, p, o, t0, 3072 + hd * 128, hd * 128, lds);
  }
  for (; item < 1280; item += gridDim.x) {
    const int tid = opaque(threadIdx.x), lane = tid & 63, wid = tid >> 6, r32 = lane & 31, hh = lane >> 5;
    const int it = item - 1024;
    f32x16 o[4];
    int b = it >> 3, hd = it & 7;
    int t0 = b * 256;
    int trow = t0 + wid * 32 + r32;
    Seg s0 = {Km + (size_t)(b * 256) * 1536 + hd * 192, Vm + (size_t)(b * 256) * 1024 + hd * 128, 1536, 1024, 256};
    Seg s1 = {s0.K, s0.V, 1536, 1024, 0};
    attn_core<192, false, false>(tid, o, Qm + (size_t)trow * 1536 + hd * 192 + hh * 8, s0, s1, CM, lds, 0, 0, 0, 0.f, 0.f);
    store_gated(tid, p, o, t0, 4928 + hd * 128, 1024 + hd * 128, lds);
  }
  for (; item < 1536; item += gridDim.x) {
    const int tid = opaque(threadIdx.x), lane = tid & 63, wid = tid >> 6, r32 = lane & 31, hh = lane >> 5;
    const int it = item - 1280;
    f32x16 o[4];
    int b = it >> 3, hd = it & 7;
    int t0 = b * 256;
    int trow = t0 + wid * 32 + r32;
    const bfu* Pb = P + (size_t)(b * 256) * EVEN_IN;
    Seg s0 = {Pb + 1024 + hd * 128, Pb + 2048 + hd * 128, EVEN_IN, EVEN_IN, 256};
    Seg s1 = {s0.K, s0.V, EVEN_IN, EVEN_IN, 0};
    attn_core<128, false, false>(tid, o, P + (size_t)trow * EVEN_IN + hd * 128 + hh * 8, s0, s1, CN, lds, 0, 0, 0, 0.f, 0.f);
    store_gated(tid, p, o, t0, 3072 + hd * 128, hd * 128, lds);
  }
}

DI void phase_attn_odd(const Params& p, int l, char* lds) {
  const int li = l >> 1;
  const bfu* P = (const bfu*)(p.ws + WS_PBUF);
  bfu* O = (bfu*)(p.ws + WS_HBUF);
  const bfu* cdk = (const bfu*)(p.ws + WS_C_DK);
  const bfu* cdv = (const bfu*)(p.ws + WS_C_DV);
  float* scr = (float*)(p.ws + WS_SCR) + (size_t)blockIdx.x * 65536;
  const float CD = 0.08838834764831845f * LOG2E;
  const float lam_init = 0.8f - 0.6f * expf(-0.3f * (float)l);
  float lam;
  {
    const float* lp = p.in[23] + li * 512;
    float s1 = 0.f, s2 = 0.f;
    for (int k = 0; k < 128; ++k) { s1 += lp[k] * lp[128 + k]; s2 += lp[256 + k] * lp[384 + k]; }
    lam = expf(s1) - expf(s2) + lam_init;
  }
  const float* gsub = p.in[24] + li * 256;
  for (int item = blockIdx.x; item < 768; item += gridDim.x) {
    const int tid = opaque(threadIdx.x), lane = tid & 63, wid = tid >> 6, r32 = lane & 31, hh = lane >> 5;
    int b, hd, t0; Seg s0, s1;
    if (item < 512) {
      const int xi = xcd_item(item);
      b = xi >> 6; hd = (xi >> 3) & 7; int qb = xi & 7;
      t0 = TP + b * 2048 + qb * 256;
      const bfu* Pl = P + (size_t)(TP + b * 2048) * ODD_IN;
      s0 = Seg{cdk + (size_t)((b * 2 + li) * 512) * 2048 + hd * 256, cdv + (size_t)((b * 2 + li) * 512) * 2048 + hd * 256, 2048, 2048, 512};
      s1 = Seg{Pl + 2048 + hd * 256, Pl + 4096 + hd * 256, ODD_IN, ODD_IN, 2048};
    } else {
      int it = item - 512;
      b = it >> 3; hd = it & 7;
      t0 = b * 256;
      const bfu* Pb = P + (size_t)(b * 256) * ODD_IN;
      s0 = Seg{Pb + 2048 + hd * 256, Pb + 4096 + hd * 256, ODD_IN, ODD_IN, 256};
      s1 = Seg{s0.K, s0.V, ODD_IN, ODD_IN, 0};
    }
    const int trow = t0 + wid * 32 + r32;
    float ssq = 0.f;
    for (int pass = 0; pass < 4; ++pass) {
      const int vh = pass >> 1, c = pass & 1;
      f32x16 o[4];
      Seg a0 = s0, a1 = s1;
      a0.K += c * 128; a1.K += c * 128; a0.V += vh * 128; a1.V += vh * 128;
      for (int rep = 0; rep < p.nrep; ++rep)
        attn_core<128, false, false>(tid, o, P + (size_t)trow * ODD_IN + hd * 256 + c * 128 + hh * 8, a0, a1, CD, lds, 0, 0, 0, 0.f, 0.f);
      float* sc = scr + vh * 32768 + tid;
      if (c == 1) {
        float ss = 0.f;
#pragma unroll
        for (int d = 0; d < 4; ++d)
#pragma unroll
          for (int r = 0; r < 16; ++r) {
            float dd = sc[(d * 16 + r) * 512] - lam * o[d][r];
            o[d][r] = dd; ss += dd * dd;
          }
        ssq += ss;
      }
#pragma unroll
      for (int d = 0; d < 4; ++d)
#pragma unroll
        for (int r = 0; r < 16; ++r) sc[(d * 16 + r) * 512] = o[d][r];
    }
    ssq += __shfl_xor(ssq, 32);
    const float rstd = rsqrtf(ssq * (1.f / 256.f) + EPS) * (1.f - lam_init);
    for (int half = 0; half < 2; ++half) {
      f32x16 o[4];
      const float* sc = scr + half * 32768 + tid;
#pragma unroll
      for (int d = 0; d < 4; ++d)
#pragma unroll
        for (int r = 0; r < 16; ++r) o[d][r] = sc[(d * 16 + r) * 512] * rstd;
      const float* tr = tr_stage(tid, o, lds);
      const int colb = hd * 256 + half * 128 + lane * 2;
      const float g0 = gsub[half * 128 + lane * 2], g1 = gsub[half * 128 + lane * 2 + 1];
#pragma unroll 1
      for (int r0 = 0; r0 < 32; r0 += 8) {
        unsigned g[8];
#pragma unroll
        for (int u = 0; u < 8; ++u) g[u] = *(const unsigned*)(P + (size_t)(t0 + wid * 32 + r0 + u) * ODD_IN + 6144 + colb);
#pragma unroll
        for (int u = 0; u < 8; ++u) {
          f2_t v = *(const f2_t*)(tr + (r0 + u) * ATT_TR_ROW + lane * 2);
          *(unsigned*)(O + (size_t)(t0 + wid * 32 + r0 + u) * D + colb) = cvtpk(v[0] * g0 * silu(bflo(g[u])), v[1] * g1 * silu(bfhi(g[u])));
        }
      }
    }
  }
}

#ifndef PM
#define PM 0xffff
#endif
template <int EPI>
DI void gemm_phase(const Params& p, const bfu* A, const bfu* Bt, int K, int nM, int nN, int li, char* lds) {
  const int ntiles = nM * nN;
  for (int it = 0; it * (int)gridDim.x < ntiles; ++it) {
    int id = tile_id(it);
    if (id >= ntiles) continue;
    int m, n; tile_mn(id, nN, m, n);
    gemm256<EPI>(p, A, Bt, K, m * 256, n * 256, li, lds);
  }
}

DI void run_phase(const Params& p, int ph, char* lds) {
  if (ph == 0) { if (PM & 1) phase_prep(p, lds); return; }
  if (ph == 1) { if (PM & 2) phase_rows(p, 0, 0, lds); return; }
  const int q = ph - 2, pair = q / 10, r = q % 10;
  const bfu* hbuf = (const bfu*)(p.ws + WS_HBUF);
  if (r < 6) {
    const int l = 2 * pair, li = pair;
    if (r == 0 && (PM & 4)) {
      gemm_phase<EPI_E1>(p, hbuf, (const bfu*)(p.ws + WS_WT_IN_E) + (size_t)li * EVEN_PAD * D, D, 96, 24, li, lds);
    } else if (r == 1 && (PM & 8)) {
      phase_mid(p, li);
    } else if (r == 2 && (PM & 16)) {
      gemm_phase<EPI_QM>(p, (const bfu*)(p.ws + WS_CQN), (const bfu*)(p.ws + WS_WT_UQ) + (size_t)li * 1536 * 512, 512, 96, 6, li, lds);
      gemm_phase<EPI_KV>(p, (const bfu*)(p.ws + WS_CKVN), (const bfu*)(p.ws + WS_WT_UKV) + (size_t)li * 2048 * 256, 256, 112, 8, li, lds);
    } else if (r == 3 && (PM & 32)) {
      phase_attn_even(p, li, lds);
    } else if (r == 4 && (PM & 64)) {
      gemm_phase<EPI_Y>(p, hbuf, (const bfu*)(p.ws + WS_WT_OUT_E) + (size_t)li * D * D, D, 96, 8, li, lds);
    } else if (r == 5 && (PM & 128)) {
      phase_rows(p, 1, l, lds);
    }
  } else {
    const int l = 2 * pair + 1, li = pair, k = r - 6;
    if (k == 0 && (PM & 256)) {
      gemm_phase<EPI_O1>(p, hbuf, (const bfu*)(p.ws + WS_WT_IN_O) + (size_t)li * ODD_IN * D, D, 96, 32, li, lds);
    } else if (k == 1 && (PM & 512)) {
      phase_attn_odd(p, l, lds);
    } else if (k == 2 && (PM & 1024)) {
      gemm_phase<EPI_Y>(p, hbuf, (const bfu*)(p.ws + WS_WT_OUT_O) + (size_t)li * D * D, D, 96, 8, li, lds);
    } else if (k == 3 && (PM & 2048)) {
      phase_rows(p, 1, l, lds);
    }
  }
}


#define XB_TMO      128
#define XB_XCNT(j)  (256  + 64 * (j))
#define XB_XSUB(j)  (1280 + 64 * (j))
#define XB_XGEN(j)  (2304 + 64 * (j))
#define XB_TOP      3328
#define XB_TOPGEN   3392
#define XCD_BAR_WORDS 3456
#define XB_SPIN_CAP (1u << 22)
#define LAS __attribute__((address_space(3)))
DI unsigned xb_ld(unsigned* p)              { return __hip_atomic_load(p, __ATOMIC_RELAXED, __HIP_MEMORY_SCOPE_AGENT); }
DI unsigned xb_add(unsigned* p, unsigned v) { return __hip_atomic_fetch_add(p, v, __ATOMIC_RELAXED, __HIP_MEMORY_SCOPE_AGENT); }
DI unsigned xb_xcc_id() { return (unsigned)__builtin_amdgcn_s_getreg((3 << 11) | 20) & 0xFu; }
#define XB_SPIN(cond, bar) do { unsigned _sp = 0; while (cond) { __builtin_amdgcn_s_sleep(1); \
    if ((++_sp & 255u) == 0u) { if (xb_ld(&(bar)[XB_TMO])) break; if (_sp > XB_SPIN_CAP) { atomicAdd(&(bar)[XB_TMO], 1u); break; } } } } while (0)
struct XcdBarrier { unsigned* bar; unsigned x; volatile LAS unsigned* st; };
DI XcdBarrier xcd_barrier_post(unsigned* bar, volatile LAS unsigned* st) {
  XcdBarrier b; b.bar = bar; b.x = xb_xcc_id(); b.st = st;
  if (threadIdx.x == 0) (void)xb_add(&bar[XB_XCNT(b.x)], 1u);
  return b;
}
DI void xcd_barrier_complete(unsigned* bar, unsigned x, unsigned& nloc, unsigned& nx) {
  const unsigned G = gridDim.x * gridDim.y * gridDim.z;
  unsigned sum, cnt, mine, sp = 0u;
  for (;;) {
    sum = 0u; cnt = 0u; mine = 0u;
#pragma unroll
    for (unsigned j = 0; j < 16; ++j) { const unsigned c = xb_ld(&bar[XB_XCNT(j)]); sum += c; cnt += (c > 0u) ? 1u : 0u; mine = (j == x) ? c : mine; }
    if (sum == G) break;
    __builtin_amdgcn_s_sleep(1);
    if ((++sp & 255u) == 0u) { if (xb_ld(&bar[XB_TMO])) break; if (sp > XB_SPIN_CAP) { atomicAdd(&bar[XB_TMO], 1u); break; } }
  }
  nloc = mine > 0u ? mine : 1u; nx = cnt > 0u ? cnt : 1u;
}
DI void xcd_barrier(const XcdBarrier& b) {
  asm volatile("s_waitcnt vmcnt(0)" ::: "memory");
  __syncthreads();
  if (threadIdx.x == 0) {
    unsigned* bar = b.bar;
    __builtin_amdgcn_s_waitcnt(0);
    unsigned nloc = b.st[0], nx = b.st[1];
    if (nloc == 0u) { xcd_barrier_complete(bar, b.x, nloc, nx); b.st[0] = nloc; b.st[1] = nx; }
    const unsigned old = xb_add(&bar[XB_XSUB(b.x)], 1u);
    const unsigned gen = old / nloc;
    if (old + 1u == (gen + 1u) * nloc) {
      __builtin_amdgcn_fence(__ATOMIC_RELEASE, "agent");
      asm volatile("s_waitcnt vmcnt(0)" ::: "memory");
      const unsigned og = xb_add(&bar[XB_TOP], 1u);
      const unsigned tg = og / nx;
      if (og + 1u == (tg + 1u) * nx) xb_add(&bar[XB_TOPGEN], 1u);
      else XB_SPIN(xb_ld(&bar[XB_TOPGEN]) == tg, bar);
      __builtin_amdgcn_fence(__ATOMIC_ACQUIRE, "agent");
      xb_add(&bar[XB_XGEN(b.x)], 1u);
      asm volatile("s_waitcnt vmcnt(0)" ::: "memory");
    } else {
      XB_SPIN(xb_ld(&bar[XB_XGEN(b.x)]) == gen, bar);
      __builtin_amdgcn_fence(__ATOMIC_ACQUIRE, "agent");
      asm volatile("s_waitcnt vmcnt(0)" ::: "memory");
    }
  }
  __syncthreads();
}

constexpr int N_PHASES = 22;
constexpr int LDS_BYTES = 8 * 32 * ATT_TR_ROW * 4;

__global__ void __launch_bounds__(512, 2) fwd_megakernel(Params p) {
  __shared__ __attribute__((aligned(16))) char lds[LDS_BYTES];
  __shared__ uint4 xb_words;
  cg::grid_group grid = cg::this_grid();
  if (threadIdx.x == 0) xb_words = make_uint4(0u, 0u, 0u, 0u);
  __syncthreads();
  XcdBarrier xb = xcd_barrier_post((unsigned*)(p.ws + WS_BAR), (volatile LAS unsigned*)&xb_words);
  for (int ph = p.lo; ph < p.hi; ++ph) {
    run_phase(p, ph, lds);
    if (ph + 1 < p.hi) { if (ph < 0) grid.sync(); else xcd_barrier(xb); }
  }
}

extern "C" void kernel_launch(void* const* d_in, const int* in_sizes, int n_in, void* d_out, int out_size, void* d_ws, size_t ws_size,
                              hipStream_t stream) {
  static int grid_blocks = 0;
  if (!grid_blocks) {
    int dev = 0, cus = 0, per_cu = 0;
    (void)hipGetDevice(&dev);
    (void)hipDeviceGetAttribute(&cus, hipDeviceAttributeMultiprocessorCount, dev);
    (void)hipOccupancyMaxActiveBlocksPerMultiprocessor(&per_cu, fwd_megakernel, 512, 0);
    if (per_cu < 1) per_cu = 1;
    per_cu = 1;
    grid_blocks = cus * per_cu;
    if (grid_blocks > 512) grid_blocks = 512;
  }
  if (n_in != 25 || ws_size < WS_NEED) {
    fprintf(stderr, "kernel_launch: bad n_in %d or ws_size %zu < %zu\n", n_in, ws_size, (size_t)WS_NEED);
    return;
  }
  Params p{};
  for (int i = 0; i < 25; ++i) p.in[i] = (const float*)d_in[i];
  p.out = (float*)d_out;
  p.ws = (char*)d_ws;
#ifndef NREP
#define NREP 1
#endif
  p.nrep = NREP; p.pad = 0;
#ifndef PROBE_PHASE
  p.lo = 0; p.hi = N_PHASES;
  void* args[] = {&p};
  (void)hipMemsetAsync((char*)d_ws + WS_BAR, 0, 16384, stream);
  hipError_t e = hipLaunchCooperativeKernel((void*)fwd_megakernel, dim3(grid_blocks), dim3(512), args, 0, stream);
  if (e != hipSuccess) fprintf(stderr, "cooperative launch failed: %s (grid %d)\n", hipGetErrorString(e), grid_blocks);
#else
  void* args[] = {&p};
  p.lo = 0; p.hi = PROBE_PHASE + 1;
  (void)hipMemsetAsync((char*)d_ws + WS_BAR, 0, 16384, stream);
  (void)hipLaunchCooperativeKernel((void*)fwd_megakernel, dim3(grid_blocks), dim3(512), args, 0, stream);
  p.lo = PROBE_PHASE; p.hi = N_PHASES;
  (void)hipMemsetAsync((char*)d_ws + WS_BAR, 0, 16384, stream);
  (void)hipLaunchCooperativeKernel((void*)fwd_megakernel, dim3(grid_blocks), dim3(512), args, 0, stream);
#endif
}
```

```cpp
#include <hip/hip_runtime.h>
#include <hip/hip_cooperative_groups.h>
#include <cstdio>
#include <cstdint>
namespace cg = cooperative_groups;

#define DI __device__ __forceinline__
typedef unsigned short bfu;
using bf16x8 = __attribute__((ext_vector_type(8))) short;
using s16x4  = __attribute__((ext_vector_type(4))) short;
using f32x16 = __attribute__((ext_vector_type(16))) float;
using f32x4  = __attribute__((ext_vector_type(4))) float;
using u32x4  = __attribute__((ext_vector_type(4))) unsigned;
using u32x2  = __attribute__((ext_vector_type(2))) unsigned;
typedef __bf16 bf2_t __attribute__((ext_vector_type(2)));
typedef float f2_t __attribute__((ext_vector_type(2)));

constexpr int D = 2048, TP = 8192, TS = 16384, T = 24576, TALL = 28672;
constexpr int EVEN_IN = 5952, ODD_IN = 8192;
constexpr float EPS = 1e-6f;
constexpr float LOG2E = 1.4426950408889634f;
constexpr float LOG2_ROPE = 13.287712379549449f;

constexpr size_t OUT_YP = 0, OUT_YS = 16777216, OUT_NAK = 50331648, OUT_NAV = 67108864, OUT_CKV = 83886080,
                 OUT_KPE = 88080384, OUT_DK = 89128960, OUT_DV = 122683392;

constexpr size_t al256(size_t x) { return (x + 255) / 256 * 256; }
constexpr size_t WS_WT_IN_E = 0;
constexpr int EVEN_PAD = 6144;
constexpr size_t WS_WT_IN_O = WS_WT_IN_E + al256((size_t)2 * EVEN_PAD * D * 2);
constexpr size_t WS_WT_OUT_E = WS_WT_IN_O + al256((size_t)2 * ODD_IN * D * 2);
constexpr size_t WS_WT_OUT_O = WS_WT_OUT_E + al256((size_t)2 * D * D * 2);
constexpr size_t WS_WT_UQ = WS_WT_OUT_O + al256((size_t)2 * D * D * 2);
constexpr size_t WS_WT_UKV = WS_WT_UQ + al256((size_t)2 * 1536 * 512 * 2);
constexpr size_t WS_C_NAK = WS_WT_UKV + al256((size_t)2 * 2048 * 256 * 2);
constexpr size_t WS_C_NAV = WS_C_NAK + al256((size_t)8 * 2 * 512 * 1024 * 2);
constexpr size_t WS_C_DK = WS_C_NAV + al256((size_t)8 * 2 * 512 * 1024 * 2);
constexpr size_t WS_C_DV = WS_C_DK + al256((size_t)8 * 2 * 512 * 2048 * 2);
constexpr size_t WS_MODP = WS_C_DV + al256((size_t)8 * 2 * 512 * 2048 * 2);
constexpr size_t WS_BAR = WS_MODP + al256((size_t)4 * 4 * 9 * 6144 * 4);
constexpr size_t WS_HBUF = WS_BAR + 16384;
constexpr size_t WS_CQN = WS_HBUF;
constexpr size_t WS_CKVN = WS_HBUF + al256((size_t)T * 512 * 2);
constexpr size_t WS_PBUF = WS_HBUF + al256((size_t)T * D * 2);
constexpr size_t WS_YBUF = WS_PBUF;
constexpr size_t WS_QM = WS_PBUF + al256((size_t)T * EVEN_IN * 2);
constexpr size_t WS_KMLA = WS_QM + al256((size_t)T * 1536 * 2);
constexpr size_t WS_VMLA = WS_KMLA + al256((size_t)TALL * 1536 * 2);
constexpr size_t WS_END_EVEN = WS_VMLA + al256((size_t)TALL * 1024 * 2);
constexpr size_t WS_SCR = WS_PBUF + al256((size_t)T * ODD_IN * 2);
constexpr size_t WS_END_ODD = WS_SCR + (size_t)1024 * 131072;
constexpr size_t WS_NEED = WS_END_EVEN > WS_END_ODD ? WS_END_EVEN : WS_END_ODD;

struct Params {
  const float* in[25];
  float* out;
  char* ws;
  int lo, hi;
  int nrep, pad;
};

DI unsigned cvtpk(float lo, float hi) {
  f2_t v = {lo, hi};
  bf2_t b = __builtin_convertvector(v, bf2_t);
  return __builtin_bit_cast(unsigned, b);
}
DI bfu f2bf(float x) { return (bfu)(cvtpk(x, 0.f) & 0xffffu); }
DI float bf2f(bfu b) { return __uint_as_float(((unsigned)b) << 16); }
DI float bflo(unsigned u) { return __uint_as_float(u << 16); }
DI float bfhi(unsigned u) { return __uint_as_float(u & 0xffff0000u); }
DI int opaque(int x) { asm volatile("" : "+v"(x)); return x; }
DI int crow(int r, int hi) { return (r & 3) + 8 * (r >> 2) + 4 * hi; }
DI float silu(float x) { return x * __builtin_amdgcn_rcpf(1.f + __expf(-x)); }
DI f32x16 mfma(bf16x8 a, bf16x8 b, f32x16 c) { return __builtin_amdgcn_mfma_f32_32x32x16_bf16(a, b, c, 0, 0, 0); }
DI float xor32(float v) {
  auto rr = __builtin_amdgcn_permlane32_swap(__float_as_uint(v), __float_as_uint(v), false, false);
  return __uint_as_float((threadIdx.x & 32) ? rr[0] : rr[1]);
}
DI float wave_sum(float v) {
#pragma unroll
  for (int o = 32; o >= 1; o >>= 1) v += __shfl_xor(v, o);
  return v;
}
DI float block_sum(float v, float* red, int tid) {
  v = wave_sum(v);
  __syncthreads();
  if ((tid & 63) == 0) red[tid >> 6] = v;
  __syncthreads();
  const int hb = (tid >> 8) * 4;
  return red[hb] + red[hb + 1] + red[hb + 2] + red[hb + 3];
}
DI float modval(const Params& p, int l, int r, int n) {
  const float* mp = (const float*)(p.ws + WS_MODP);
  float s = p.in[11][l * 6144 + n];
#pragma unroll
  for (int ks = 0; ks < 4; ++ks) s += mp[((size_t)(ks * 4 + l) * 9 + r) * 6144 + n];
  return s;
}

DI void prep_mod_item(const Params& p, int item, char* lds) {
  const int tid = opaque(threadIdx.x), lane = tid & 63, wid = tid >> 6;
  const int ks = item & 3, cgp = (item >> 2) % 24, l = item / 96;
  float* scond = (float*)lds;
  float* red = (float*)(lds + 18432);
  for (int idx = tid; idx < 9 * 512; idx += 512) {
    int r = idx >> 9, kk = idx & 511;
    float cv = r < 8 ? p.in[8][r * 2048 + ks * 512 + kk] : p.in[9][ks * 512 + kk];
    scond[idx] = silu(cv);
  }
  __syncthreads();
  const float* W = p.in[10] + ((size_t)l * 2048 + ks * 512 + wid * 64) * 6144 + cgp * 256 + lane * 4;
  float acc[9][4];
#pragma unroll
  for (int r = 0; r < 9; ++r) { acc[r][0] = 0; acc[r][1] = 0; acc[r][2] = 0; acc[r][3] = 0; }
  for (int kk = 0; kk < 64; kk += 4) {
    f32x4 w[4];
#pragma unroll
    for (int u = 0; u < 4; ++u) w[u] = *(const f32x4*)(W + (size_t)(kk + u) * 6144);
#pragma unroll
    for (int u = 0; u < 4; ++u) {
#pragma unroll
      for (int r = 0; r < 9; ++r) {
        float s = scond[r * 512 + wid * 64 + kk + u];
        acc[r][0] += s * w[u][0]; acc[r][1] += s * w[u][1]; acc[r][2] += s * w[u][2]; acc[r][3] += s * w[u][3];
      }
    }
  }
#pragma unroll
  for (int r = 0; r < 9; ++r) {
    f32x4 v = {acc[r][0], acc[r][1], acc[r][2], acc[r][3]};
    *(f32x4*)(red + (wid * 9 + r) * 256 + lane * 4) = v;
  }
  __syncthreads();
  float* mp = (float*)(p.ws + WS_MODP);
  for (int idx = tid; idx < 9 * 256; idx += 512) {
    int r = idx >> 8, cc = idx & 255;
    float s = 0.f;
#pragma unroll
    for (int w = 0; w < 8; ++w) s += red[(w * 9 + r) * 256 + cc];
    mp[((size_t)(ks * 4 + l) * 9 + r) * 6144 + cgp * 256 + cc] = s;
  }
  __syncthreads();
}

DI int swap45(int n) { return (n & ~0x30) | ((n & 0x10) << 1) | ((n & 0x20) >> 1); }

DI void prep_transpose_tile(const float* __restrict__ src, bfu* __restrict__ dst, int K, int N, int k0, int n0, char* lds, int tid) {
  float* tl = (float*)lds + (tid >> 8) * (64 * 65);
  const int t4 = tid & 255;
#pragma unroll
  for (int i = 0; i < 4; ++i) {
    int kr = (t4 >> 4) + 16 * i, nc = (t4 & 15) * 4;
    f32x4 v = *(const f32x4*)(src + (size_t)(k0 + kr) * N + n0 + nc);
    tl[kr * 65 + nc + 0] = v[0]; tl[kr * 65 + nc + 1] = v[1]; tl[kr * 65 + nc + 2] = v[2]; tl[kr * 65 + nc + 3] = v[3];
  }
  __syncthreads();
  {
    int n = t4 >> 2, kseg = (t4 & 3) * 16;
    unsigned w[8];
#pragma unroll
    for (int e = 0; e < 8; ++e) w[e] = cvtpk(tl[(kseg + 2 * e) * 65 + n], tl[(kseg + 2 * e + 1) * 65 + n]);
    u32x4 a = {w[0], w[1], w[2], w[3]}, b = {w[4], w[5], w[6], w[7]};
    bfu* d = dst + (size_t)swap45(n0 + n) * K + k0 + kseg;
    *(u32x4*)d = a; *(u32x4*)(d + 8) = b;
  }
  __syncthreads();
}

DI void phase_prep(const Params& p, char* lds) {
  constexpr int N_MOD = 384, N_TR_L = 9440, N_TRP = N_TR_L, N_CV = 1536;
  for (int item = blockIdx.x; item < N_MOD + N_TRP + N_CV; item += gridDim.x) {
    if (item < N_MOD) { prep_mod_item(p, item, lds); continue; }
    const int tid = opaque(threadIdx.x);
    int it = item - N_MOD;
    if (it < N_TRP) {
      int tl = it * 2 + (tid >> 8);
      int i = tl / N_TR_L, r = tl % N_TR_L;
      const float* src; bfu* dst; int K, N;
      if (r < 2976) { src = p.in[14] + (size_t)i * 2048 * EVEN_IN; dst = (bfu*)(p.ws + WS_WT_IN_E) + (size_t)i * EVEN_PAD * 2048; K = 2048; N = EVEN_IN; }
      else if ((r -= 2976) < 1024) { src = p.in[15] + (size_t)i * 2048 * 2048; dst = (bfu*)(p.ws + WS_WT_OUT_E) + (size_t)i * 2048 * 2048; K = 2048; N = 2048; }
      else if ((r -= 1024) < 192) { src = p.in[18] + (size_t)i * 512 * 1536; dst = (bfu*)(p.ws + WS_WT_UQ) + (size_t)i * 1536 * 512; K = 512; N = 1536; }
      else if ((r -= 192) < 128) { src = p.in[20] + (size_t)i * 256 * 2048; dst = (bfu*)(p.ws + WS_WT_UKV) + (size_t)i * 2048 * 256; K = 256; N = 2048; }
      else if ((r -= 128) < 4096) { src = p.in[21] + (size_t)i * 2048 * ODD_IN; dst = (bfu*)(p.ws + WS_WT_IN_O) + (size_t)i * ODD_IN * 2048; K = 2048; N = ODD_IN; }
      else { r -= 4096; src = p.in[22] + (size_t)i * 2048 * 2048; dst = (bfu*)(p.ws + WS_WT_OUT_O) + (size_t)i * 2048 * 2048; K = 2048; N = 2048; }
      int nN = N / 64;
      int kt = r / nN, nt = r % nN;
      prep_transpose_tile(src, dst, K, N, kt * 64, nt * 64, lds, tid);
      continue;
    }
    it -= N_TRP;
    {
      size_t ch = (size_t)it * 4096;
      const float* src; bfu* dst;
      if (ch < 1048576) { src = p.in[2]; dst = (bfu*)(p.ws + WS_C_NAK); }
      else if ((ch -= 1048576) < 1048576) { src = p.in[3]; dst = (bfu*)(p.ws + WS_C_NAV); }
      else if ((ch -= 1048576) < 2097152) { src = p.in[6]; dst = (bfu*)(p.ws + WS_C_DK); }
      else { ch -= 2097152; src = p.in[7]; dst = (bfu*)(p.ws + WS_C_DV); }
#pragma unroll
      for (int u = 0; u < 8; ++u) {
        size_t c = ch + u * 512 + tid;
        f32x4 a = *(const f32x4*)(src + c * 8), b = *(const f32x4*)(src + c * 8 + 4);
        u32x4 w = {cvtpk(a[0], a[1]), cvtpk(a[2], a[3]), cvtpk(b[0], b[1]), cvtpk(b[2], b[3])};
        *(u32x4*)(dst + c * 8) = w;
      }
    }
  }
}

DI void phase_rows(const Params& p, int kind, int l, char* lds) {
  float* vA = (float*)lds; float* vSH = vA + 2048; float* vG = vSH + 2048;
  const int tid = opaque(threadIdx.x), lane = tid & 63, wid = tid >> 6;
  const int rows_per = ((T / 8 + gridDim.x - 1) / gridDim.x) * 8;
  const int t_begin = blockIdx.x * rows_per;
  const int t_end = min(T, t_begin + rows_per);
  const int ln = kind == 0 ? 0 : l + 1;
  const bool do_h = ln < 4;
  int cur_r = -1;
  bfu* hbuf = (bfu*)(p.ws + WS_HBUF);
  const bfu* ybuf = (const bfu*)(p.ws + WS_YBUF);
  for (int base = t_begin; base < t_end; base += 8) {
    const int r = base < TP ? 8 : (base - TP) >> 11;
    if (r != cur_r) {
      cur_r = r;
      __syncthreads();
#pragma unroll
      for (int e = 0; e < 4; ++e) {
        const int col = tid * 4 + e;
        if (do_h) {
          vSH[col] = modval(p, ln, r, col);
          vA[col] = (1.f + modval(p, ln, r, 2048 + col)) * p.in[12][ln * 2048 + col];
        }
        if (kind == 1) vG[col] = modval(p, l, r, 4096 + col) * p.in[13][l * 2048 + col];
      }
      __syncthreads();
    }
    const int t = base + wid;
    if (t < t_end) {
      const float* xin = (kind == 0 || l == 0) ? (t < TP ? p.in[0] + (size_t)t * D : p.in[1] + (size_t)(t - TP) * D) : p.out + (size_t)t * D;
      f32x4 x[8];
#pragma unroll
      for (int i = 0; i < 8; ++i) x[i] = *(const f32x4*)(xin + i * 256 + lane * 4);
      if (kind == 1) {
        f32x4 y[8];
#pragma unroll
        for (int i = 0; i < 8; ++i) {
          u32x2 w = *(const u32x2*)(ybuf + (size_t)t * D + i * 256 + lane * 4);
          y[i][0] = bflo(w[0]); y[i][1] = bfhi(w[0]); y[i][2] = bflo(w[1]); y[i][3] = bfhi(w[1]);
        }
        float ss = 0.f;
#pragma unroll
        for (int i = 0; i < 8; ++i) ss += y[i][0] * y[i][0] + y[i][1] * y[i][1] + y[i][2] * y[i][2] + y[i][3] * y[i][3];
        ss = wave_sum(ss);
        const float rstd = rsqrtf(ss * (1.f / 2048.f) + EPS);
#pragma unroll
        for (int i = 0; i < 8; ++i) {
          f32x4 g = *(const f32x4*)(vG + i * 256 + lane * 4);
          x[i][0] += g[0] * (y[i][0] * rstd); x[i][1] += g[1] * (y[i][1] * rstd);
          x[i][2] += g[2] * (y[i][2] * rstd); x[i][3] += g[3] * (y[i][3] * rstd);
          *(f32x4*)(p.out + (size_t)t * D + i * 256 + lane * 4) = x[i];
        }
      }
      if (do_h) {
        float ss = 0.f;
#pragma unroll
        for (int i = 0; i < 8; ++i) ss += x[i][0] * x[i][0] + x[i][1] * x[i][1] + x[i][2] * x[i][2] + x[i][3] * x[i][3];
        ss = wave_sum(ss);
        const float rstd = rsqrtf(ss * (1.f / 2048.f) + EPS);
#pragma unroll
        for (int i = 0; i < 8; ++i) {
          f32x4 a = *(const f32x4*)(vA + i * 256 + lane * 4), s = *(const f32x4*)(vSH + i * 256 + lane * 4);
          u32x2 w = {cvtpk(x[i][0] * rstd * a[0] + s[0], x[i][1] * rstd * a[1] + s[1]), cvtpk(x[i][2] * rstd * a[2] + s[2], x[i][3] * rstd * a[3] + s[3])};
          *(u32x2*)(hbuf + (size_t)t * D + i * 256 + lane * 4) = w;
        }
      }
    }
  }
}

constexpr int GBM = 256, GBK = 64, GHALF = 128, GHT = GHALF * GBK;
enum { EPI_E1 = 0, EPI_O1 = 1, EPI_QM = 2, EPI_KV = 3, EPI_Y = 4 };

DI int lds_byte(int r, int c) {
  int st = (r >> 4) * 2 + (c >> 5), rr = r & 15, cc = c & 31, ob = rr * 64 + cc * 2;
  return st * 1024 + (ob ^ (((ob >> 9) & 1) << 5));
}
DI void stage_rc(int b, int& R, int& C) {
  int st = b / 1024, sb = b % 1024, swz = sb ^ (((sb >> 9) & 1) << 5);
  R = (st >> 1) * 16 + swz / 64; C = (st & 1) * 32 + (swz % 64) / 2;
}

template <int EPI>
DI void gemm256(const Params& p, const bfu* __restrict__ A, const bfu* __restrict__ Bt, const int K, const int brow, const int bcol,
                const int li, char* lds) {
  const int tid = opaque(threadIdx.x);
  bfu* shm = (bfu*)lds;
#define SA(b, h) (shm + ((b) * 2 + (h)) * GHT)
#define SB(b, h) (shm + (4 + (b) * 2 + (h)) * GHT)
#define STAGE(P_, BASE, br, kt) do { long _g = (long)(br) * K + (long)(kt) * GBK;                          \
    for (int _i = 0; _i < 2; ++_i) { int _b = tid * 16 + _i * 8192; int _r, _c; stage_rc(_b, _r, _c);      \
      __builtin_amdgcn_global_load_lds((const unsigned*)(BASE + _g + (long)_r * K + _c),                    \
        (__attribute__((address_space(3))) unsigned*)((char*)(P_) + _b), 16, 0, 0); } } while (0)
#define LDA(dst, b, h) for (int m = 0; m < 4; ++m) for (int k = 0; k < 2; ++k)                              \
    dst[m][k] = *reinterpret_cast<const bf16x8*>((char*)SA(b, h) + lds_byte(wr * 64 + m * 16 + fr, k * 32 + fq * 8))
#define LDB(dst, b, h) for (int n = 0; n < 2; ++n) for (int k = 0; k < 2; ++k)                              \
    dst[n][k] = *reinterpret_cast<const bf16x8*>((char*)SB(b, h) + lds_byte(wc * 32 + n * 16 + fr, k * 32 + fq * 8))
#define MMA(ai, bj, At_, Bt_) do { __builtin_amdgcn_s_setprio(1);                                            \
    for (int m = 0; m < 4; ++m) for (int n = 0; n < 2; ++n) for (int k = 0; k < 2; ++k)                      \
      acc[ai][bj][m][n] = __builtin_amdgcn_mfma_f32_16x16x32_bf16(At_[m][k], Bt_[n][k], acc[ai][bj][m][n], 0, 0, 0); \
    __builtin_amdgcn_s_setprio(0); } while (0)
#define WAIT_V(n) asm volatile("s_waitcnt vmcnt(" #n ")" ::: "memory")
#define WAIT_L(n) asm volatile("s_waitcnt lgkmcnt(" #n ")" ::: "memory")
#define BAR __builtin_amdgcn_s_barrier()
#define SCHED __builtin_amdgcn_sched_barrier(0)
  const int wid = tid >> 6, lane = tid & 63, wr = wid >> 2, wc = wid & 3, fr = lane & 15, fq = lane >> 4;
  f32x4 acc[2][2][4][2];
#pragma unroll
  for (int a_ = 0; a_ < 2; ++a_)
#pragma unroll
    for (int b_ = 0; b_ < 2; ++b_)
#pragma unroll
      for (int m = 0; m < 4; ++m)
#pragma unroll
        for (int n = 0; n < 2; ++n) { acc[a_][b_][m][n][0] = 0.f; acc[a_][b_][m][n][1] = 0.f; acc[a_][b_][m][n][2] = 0.f; acc[a_][b_][m][n][3] = 0.f; }
  bf16x8 At[4][2], B0[2][2], B1[2][2];
  const int nt = K / GBK;
  WAIT_V(0); BAR;
  STAGE(SB(0, 0), Bt, bcol, 0); STAGE(SA(0, 0), A, brow, 0);
  STAGE(SB(0, 1), Bt, bcol + GHALF, 0); STAGE(SA(0, 1), A, brow + GHALF, 0);
  if (wr == 1) BAR;
  WAIT_V(4); BAR;
  STAGE(SB(1, 0), Bt, bcol, 1); STAGE(SA(1, 0), A, brow, 1); STAGE(SB(1, 1), Bt, bcol + GHALF, 1);
  WAIT_V(6); BAR;
  for (int t = 0; t < nt - 2; t += 2) {
    LDB(B0, 0, 0); SCHED; LDA(At, 0, 0); STAGE(SA(1, 1), A, brow + GHALF, t + 1);
    WAIT_L(8); BAR; WAIT_L(0); MMA(0, 0, At, B0); BAR; SCHED;
    LDB(B1, 0, 1); STAGE(SB(0, 0), Bt, bcol, t + 2);
    BAR; WAIT_L(0); MMA(0, 1, At, B1); BAR;
    LDA(At, 0, 1); STAGE(SA(0, 0), A, brow, t + 2);
    BAR; WAIT_L(0); MMA(1, 0, At, B0); BAR; SCHED;
    STAGE(SB(0, 1), Bt, bcol + GHALF, t + 2);
    WAIT_V(6); BAR; MMA(1, 1, At, B1); BAR;
    LDB(B0, 1, 0); SCHED; LDA(At, 1, 0); STAGE(SA(0, 1), A, brow + GHALF, t + 2);
    WAIT_L(8); BAR; WAIT_L(0); MMA(0, 0, At, B0); BAR; SCHED;
    LDB(B1, 1, 1); STAGE(SB(1, 0), Bt, bcol, t + 3);
    BAR; WAIT_L(0); MMA(0, 1, At, B1); BAR;
    LDA(At, 1, 1); STAGE(SA(1, 0), A, brow, t + 3);
    BAR; WAIT_L(0); MMA(1, 0, At, B0); BAR; SCHED;
    STAGE(SB(1, 1), Bt, bcol + GHALF, t + 3);
    WAIT_V(6); BAR; MMA(1, 1, At, B1); BAR;
  }
  { LDB(B0, 0, 0); LDA(At, 0, 0); STAGE(SA(1, 1), A, brow + GHALF, nt - 1);
    BAR; WAIT_L(0); MMA(0, 0, At, B0); BAR;
    LDB(B1, 0, 1); BAR; WAIT_L(0); MMA(0, 1, At, B1); BAR;
    LDA(At, 0, 1); WAIT_V(4); BAR; WAIT_L(0); MMA(1, 0, At, B0); MMA(1, 1, At, B1); BAR; }
  { LDB(B0, 1, 0); LDA(At, 1, 0); WAIT_V(2); BAR; WAIT_L(0); MMA(0, 0, At, B0); BAR;
    LDB(B1, 1, 1); WAIT_V(0); BAR; WAIT_L(0); MMA(0, 1, At, B1); BAR;
    LDA(At, 1, 1); BAR; WAIT_L(0); MMA(1, 0, At, B0); MMA(1, 1, At, B1); BAR; }
  if (wr == 0) BAR;
#undef SA
#undef SB
#undef STAGE
#undef LDA
#undef LDB
#undef MMA
#undef WAIT_V
#undef WAIT_L
#undef BAR
#undef SCHED

  const int jr = (wc & 1) * 16 + fr;
  if constexpr (EPI == EPI_O1) {
    if (brow >= TP && bcol < 4096) {
      const float inv = exp2f(-(float)jr * (LOG2_ROPE / 32.f));
      const bool colrope = (wc >> 1) & 1;
#pragma unroll
      for (int ai = 0; ai < 2; ++ai)
#pragma unroll
        for (int m = 0; m < 4; ++m)
#pragma unroll
          for (int j = 0; j < 4; ++j) {
            int row = brow + ai * 128 + wr * 64 + m * 16 + fq * 4 + j;
            int s = (row - TP) & 2047;
            float ang = (float)(colrope ? (s & 63) : (s >> 6)) * inv;
            float cs = __cosf(ang), sn = __sinf(ang);
#pragma unroll
            for (int bj = 0; bj < 2; ++bj) {
              float x1 = acc[ai][bj][m][0][j], x2 = acc[ai][bj][m][1][j];
              acc[ai][bj][m][0][j] = x1 * cs - x2 * sn;
              acc[ai][bj][m][1][j] = x2 * cs + x1 * sn;
            }
          }
    }
  }
  if constexpr (EPI == EPI_E1 || EPI == EPI_O1) {
    if (brow < TP) {
#pragma unroll
      for (int ai = 0; ai < 2; ++ai)
#pragma unroll
        for (int bj = 0; bj < 2; ++bj)
#pragma unroll
          for (int n = 0; n < 2; ++n) {
            const int colg = bcol + bj * 128 + (wc >> 1) * 64 + n * 32 + (wc & 1) * 16;
            const int col = colg + fr;
            float* dst = nullptr; int ldo = 0, c0 = 0;
            if constexpr (EPI == EPI_E1) {
              if (colg >= 1024 && colg < 2048) { dst = p.out + OUT_NAK; ldo = 1024; c0 = 1024; }
              else if (colg >= 2048 && colg < 3072) { dst = p.out + OUT_NAV; ldo = 1024; c0 = 2048; }
              else if (colg >= 4864 && colg < 4928) { dst = p.out + OUT_KPE; ldo = 64; c0 = 4864; }
            } else {
              if (colg >= 2048 && colg < 4096) { dst = p.out + OUT_DK; ldo = 2048; c0 = 2048; }
              else if (colg >= 4096 && colg < 6144) { dst = p.out + OUT_DV; ldo = 2048; c0 = 4096; }
            }
            if (dst) {
#pragma unroll
              for (int m = 0; m < 4; ++m)
#pragma unroll
                for (int j = 0; j < 4; ++j) {
                  const int row = brow + ai * 128 + wr * 64 + m * 16 + fq * 4 + j;
                  size_t orow = (size_t)((row >> 8) * 2 + li) * 256 + (row & 255);
                  dst[orow * ldo + (col - c0)] = acc[ai][bj][m][n][j];
                }
            }
          }
    }
  }
  constexpr int CT_ROW = 528;
#pragma unroll
  for (int ai = 0; ai < 2; ++ai)
#pragma unroll
    for (int bj = 0; bj < 2; ++bj)
#pragma unroll
      for (int n = 0; n < 2; ++n) {
        const int cl = bj * 128 + (wc >> 1) * 64 + n * 32 + (wc & 1) * 16 + fr;
#pragma unroll
        for (int m = 0; m < 4; ++m)
#pragma unroll
          for (int j = 0; j < 4; ++j) {
            const int rl = ai * 128 + wr * 64 + m * 16 + fq * 4 + j;
            *(bfu*)(lds + rl * CT_ROW + cl * 2) = f2bf(acc[ai][bj][m][n][j]);
          }
      }
  __syncthreads();
#pragma unroll 4
  for (int i = 0; i < 16; ++i) {
    const int c = tid + 512 * i, rl = c >> 5, cc = c & 31;
    const u32x4 w = *(const u32x4*)(lds + rl * CT_ROW + cc * 16);
    const size_t row = (size_t)(brow + rl);
    const int col = bcol + cc * 8;
    if constexpr (EPI == EPI_E1) {
      if (col < EVEN_IN) *(u32x4*)((bfu*)(p.ws + WS_PBUF) + row * EVEN_IN + col) = w;
    } else if constexpr (EPI == EPI_O1) {
      *(u32x4*)((bfu*)(p.ws + WS_PBUF) + row * ODD_IN + col) = w;
    } else if constexpr (EPI == EPI_QM) {
      *(u32x4*)((bfu*)(p.ws + WS_QM) + row * 1536 + col) = w;
    } else if constexpr (EPI == EPI_KV) {
      const int hd = col >> 8, jj = col & 255;
      if (jj < 128) *(u32x4*)((bfu*)(p.ws + WS_KMLA) + row * 1536 + hd * 192 + jj) = w;
      else *(u32x4*)((bfu*)(p.ws + WS_VMLA) + row * 1024 + hd * 128 + (jj - 128)) = w;
    } else {
      *(u32x4*)((bfu*)(p.ws + WS_YBUF) + row * D + col) = w;
    }
  }
}

DI int tile_id(int it) {
  const int G = gridDim.x;
  const int pb = (G & 7) == 0 ? (blockIdx.x & 7) * (G >> 3) + (blockIdx.x >> 3) : blockIdx.x;
  return it * G + pb;
}
DI void tile_mn(int id, int nN, int& m, int& n) {
  int grp = id / (8 * nN), rem = id % (8 * nN);
  m = grp * 8 + (rem & 7); n = rem >> 3;
}

DI void phase_mid(const Params& p, int li) {
  const int tid = opaque(threadIdx.x), lane = tid & 63, wid = tid >> 6;
  const bfu* P = (const bfu*)(p.ws + WS_PBUF);
  bfu* cqn = (bfu*)(p.ws + WS_CQN);
  bfu* ckvn = (bfu*)(p.ws + WS_CKVN);
  bfu* kmla = (bfu*)(p.ws + WS_KMLA);
  const float* gq = p.in[17] + li * 512;
  const float* gkv = p.in[19] + li * 256;
  for (int t = blockIdx.x * 8 + wid; t < TALL; t += gridDim.x * 8) {
    float kp;
    if (t < T) {
      const bfu* Pr = P + (size_t)t * EVEN_IN;
      {
        u32x4 w = *(const u32x4*)(Pr + 4096 + lane * 8);
        float v[8] = {bflo(w[0]), bfhi(w[0]), bflo(w[1]), bfhi(w[1]), bflo(w[2]), bfhi(w[2]), bflo(w[3]), bfhi(w[3])};
        float ss = 0;
#pragma unroll
        for (int e = 0; e < 8; ++e) ss += v[e] * v[e];
        ss = wave_sum(ss);
        float rstd = rsqrtf(ss * (1.f / 512.f) + EPS);
#pragma unroll
        for (int e = 0; e < 8; ++e) v[e] = v[e] * rstd * gq[lane * 8 + e];
        u32x4 o = {cvtpk(v[0], v[1]), cvtpk(v[2], v[3]), cvtpk(v[4], v[5]), cvtpk(v[6], v[7])};
        *(u32x4*)(cqn + (size_t)t * 512 + lane * 8) = o;
      }
      {
        u32x2 w = *(const u32x2*)(Pr + 4608 + lane * 4);
        float v[4] = {bflo(w[0]), bfhi(w[0]), bflo(w[1]), bfhi(w[1])};
        float ss = v[0] * v[0] + v[1] * v[1] + v[2] * v[2] + v[3] * v[3];
        ss = wave_sum(ss);
        float rstd = rsqrtf(ss * (1.f / 256.f) + EPS);
#pragma unroll
        for (int e = 0; e < 4; ++e) v[e] = v[e] * rstd * gkv[lane * 4 + e];
        u32x2 o = {cvtpk(v[0], v[1]), cvtpk(v[2], v[3])};
        *(u32x2*)(ckvn + (size_t)t * 256 + lane * 4) = o;
        if (t < TP) {
          size_t orow = (size_t)((t >> 8) * 2 + li) * 256 + (t & 255);
          f32x4 f = {v[0], v[1], v[2], v[3]};
          *(f32x4*)(p.out + OUT_CKV + orow * 256 + lane * 4) = f;
        }
      }
      kp = bf2f(Pr[4864 + lane]);
      if (t >= TP) {
        int s = (t - TP) & 2047;
        float pos = (float)(lane < 32 ? (s >> 6) : (s & 63));
        int jj = lane & 15;
        float inv = exp2f(-(float)jj * (LOG2_ROPE / 16.f));
        float ang = pos * inv;
        float cs = __cosf(ang), sn = __sinf(ang);
        float pv = __shfl_xor(kp, 16);
        kp = (lane & 16) ? (kp * cs + pv * sn) : (kp * cs - pv * sn);
      }
    } else {
      int ci = t - T;
      int b = ci >> 9, j = ci & 511;
      size_t crow_ = (size_t)(b * 2 + li) * 512 + j;
      f32x4 f = *(const f32x4*)(p.in[4] + crow_ * 256 + lane * 4);
      u32x2 o = {cvtpk(f[0], f[1]), cvtpk(f[2], f[3])};
      *(u32x2*)(ckvn + (size_t)t * 256 + lane * 4) = o;
      kp = p.in[5][crow_ * 64 + lane];
    }
    bfu kb = f2bf(kp);
#pragma unroll
    for (int hd = 0; hd < 8; ++hd) kmla[(size_t)t * 1536 + hd * 192 + 128 + lane] = kb;
  }
}

struct Seg { const bfu* K; const bfu* V; int ldk, ldv, n; };
constexpr int ATT_KB = 24576, ATT_VB = 16384, ATT_BUF = ATT_KB + ATT_VB;
constexpr int ATT_BIAS_OFF = 3 * ATT_BUF;
constexpr int ATT_TR_ROW = 132;

template <int DQK>
DI void attn_issue(const int tid, const bfu* __restrict__ Kp, const bfu* __restrict__ Vp, int ldk, int ldv, char* buf) {
  constexpr int KROWB = DQK * 2;
  const int r0 = tid >> 4;
  if constexpr (DQK == 128) {
    const unsigned offk = (unsigned)(r0 * ldk) * 2u + (unsigned)(((tid & 15) ^ (r0 & 7)) << 4);
#pragma unroll
    for (int i = 0; i < 2; ++i)
      __builtin_amdgcn_global_load_lds((const unsigned*)((const char*)(Kp + (size_t)(i * 32) * ldk) + offk),
                                       (__attribute__((address_space(3))) unsigned*)(buf + i * 8192 + tid * 16), 16, 0, 0);
  } else {
#pragma unroll
    for (int i = 0; i < DQK / 64; ++i) {
      int bb = i * 8192 + tid * 16, row = bb / KROWB, cpos = (bb % KROWB) >> 4, c = cpos ^ (row & 7);
      __builtin_amdgcn_global_load_lds((const unsigned*)(Kp + (size_t)row * ldk + c * 8),
                                       (__attribute__((address_space(3))) unsigned*)(buf + bb), 16, 0, 0);
    }
  }
  const unsigned offv = (unsigned)(r0 * ldv) * 2u + (unsigned)(((tid & 15) ^ ((r0 & 3) << 2)) << 4);
#pragma unroll
  for (int i = 0; i < 2; ++i)
    __builtin_amdgcn_global_load_lds((const unsigned*)((const char*)(Vp + (size_t)(i * 32) * ldv) + offv),
                                     (__attribute__((address_space(3))) unsigned*)(buf + ATT_KB + i * 8192 + tid * 16), 16, 0, 0);
}

template <int DQK, bool NA, bool ROPEQ>
DI void attn_core(const int tid, f32x16* o, const bfu* __restrict__ Qrow, const Seg& s0, const Seg& s1, float C, char* lds,
                  int gr, int gc, int kr0, float prow, float pcol) {
  constexpr int KROWB = DQK * 2;
  constexpr int ND = DQK / 16;
  const int lane = tid & 63, r32 = lane & 31, hh = lane >> 5;
  const bool lag = __builtin_amdgcn_readfirstlane(tid >> 8) != 0;
  const float* sbias = (const float*)(lds + ATT_BIAS_OFF);
  const int nt0 = s0.n >> 6, ntile = nt0 + (s1.n >> 6);
  auto issue_tile = [&](int jt, int slot) {
    const bool in0 = jt < nt0;
    const bfu* Kp = in0 ? s0.K + (size_t)(jt * 64) * s0.ldk : s1.K + (size_t)((jt - nt0) * 64) * s1.ldk;
    const bfu* Vp = in0 ? s0.V + (size_t)(jt * 64) * s0.ldv : s1.V + (size_t)((jt - nt0) * 64) * s1.ldv;
    attn_issue<DQK>(tid, Kp, Vp, in0 ? s0.ldk : s1.ldk, in0 ? s0.ldv : s1.ldv, lds + slot * ATT_BUF);
  };
  __syncthreads();
  issue_tile(0, 0);
  bf16x8 qr[ND];
#pragma unroll
  for (int d0 = 0; d0 < ND; ++d0) qr[d0] = *(const bf16x8*)(Qrow + d0 * 16);
  if constexpr (ROPEQ) {
#pragma unroll
    for (int pr = 0; pr < 2; ++pr) {
      float pos = pr == 0 ? prow : pcol;
      bf16x8 a = qr[8 + 2 * pr], b = qr[9 + 2 * pr];
      float xa[8], xb[8];
#pragma unroll
      for (int e = 0; e < 8; ++e) {
        float inv = exp2f(-(float)(8 * hh + e) * (LOG2_ROPE / 16.f));
        float ang = pos * inv;
        float cs = __cosf(ang), sn = __sinf(ang);
        float x1 = bf2f((bfu)a[e]), x2 = bf2f((bfu)b[e]);
        xa[e] = x1 * cs - x2 * sn; xb[e] = x2 * cs + x1 * sn;
      }
      u32x4 wa = {cvtpk(xa[0], xa[1]), cvtpk(xa[2], xa[3]), cvtpk(xa[4], xa[5]), cvtpk(xa[6], xa[7])};
      u32x4 wb = {cvtpk(xb[0], xb[1]), cvtpk(xb[2], xb[3]), cvtpk(xb[4], xb[5]), cvtpk(xb[6], xb[7])};
      qr[8 + 2 * pr] = __builtin_bit_cast(bf16x8, wa); qr[9 + 2 * pr] = __builtin_bit_cast(bf16x8, wb);
    }
  }
#pragma unroll
  for (int d = 0; d < 4; ++d)
#pragma unroll
    for (int r = 0; r < 16; ++r) o[d][r] = 0.f;
  float m = -1e30f, l = 0.f;
  const int rs = min(max(gr - 4, 0), 24), cs_ = min(max(gc - 8, 0), 48);
  int kad[4];
#pragma unroll
  for (int q = 0; q < 4; ++q) kad[q] = r32 * KROWB + (((q * 2 + hh) ^ (r32 & 7)) << 4);
  const int q_ = (lane & 15) >> 2;
  int vad[4];
#pragma unroll
  for (int d = 0; d < 4; ++d) vad[d] = ATT_KB + (hh * 4 + q_) * 256 + ((d ^ q_) << 6) + (16 * ((lane >> 4) & 1) + 4 * (lane & 3)) * 2;

  auto qk_sm = [&](bf16x8* pa, const char* buf, const int j) {
    f32x16 p0, p1;
#pragma unroll
    for (int r = 0; r < 16; ++r) { p0[r] = 0.f; p1[r] = 0.f; }
#pragma unroll
    for (int hb = 0; hb < ND; hb += 4) {
      bf16x8 k0[4], k1[4];
#pragma unroll
      for (int d = 0; d < 4; ++d) {
        k0[d] = *(const bf16x8*)(buf + kad[d] + (hb >> 2) * 128);
        k1[d] = *(const bf16x8*)(buf + kad[d] + (hb >> 2) * 128 + 32 * KROWB);
      }
      __builtin_amdgcn_sched_barrier(0);
#pragma unroll
      for (int d = 0; d < 4; ++d) {
        p0 = mfma(k0[d], qr[hb + d], p0);
        p1 = mfma(k1[d], qr[hb + d], p1);
      }
      __builtin_amdgcn_sched_barrier(0);
    }
    float mx;
    if (NA && j >= nt0) {
      const int kr = kr0 + (j - nt0);
      const bool rowok = (kr >= rs) && (kr < rs + 8);
      const int brow = (kr - gr + 7) * 31 - gc + 15;
#pragma unroll
      for (int r = 0; r < 16; ++r) {
        int kc0 = crow(r, hh), kc1 = 32 + kc0;
        bool ok0 = rowok && (kc0 >= cs_) && (kc0 < cs_ + 16);
        bool ok1 = rowok && (kc1 >= cs_) && (kc1 < cs_ + 16);
        float b0 = sbias[ok0 ? brow + kc0 : 0], b1 = sbias[ok1 ? brow + kc1 : 0];
        p0[r] = ok0 ? p0[r] * C + b0 : -1e30f;
        p1[r] = ok1 ? p1[r] * C + b1 : -1e30f;
      }
      mx = p0[0];
#pragma unroll
      for (int r = 1; r < 16; ++r) mx = fmaxf(mx, p0[r]);
#pragma unroll
      for (int r = 0; r < 16; ++r) mx = fmaxf(mx, p1[r]);
      mx = fmaxf(mx, xor32(mx));
    } else {
      mx = p0[0];
#pragma unroll
      for (int r = 1; r < 16; ++r) mx = fmaxf(mx, p0[r]);
#pragma unroll
      for (int r = 0; r < 16; ++r) mx = fmaxf(mx, p1[r]);
      mx = fmaxf(mx, xor32(mx)) * C;
    }
    float mn, alpha;
    if (__all(mx - m <= 11.541560327111707f)) { mn = m; alpha = 1.f; }
    else { mn = fmaxf(m, mx); alpha = __builtin_amdgcn_exp2f(m - mn); m = mn; }
    f2_t ps2 = {0.f, 0.f};
    if (NA && j >= nt0) {
#pragma unroll
      for (int r = 0; r < 16; r += 2) {
        p0[r] = __builtin_amdgcn_exp2f(p0[r] - mn); p0[r + 1] = __builtin_amdgcn_exp2f(p0[r + 1] - mn);
        p1[r] = __builtin_amdgcn_exp2f(p1[r] - mn); p1[r + 1] = __builtin_amdgcn_exp2f(p1[r + 1] - mn);
        f2_t a = {p0[r], p0[r + 1]}, b = {p1[r], p1[r + 1]};
        ps2 += a; ps2 += b;
      }
    } else {
      const f2_t c2 = {C, C}, nm2 = {-mn, -mn};
#pragma unroll
      for (int r = 0; r < 16; r += 2) {
        f2_t a = {p0[r], p0[r + 1]}, b = {p1[r], p1[r + 1]};
        a = a * c2 + nm2; b = b * c2 + nm2;
        p0[r] = __builtin_amdgcn_exp2f(a[0]); p0[r + 1] = __builtin_amdgcn_exp2f(a[1]);
        p1[r] = __builtin_amdgcn_exp2f(b[0]); p1[r + 1] = __builtin_amdgcn_exp2f(b[1]);
        f2_t ea = {p0[r], p0[r + 1]}, eb = {p1[r], p1[r + 1]};
        ps2 += ea; ps2 += eb;
      }
    }
    float ps = ps2[0] + ps2[1];
    ps += xor32(ps);
    l = l * alpha + ps;
    if (__any(alpha != 1.f)) {
#pragma unroll
      for (int d = 0; d < 4; ++d)
#pragma unroll
        for (int r = 0; r < 16; ++r) o[d][r] *= alpha;
    }
    u32x4 w0 = {cvtpk(p0[0], p0[1]), cvtpk(p0[2], p0[3]), cvtpk(p0[4], p0[5]), cvtpk(p0[6], p0[7])};
    u32x4 w1 = {cvtpk(p0[8], p0[9]), cvtpk(p0[10], p0[11]), cvtpk(p0[12], p0[13]), cvtpk(p0[14], p0[15])};
    u32x4 w2 = {cvtpk(p1[0], p1[1]), cvtpk(p1[2], p1[3]), cvtpk(p1[4], p1[5]), cvtpk(p1[6], p1[7])};
    u32x4 w3 = {cvtpk(p1[8], p1[9]), cvtpk(p1[10], p1[11]), cvtpk(p1[12], p1[13]), cvtpk(p1[14], p1[15])};
    pa[0] = __builtin_bit_cast(bf16x8, w0); pa[1] = __builtin_bit_cast(bf16x8, w1);
    pa[2] = __builtin_bit_cast(bf16x8, w2); pa[3] = __builtin_bit_cast(bf16x8, w3);
  };
  auto pv = [&](const bf16x8* pa, const char* buf) {
#pragma unroll
    for (int d = 0; d < 4; ++d) {
      s16x4 lo[4], hi[4];
#pragma unroll
      for (int s = 0; s < 4; ++s) {
        lo[s] = __builtin_amdgcn_ds_read_tr16_b64_v4i16((s16x4 __attribute__((address_space(3)))*)(buf + vad[d] + (16 * s) * 256));
        hi[s] = __builtin_amdgcn_ds_read_tr16_b64_v4i16((s16x4 __attribute__((address_space(3)))*)(buf + vad[d] + (16 * s + 8) * 256));
      }
#pragma unroll
      for (int s = 0; s < 4; ++s) {
        bf16x8 vb = {lo[s][0], lo[s][1], lo[s][2], lo[s][3], hi[s][0], hi[s][1], hi[s][2], hi[s][3]};
        o[d] = mfma(vb, pa[s], o[d]);
      }
    }
  };

  if (!lag) {
    int sl = 0;
    for (int j = 0; j <= ntile; ++j) {
      asm volatile("s_waitcnt vmcnt(0)" ::: "memory");
      __builtin_amdgcn_s_barrier();
      const int sn = sl == 2 ? 0 : sl + 1;
      if (j + 1 < ntile) issue_tile(j + 1, sn);
      if (j < ntile) { bf16x8 pa[4]; qk_sm(pa, lds + sl * ATT_BUF, j); pv(pa, lds + sl * ATT_BUF); }
      sl = sn;
    }
  } else {
    bf16x8 pa[4];
    int sl = 0;
    for (int j = 0; j <= ntile; ++j) {
      asm volatile("s_waitcnt vmcnt(0)" ::: "memory");
      __builtin_amdgcn_s_barrier();
      const int sn = sl == 2 ? 0 : sl + 1, sp = sl == 0 ? 2 : sl - 1;
      if (j + 1 < ntile) issue_tile(j + 1, sn);
      if (j > 0) pv(pa, lds + sp * ATT_BUF);
      if (j < ntile) qk_sm(pa, lds + sl * ATT_BUF, j);
      sl = sn;
    }
  }
  const float linv = 1.f / l;
#pragma unroll
  for (int d = 0; d < 4; ++d)
#pragma unroll
    for (int r = 0; r < 16; ++r) o[d][r] *= linv;
}

DI float* tr_stage(const int tid, const f32x16* o, char* lds) {
  const int lane = tid & 63, wid = tid >> 6, r32 = lane & 31, hh = lane >> 5;
  float* tr = (float*)lds + wid * (32 * ATT_TR_ROW);
  __syncthreads();
#pragma unroll
  for (int d = 0; d < 4; ++d)
#pragma unroll
    for (int g = 0; g < 4; ++g) {
      f32x4 v = {o[d][4 * g], o[d][4 * g + 1], o[d][4 * g + 2], o[d][4 * g + 3]};
      *(f32x4*)(tr + r32 * ATT_TR_ROW + d * 32 + 8 * g + 4 * hh) = v;
    }
  return tr;
}

DI void store_gated(const int tid, const Params& p, const f32x16* o, int t0, int gcol, int ocol, char* lds) {
  const int lane = tid & 63, wid = tid >> 6;
  const bfu* P = (const bfu*)(p.ws + WS_PBUF);
  bfu* O = (bfu*)(p.ws + WS_HBUF);
  const float* tr = tr_stage(tid, o, lds);
#pragma unroll 1
  for (int r0 = 0; r0 < 32; r0 += 8) {
    unsigned g[8];
#pragma unroll
    for (int u = 0; u < 8; ++u) g[u] = *(const unsigned*)(P + (size_t)(t0 + wid * 32 + r0 + u) * EVEN_IN + gcol + lane * 2);
#pragma unroll
    for (int u = 0; u < 8; ++u) {
      f2_t v = *(const f2_t*)(tr + (r0 + u) * ATT_TR_ROW + lane * 2);
      *(unsigned*)(O + (size_t)(t0 + wid * 32 + r0 + u) * D + ocol + lane * 2) = cvtpk(v[0] * silu(bflo(g[u])), v[1] * silu(bfhi(g[u])));
    }
  }
}

DI int xcd_item(int item) {
  if (gridDim.x != 256) return item;
  const int blk = item & 255, sweep = item >> 8;
  const int xcd = blk & 7, slot = blk >> 3, gl = slot >> 3, qb = slot & 7;
  return sweep * 256 + ((gl * 8 + xcd) << 3) + qb;
}

DI void phase_attn_even(const Params& p, int li, char* lds) {
  const bfu* P = (const bfu*)(p.ws + WS_PBUF);
  const bfu* Qm = (const bfu*)(p.ws + WS_QM);
  const bfu* Km = (const bfu*)(p.ws + WS_KMLA);
  const bfu* Vm = (const bfu*)(p.ws + WS_VMLA);
  const bfu* cnk = (const bfu*)(p.ws + WS_C_NAK);
  const bfu* cnv = (const bfu*)(p.ws + WS_C_NAV);
  const float CM = 0.07216878364870322f * LOG2E;
  const float CN = 0.08838834764831845f * LOG2E;
  int item = blockIdx.x;
  for (; item < 512; item += gridDim.x) {
    const int tid = opaque(threadIdx.x), lane = tid & 63, wid = tid >> 6, r32 = lane & 31, hh = lane >> 5;
    f32x16 o[4];
    const int xi = xcd_item(item);
    int b = xi >> 6, hd = (xi >> 3) & 7, qb = xi & 7;
    int t0 = TP + b * 2048 + qb * 256;
    int trow = t0 + wid * 32 + r32;
    int s = qb * 256 + wid * 32 + r32;
    Seg s0 = {Km + (size_t)(T + b * 512) * 1536 + hd * 192, Vm + (size_t)(T + b * 512) * 1024 + hd * 128, 1536, 1024, 512};
    Seg s1 = {Km + (size_t)(TP + b * 2048) * 1536 + hd * 192, Vm + (size_t)(TP + b * 2048) * 1024 + hd * 128, 1536, 1024, 2048};
    attn_core<192, false, true>(tid, o, Qm + (size_t)trow * 1536 + hd * 192 + hh * 8, s0, s1, CM, lds, 0, 0, 0, (float)(s >> 6), (float)(s & 63));
    store_gated(tid, p, o, t0, 4928 + hd * 128, 1024 + hd * 128, lds);
  }
  for (; item < 1024; item += gridDim.x) {
    const int tid = opaque(threadIdx.x), lane = tid & 63, wid = tid >> 6, r32 = lane & 31, hh = lane >> 5;
    const int it = xcd_item(item - 512);
    f32x16 o[4];
    int b = it >> 6, hd = (it >> 3) & 7, qb = it & 7;
    int t0 = TP + b * 2048 + qb * 256;
    int trow = t0 + wid * 32 + r32;
    int qi = wid * 32 + r32;
    int gr = qb * 4 + (qi >> 6), gc = qi & 63;
    int kr0 = min(max(qb * 4 - 4, 0), 24);
    int kr1 = min(max(qb * 4 + 3 - 4, 0), 24) + 8;
    __syncthreads();
    float* sb = (float*)(lds + ATT_BIAS_OFF);
    for (int idx = tid; idx < 465; idx += 512) sb[idx] = p.in[16][(size_t)(li * 8 + hd) * 465 + idx] * LOG2E;
    Seg s0 = {cnk + (size_t)((b * 2 + li) * 512) * 1024 + hd * 128, cnv + (size_t)((b * 2 + li) * 512) * 1024 + hd * 128, 1024, 1024, 512};
    const bfu* Pl = P + (size_t)(TP + b * 2048 + kr0 * 64) * EVEN_IN;
    Seg s1 = {Pl + 1024 + hd * 128, Pl + 2048 + hd * 128, EVEN_IN, EVEN_IN, (kr1 - kr0) * 64};
    attn_core<128, true, false>(tid, o, P + (size_t)trow * EVEN_IN + hd * 128 + hh * 8, s0, s1, CN, lds, gr, gc, kr0, 0.f, 0.f);
    store_gated(tid, p, o, t0, 3072 + hd * 128, hd * 128, lds);
  }
  for (; item < 1280; item += gridDim.x) {
    const int tid = opaque(threadIdx.x), lane = tid & 63, wid = tid >> 6, r32 = lane & 31, hh = lane >> 5;
    const int it = item - 1024;
    f32x16 o[4];
    int b = it >> 3, hd = it & 7;
    int t0 = b * 256;
    int trow = t0 + wid * 32 + r32;
    Seg s0 = {Km + (size_t)(b * 256) * 1536 + hd * 192, Vm + (size_t)(b * 256) * 1024 + hd * 128, 1536, 1024, 256};
    Seg s1 = {s0.K, s0.V, 1536, 1024, 0};
    attn_core<192, false, false>(tid, o, Qm + (size_t)trow * 1536 + hd * 192 + hh * 8, s0, s1, CM, lds, 0, 0, 0, 0.f, 0.f);
    store_gated(tid, p, o, t0, 4928 + hd * 128, 1024 + hd * 128, lds);
  }
  for (; item < 1536; item += gridDim.x) {
    const int tid = opaque(threadIdx.x), lane = tid & 63, wid = tid >> 6, r32 = lane & 31, hh = lane >> 5;
    const int it = item - 1280;
    f32x16 o[4];
    int b = it >> 3, hd = it & 7;
    int t0 = b * 256;
    int trow = t0 + wid * 32 + r32;
    const bfu* Pb = P + (size_t)(b * 256) * EVEN_IN;
    Seg s0 = {Pb + 1024 + hd * 128, Pb + 2048 + hd * 128, EVEN_IN, EVEN_IN, 256};
    Seg s1 = {s0.K, s0.V, EVEN_IN, EVEN_IN, 0};
    attn_core<128, false, false>(tid, o, P + (size_t)trow * EVEN_IN + hd * 128 + hh * 8, s0, s1, CN, lds, 0, 0, 0, 0.f, 0.f);
    store_gated(tid, p, o, t0, 3072 + hd * 128, hd * 128, lds);
  }
}

DI void phase_attn_odd(const Params& p, int l, char* lds) {
  const int li = l >> 1;
  const bfu* P = (const bfu*)(p.ws + WS_PBUF);
  bfu* O = (bfu*)(p.ws + WS_HBUF);
  const bfu* cdk = (const bfu*)(p.ws + WS_C_DK);
  const bfu* cdv = (const bfu*)(p.ws + WS_C_DV);
  float* scr = (float*)(p.ws + WS_SCR) + (size_t)blockIdx.x * 65536;
  const float CD = 0.08838834764831845f * LOG2E;
  const float lam_init = 0.8f - 0.6f * expf(-0.3f * (float)l);
  float lam;
  {
    const float* lp = p.in[23] + li * 512;
    float s1 = 0.f, s2 = 0.f;
    for (int k = 0; k < 128; ++k) { s1 += lp[k] * lp[128 + k]; s2 += lp[256 + k] * lp[384 + k]; }
    lam = expf(s1) - expf(s2) + lam_init;
  }
  const float* gsub = p.in[24] + li * 256;
  for (int item = blockIdx.x; item < 768; item += gridDim.x) {
    const int tid = opaque(threadIdx.x), lane = tid & 63, wid = tid >> 6, r32 = lane & 31, hh = lane >> 5;
    int b, hd, t0; Seg s0, s1;
    if (item < 512) {
      const int xi = xcd_item(item);
      b = xi >> 6; hd = (xi >> 3) & 7; int qb = xi & 7;
      t0 = TP + b * 2048 + qb * 256;
      const bfu* Pl = P + (size_t)(TP + b * 2048) * ODD_IN;
      s0 = Seg{cdk + (size_t)((b * 2 + li) * 512) * 2048 + hd * 256, cdv + (size_t)((b * 2 + li) * 512) * 2048 + hd * 256, 2048, 2048, 512};
      s1 = Seg{Pl + 2048 + hd * 256, Pl + 4096 + hd * 256, ODD_IN, ODD_IN, 2048};
    } else {
      int it = item - 512;
      b = it >> 3; hd = it & 7;
      t0 = b * 256;
      const bfu* Pb = P + (size_t)(b * 256) * ODD_IN;
      s0 = Seg{Pb + 2048 + hd * 256, Pb + 4096 + hd * 256, ODD_IN, ODD_IN, 256};
      s1 = Seg{s0.K, s0.V, ODD_IN, ODD_IN, 0};
    }
    const int trow = t0 + wid * 32 + r32;
    float ssq = 0.f;
    for (int pass = 0; pass < 4; ++pass) {
      const int vh = pass >> 1, c = pass & 1;
      f32x16 o[4];
      Seg a0 = s0, a1 = s1;
      a0.K += c * 128; a1.K += c * 128; a0.V += vh * 128; a1.V += vh * 128;
      for (int rep = 0; rep < p.nrep; ++rep)
        attn_core<128, false, false>(tid, o, P + (size_t)trow * ODD_IN + hd * 256 + c * 128 + hh * 8, a0, a1, CD, lds, 0, 0, 0, 0.f, 0.f);
      float* sc = scr + vh * 32768 + tid;
      if (c == 1) {
        float ss = 0.f;
#pragma unroll
        for (int d = 0; d < 4; ++d)
#pragma unroll
          for (int r = 0; r < 16; ++r) {
            float dd = sc[(d * 16 + r) * 512] - lam * o[d][r];
            o[d][r] = dd; ss += dd * dd;
          }
        ssq += ss;
      }
#pragma unroll
      for (int d = 0; d < 4; ++d)
#pragma unroll
        for (int r = 0; r < 16; ++r) sc[(d * 16 + r) * 512] = o[d][r];
    }
    ssq += __shfl_xor(ssq, 32);
    const float rstd = rsqrtf(ssq * (1.f / 256.f) + EPS) * (1.f - lam_init);
    for (int half = 0; half < 2; ++half) {
      f32x16 o[4];
      const float* sc = scr + half * 32768 + tid;
#pragma unroll
      for (int d = 0; d < 4; ++d)
#pragma unroll
        for (int r = 0; r < 16; ++r) o[d][r] = sc[(d * 16 + r) * 512] * rstd;
      const float* tr = tr_stage(tid, o, lds);
      const int colb = hd * 256 + half * 128 + lane * 2;
      const float g0 = gsub[half * 128 + lane * 2], g1 = gsub[half * 128 + lane * 2 + 1];
#pragma unroll 1
      for (int r0 = 0; r0 < 32; r0 += 8) {
        unsigned g[8];
#pragma unroll
        for (int u = 0; u < 8; ++u) g[u] = *(const unsigned*)(P + (size_t)(t0 + wid * 32 + r0 + u) * ODD_IN + 6144 + colb);
#pragma unroll
        for (int u = 0; u < 8; ++u) {
          f2_t v = *(const f2_t*)(tr + (r0 + u) * ATT_TR_ROW + lane * 2);
          *(unsigned*)(O + (size_t)(t0 + wid * 32 + r0 + u) * D + colb) = cvtpk(v[0] * g0 * silu(bflo(g[u])), v[1] * g1 * silu(bfhi(g[u])));
        }
      }
    }
  }
}

#ifndef PM
#define PM 0xffff
#endif
template <int EPI>
DI void gemm_phase(const Params& p, const bfu* A, const bfu* Bt, int K, int nM, int nN, int li, char* lds) {
  const int ntiles = nM * nN;
  for (int it = 0; it * (int)gridDim.x < ntiles; ++it) {
    int id = tile_id(it);
    if (id >= ntiles) continue;
    int m, n; tile_mn(id, nN, m, n);
    gemm256<EPI>(p, A, Bt, K, m * 256, n * 256, li, lds);
  }
}

DI void run_phase(const Params& p, int ph, char* lds) {
  if (ph == 0) { if (PM & 1) phase_prep(p, lds); return; }
  if (ph == 1) { if (PM & 2) phase_rows(p, 0, 0, lds); return; }
  const int q = ph - 2, pair = q / 10, r = q % 10;
  const bfu* hbuf = (const bfu*)(p.ws + WS_HBUF);
  if (r < 6) {
    const int l = 2 * pair, li = pair;
    if (r == 0 && (PM & 4)) {
      gemm_phase<EPI_E1>(p, hbuf, (const bfu*)(p.ws + WS_WT_IN_E) + (size_t)li * EVEN_PAD * D, D, 96, 24, li, lds);
    } else if (r == 1 && (PM & 8)) {
      phase_mid(p, li);
    } else if (r == 2 && (PM & 16)) {
      gemm_phase<EPI_QM>(p, (const bfu*)(p.ws + WS_CQN), (const bfu*)(p.ws + WS_WT_UQ) + (size_t)li * 1536 * 512, 512, 96, 6, li, lds);
      gemm_phase<EPI_KV>(p, (const bfu*)(p.ws + WS_CKVN), (const bfu*)(p.ws + WS_WT_UKV) + (size_t)li * 2048 * 256, 256, 112, 8, li, lds);
    } else if (r == 3 && (PM & 32)) {
      phase_attn_even(p, li, lds);
    } else if (r == 4 && (PM & 64)) {
      gemm_phase<EPI_Y>(p, hbuf, (const bfu*)(p.ws + WS_WT_OUT_E) + (size_t)li * D * D, D, 96, 8, li, lds);
    } else if (r == 5 && (PM & 128)) {
      phase_rows(p, 1, l, lds);
    }
  } else {
    const int l = 2 * pair + 1, li = pair, k = r - 6;
    if (k == 0 && (PM & 256)) {
      gemm_phase<EPI_O1>(p, hbuf, (const bfu*)(p.ws + WS_WT_IN_O) + (size_t)li * ODD_IN * D, D, 96, 32, li, lds);
    } else if (k == 1 && (PM & 512)) {
      phase_attn_odd(p, l, lds);
    } else if (k == 2 && (PM & 1024)) {
      gemm_phase<EPI_Y>(p, hbuf, (const bfu*)(p.ws + WS_WT_OUT_O) + (size_t)li * D * D, D, 96, 8, li, lds);
    } else if (k == 3 && (PM & 2048)) {
      phase_rows(p, 1, l, lds);
    }
  }
}


#define XB_TMO      128
#define XB_XCNT(j)  (256  + 64 * (j))
#define XB_XSUB(j)  (1280 + 64 * (j))
#define XB_XGEN(j)  (2304 + 64 * (j))
#define XB_TOP      3328
#define XB_TOPGEN   3392
#define XCD_BAR_WORDS 3456
#define XB_SPIN_CAP (1u << 22)
#define LAS __attribute__((address_space(3)))
DI unsigned xb_ld(unsigned* p)              { return __hip_atomic_load(p, __ATOMIC_RELAXED, __HIP_MEMORY_SCOPE_AGENT); }
DI unsigned xb_add(unsigned* p, unsigned v) { return __hip_atomic_fetch_add(p, v, __ATOMIC_RELAXED, __HIP_MEMORY_SCOPE_AGENT); }
DI unsigned xb_xcc_id() { return (unsigned)__builtin_amdgcn_s_getreg((3 << 11) | 20) & 0xFu; }
#define XB_SPIN(cond, bar) do { unsigned _sp = 0; while (cond) { __builtin_amdgcn_s_sleep(1); \
    if ((++_sp & 255u) == 0u) { if (xb_ld(&(bar)[XB_TMO])) break; if (_sp > XB_SPIN_CAP) { atomicAdd(&(bar)[XB_TMO], 1u); break; } } } } while (0)
struct XcdBarrier { unsigned* bar; unsigned x; volatile LAS unsigned* st; };
DI XcdBarrier xcd_barrier_post(unsigned* bar, volatile LAS unsigned* st) {
  XcdBarrier b; b.bar = bar; b.x = xb_xcc_id(); b.st = st;
  if (threadIdx.x == 0) (void)xb_add(&bar[XB_XCNT(b.x)], 1u);
  return b;
}
DI void xcd_barrier_complete(unsigned* bar, unsigned x, unsigned& nloc, unsigned& nx) {
  const unsigned G = gridDim.x * gridDim.y * gridDim.z;
  unsigned sum, cnt, mine, sp = 0u;
  for (;;) {
    sum = 0u; cnt = 0u; mine = 0u;
#pragma unroll
    for (unsigned j = 0; j < 16; ++j) { const unsigned c = xb_ld(&bar[XB_XCNT(j)]); sum += c; cnt += (c > 0u) ? 1u : 0u; mine = (j == x) ? c : mine; }
    if (sum == G) break;
    __builtin_amdgcn_s_sleep(1);
    if ((++sp & 255u) == 0u) { if (xb_ld(&bar[XB_TMO])) break; if (sp > XB_SPIN_CAP) { atomicAdd(&bar[XB_TMO], 1u); break; } }
  }
  nloc = mine > 0u ? mine : 1u; nx = cnt > 0u ? cnt : 1u;
}
DI void xcd_barrier(const XcdBarrier& b) {
  asm volatile("s_waitcnt vmcnt(0)" ::: "memory");
  __syncthreads();
  if (threadIdx.x == 0) {
    unsigned* bar = b.bar;
    __builtin_amdgcn_s_waitcnt(0);
    unsigned nloc = b.st[0], nx = b.st[1];
    if (nloc == 0u) { xcd_barrier_complete(bar, b.x, nloc, nx); b.st[0] = nloc; b.st[1] = nx; }
    const unsigned old = xb_add(&bar[XB_XSUB(b.x)], 1u);
    const unsigned gen = old / nloc;
    if (old + 1u == (gen + 1u) * nloc) {
      __builtin_amdgcn_fence(__ATOMIC_RELEASE, "agent");
      asm volatile("s_waitcnt vmcnt(0)" ::: "memory");
      const unsigned og = xb_add(&bar[XB_TOP], 1u);
      const unsigned tg = og / nx;
      if (og + 1u == (tg + 1u) * nx) xb_add(&bar[XB_TOPGEN], 1u);
      else XB_SPIN(xb_ld(&bar[XB_TOPGEN]) == tg, bar);
      __builtin_amdgcn_fence(__ATOMIC_ACQUIRE, "agent");
      xb_add(&bar[XB_XGEN(b.x)], 1u);
      asm volatile("s_waitcnt vmcnt(0)" ::: "memory");
    } else {
      XB_SPIN(xb_ld(&bar[XB_XGEN(b.x)]) == gen, bar);
      __builtin_amdgcn_fence(__ATOMIC_ACQUIRE, "agent");
      asm volatile("s_waitcnt vmcnt(0)" ::: "memory");
    }
  }
  __syncthreads();
}

constexpr int N_PHASES = 22;
constexpr int LDS_BYTES = 8 * 32 * ATT_TR_ROW * 4;

__global__ void __launch_bounds__(512, 2) fwd_megakernel(Params p) {
  __shared__ __attribute__((aligned(16))) char lds[LDS_BYTES];
  __shared__ uint4 xb_words;
  cg::grid_group grid = cg::this_grid();
  if (threadIdx.x == 0) xb_words = make_uint4(0u, 0u, 0u, 0u);
  __syncthreads();
  XcdBarrier xb = xcd_barrier_post((unsigned*)(p.ws + WS_BAR), (volatile LAS unsigned*)&xb_words);
  for (int ph = p.lo; ph < p.hi; ++ph) {
    run_phase(p, ph, lds);
    if (ph + 1 < p.hi) { if (ph < 0) grid.sync(); else xcd_barrier(xb); }
  }
}

extern "C" void kernel_launch(void* const* d_in, const int* in_sizes, int n_in, void* d_out, int out_size, void* d_ws, size_t ws_size,
                              hipStream_t stream) {
  static int grid_blocks = 0;
  if (!grid_blocks) {
    int dev = 0, cus = 0, per_cu = 0;
    (void)hipGetDevice(&dev);
    (void)hipDeviceGetAttribute(&cus, hipDeviceAttributeMultiprocessorCount, dev);
    (void)hipOccupancyMaxActiveBlocksPerMultiprocessor(&per_cu, fwd_megakernel, 512, 0);
    if (per_cu < 1) per_cu = 1;
    per_cu = 1;
    grid_blocks = cus * per_cu;
    if (grid_blocks > 512) grid_blocks = 512;
  }
  if (n_in != 25 || ws_size < WS_NEED) {
    fprintf(stderr, "kernel_launch: bad n_in %d or ws_size %zu < %zu\n", n_in, ws_size, (size_t)WS_NEED);
    return;
  }
  Params p{};
  for (int i = 0; i < 25; ++i) p.in[i] = (const float*)d_in[i];
  p.out = (float*)d_out;
  p.ws = (char*)d_ws;
#ifndef NREP
#define NREP 1
#endif
  p.nrep = NREP; p.pad = 0;
#ifndef PROBE_PHASE
  p.lo = 0; p.hi = N_PHASES;
  void* args[] = {&p};
  (void)hipMemsetAsync((char*)d_ws + WS_BAR, 0, 16384, stream);
  hipError_t e = hipLaunchCooperativeKernel((void*)fwd_megakernel, dim3(grid_blocks), dim3(512), args, 0, stream);
  if (e != hipSuccess) fprintf(stderr, "cooperative launch failed: %s (grid %d)\n", hipGetErrorString(e), grid_blocks);
#else
  void* args[] = {&p};
  p.lo = 0; p.hi = PROBE_PHASE + 1;
  (void)hipMemsetAsync((char*)d_ws + WS_BAR, 0, 16384, stream);
  (void)hipLaunchCooperativeKernel((void*)fwd_megakernel, dim3(grid_blocks), dim3(512), args, 0, stream);
  p.lo = PROBE_PHASE; p.hi = N_PHASES;
  (void)hipMemsetAsync((char*)d_ws + WS_BAR, 0, 16384, stream);
  (void)hipLaunchCooperativeKernel((void*)fwd_megakernel, dim3(grid_blocks), dim3(512), args, 0, stream);
#endif
}
```
